# Optimizing an MI355X kernel written in HIP

```python
import jax, jax.numpy as jnp
from jax import lax
import numpy as np

D_MODEL = 1024
BATCH = 32
SEQ = 2048
DEPTH = 2

GRID_W = 64
N_HEADS = 8
N_KV_HEADS = 2
HEAD_DIM = 64
Q_GROUP = N_HEADS // N_KV_HEADS
ROPE_THETA = 10000.0
Q_BLOCK = 128
SGU_GROUPS = 4
SGU_HEAD = 64
SGU_W = SGU_GROUPS * SGU_HEAD
SGU_CHUNK = 128
POOL_WINDOWS = (2, 4, 8, 16)
POOL_GROUPS = len(POOL_WINDOWS)
POOL_HEAD = 64
POOL_W = POOL_GROUPS * POOL_HEAD
Q_W = N_HEADS * HEAD_DIM
KV_W = N_KV_HEADS * HEAD_DIM
N_BRANCHES = 3
GATE_W = N_BRANCHES * D_MODEL
SPLITS = (Q_W, KV_W, KV_W, SGU_W, SGU_W, POOL_W, GATE_W)
IN_W = sum(SPLITS)
N_EXPERTS = 16
CAPACITY_FACTOR = 2
D_FF_EXPERT = 1024
EPS = 1e-6

kernel_name = "hybrid_gated_attn_sgu_pool_ecmoe"


def rmsnorm(x, g):
    xf = x.astype(jnp.float32)
    y = xf * lax.rsqrt(jnp.mean(xf * xf, axis=-1, keepdims=True) + EPS)
    return (y * g.astype(jnp.float32)).astype(x.dtype)


def axial_rope_tables(seq_len):
    rows = seq_len // GRID_W
    row = jnp.broadcast_to(jnp.arange(rows, dtype=jnp.float32)[:, None], (rows, GRID_W)).reshape(-1)
    col = jnp.broadcast_to(jnp.arange(GRID_W, dtype=jnp.float32)[None, :], (rows, GRID_W)).reshape(-1)
    part = HEAD_DIM // 2
    freqs = ROPE_THETA ** (-jnp.arange(0, part, 2, dtype=jnp.float32) / part)
    ang = jnp.stack([row[:, None] * freqs, col[:, None] * freqs], axis=1)
    return jnp.cos(ang), jnp.sin(ang)


def apply_axial_rope(x, cos, sin):
    B, S, H, _ = x.shape
    nf = HEAD_DIM // 4
    xf = x.astype(jnp.float32).reshape(B, S, H, 2, 2, nf)
    x1, x2 = xf[..., 0, :], xf[..., 1, :]
    c = cos[None, :, None]
    s = sin[None, :, None]
    out = jnp.stack([x1 * c - x2 * s, x2 * c + x1 * s], axis=-2)
    return out.reshape(B, S, H, HEAD_DIM).astype(x.dtype)


def block_attention(q, k, v):
    B, S = q.shape[:2]
    nb = S // Q_BLOCK
    scale = HEAD_DIM ** -0.5
    qb = q.reshape(B, nb, Q_BLOCK, N_KV_HEADS, Q_GROUP, HEAD_DIM).transpose(1, 0, 2, 3, 4, 5)

    def one_block(qblk):
        s = jnp.einsum('bqkgd,bskd->bkgqs', qblk, k).astype(jnp.float32) * scale
        p = jax.nn.softmax(s, axis=-1).astype(v.dtype)
        return jnp.einsum('bkgqs,bskd->bqkgd', p, v)

    o = lax.map(one_block, qb)
    return o.transpose(1, 0, 2, 3, 4, 5).reshape(B, S, Q_W)


def spatial_gating(u, v, g_sgu, w_spatial, b_spatial):
    B, S, _ = v.shape
    nc = S // SGU_CHUNK
    vn = rmsnorm(v, g_sgu).reshape(B, nc, SGU_CHUNK, SGU_GROUPS, SGU_HEAD)
    z = jnp.einsum('gpq,bcqgd->bcpgd', w_spatial, vn) + b_spatial.T[None, None, :, :, None]
    return u * z.reshape(B, S, SGU_W)


def multiscale_pool(p, w_pool, pool_scale):
    B, S, _ = p.shape
    pf = p.astype(jnp.float32)
    cs = jnp.concatenate([jnp.zeros((B, 1, POOL_W), jnp.float32), jnp.cumsum(pf, axis=1)], axis=1)
    t = jnp.arange(S)
    means = []
    for g, w in enumerate(POOL_WINDOWS):
        lo = jnp.clip(t - w // 2, 0, S - 1)
        hi = jnp.clip(t + (w - 1 - w // 2), 0, S - 1)
        seg = cs[:, :, g * POOL_HEAD:(g + 1) * POOL_HEAD]
        cnt = (hi - lo + 1).astype(jnp.float32)
        means.append((jnp.take(seg, hi + 1, axis=1) - jnp.take(seg, lo, axis=1)) / cnt[None, :, None])
    pooled = jnp.concatenate(means, axis=-1)
    d = (pooled - pf).astype(p.dtype).reshape(B, S, POOL_GROUPS, POOL_HEAD)
    y = jnp.einsum('bsgc,gcd->bsgd', d, w_pool).reshape(B, S, POOL_W)
    return y * pool_scale


def expert_choice_moe(h, w_router, w_gate_e, w_up_e, w_down_e):
    B, S, D = h.shape
    cap = CAPACITY_FACTOR * S // N_EXPERTS
    aff = jax.nn.softmax(jnp.einsum('bsd,de->bse', h, w_router).astype(jnp.float32), axis=-1)
    vals, idx = lax.top_k(aff.transpose(0, 2, 1), cap)
    xs = jax.vmap(lambda hb, ib: hb[ib])(h, idx)
    a = jnp.einsum('becd,edf->becf', xs, w_gate_e)
    b = jnp.einsum('becd,edf->becf', xs, w_up_e)
    out = jnp.einsum('becf,efd->becd', jax.nn.silu(a) * b, w_down_e)
    out = out * vals[..., None].astype(out.dtype)
    return jax.vmap(lambda ib, ob: jnp.zeros((S, D), ob.dtype).at[ib.reshape(-1)].add(ob.reshape(-1, D)))(idx, out)


def setup_inputs(seed: int = 0) -> dict:
    key = jax.random.key(seed)
    ks = jax.random.split(key, 24)
    f32 = jnp.float32

    def nrm(k, shape, fan_in):
        return jax.random.normal(k, shape, f32) * (fan_in ** -0.5)

    def gain(k, shape, s=0.05):
        return 1.0 + s * jax.random.normal(k, shape, f32)

    L = DEPTH
    return {
        "x": jax.random.normal(ks[0], (BATCH, SEQ, D_MODEL), f32),
        "g_mix": gain(ks[1], (L, D_MODEL)),
        "w_in": nrm(ks[2], (L, D_MODEL, IN_W), D_MODEL),
        "g_q": gain(ks[3], (L, HEAD_DIM)),
        "g_k": gain(ks[4], (L, HEAD_DIM)),
        "g_sgu": gain(ks[5], (L, SGU_W)),
        "w_spatial": nrm(ks[6], (L, SGU_GROUPS, SGU_CHUNK, SGU_CHUNK), SGU_CHUNK),
        "b_spatial": gain(ks[7], (L, SGU_GROUPS, SGU_CHUNK)),
        "w_pool": nrm(ks[8], (L, POOL_GROUPS, POOL_HEAD, POOL_HEAD), POOL_HEAD),
        "pool_scale": gain(ks[9], (L, POOL_W), 0.1),
        "w_attn_o": nrm(ks[10], (L, Q_W, D_MODEL), Q_W),
        "w_sgu_o": nrm(ks[11], (L, SGU_W, D_MODEL), SGU_W),
        "w_pool_o": nrm(ks[12], (L, POOL_W, D_MODEL), POOL_W),
        "w_out": nrm(ks[13], (L, D_MODEL, D_MODEL), D_MODEL),
        "g_ffn": gain(ks[14], (L, D_MODEL)),
        "w_router": nrm(ks[15], (L, D_MODEL, N_EXPERTS), D_MODEL),
        "w_gate_e": nrm(ks[16], (L, N_EXPERTS, D_MODEL, D_FF_EXPERT), D_MODEL),
        "w_up_e": nrm(ks[17], (L, N_EXPERTS, D_MODEL, D_FF_EXPERT), D_MODEL),
        "w_down_e": nrm(ks[18], (L, N_EXPERTS, D_FF_EXPERT, D_MODEL), D_FF_EXPERT),
        "g_final": gain(ks[19], (D_MODEL,)),
    }


def reference(x, g_mix, w_in, g_q, g_k, g_sgu, w_spatial, b_spatial, w_pool, pool_scale,
              w_attn_o, w_sgu_o, w_pool_o, w_out, g_ffn, w_router, w_gate_e, w_up_e, w_down_e, g_final):
    B, S, D = x.shape
    cos, sin = axial_rope_tables(S)
    cuts = [int(c) for c in np.cumsum(SPLITS)[:-1]]
    for l in range(DEPTH):
        h = rmsnorm(x, g_mix[l])
        proj = jnp.einsum('bsd,dn->bsn', h, w_in[l])
        q, k, v, u, vs, p, gl = jnp.split(proj, cuts, axis=-1)
        q = apply_axial_rope(rmsnorm(q.reshape(B, S, N_HEADS, HEAD_DIM), g_q[l]), cos, sin)
        k = apply_axial_rope(rmsnorm(k.reshape(B, S, N_KV_HEADS, HEAD_DIM), g_k[l]), cos, sin)
        v = v.reshape(B, S, N_KV_HEADS, HEAD_DIM)
        br_a = jnp.einsum('bsc,cd->bsd', block_attention(q, k, v), w_attn_o[l])
        br_b = jnp.einsum('bsc,cd->bsd', spatial_gating(u, vs, g_sgu[l], w_spatial[l], b_spatial[l]), w_sgu_o[l])
        br_c = jnp.einsum('bsc,cd->bsd', multiscale_pool(p, w_pool[l], pool_scale[l]), w_pool_o[l])
        ga, gb, gc = jnp.split(jax.nn.sigmoid(gl), N_BRANCHES, axis=-1)
        merged = ga * br_a + gb * br_b + gc * br_c
        x = x + jnp.einsum('bsd,de->bse', merged, w_out[l])
        h2 = rmsnorm(x, g_ffn[l])
        x = x + expert_choice_moe(h2, w_router[l], w_gate_e[l], w_up_e[l], w_down_e[l])
    return rmsnorm(x, g_final)
```

```cpp
#include <hip/hip_runtime.h>
#include <hip/hip_bf16.h>
#include <stdint.h>
#include <stdio.h>

#define DEVI __device__ __forceinline__
typedef unsigned short bf16;
typedef short bf16x8 __attribute__((ext_vector_type(8)));
typedef float f32x4 __attribute__((ext_vector_type(4)));
typedef unsigned u32x4 __attribute__((ext_vector_type(4)));
typedef unsigned u32x2 __attribute__((ext_vector_type(2)));

constexpr int NB = 32, S = 2048, D = 1024, M = NB * S, DEPTH = 2;
constexpr int INW = 4608, QW = 512, KVW = 128, SGW = 256, PLW = 256, GW = 3072;
constexpr int NE = 16, CAP = 256, FF = 1024, NSLOT = NB * NE * CAP;
constexpr float EPS = 1e-6f;
constexpr float C2 = 0.125f * 1.4426950408889634f;

constexpr size_t MiB = 1u << 20;
constexpr size_t WS_CTL = 0;
constexpr size_t WS_ROPE = 1 * MiB;
constexpr size_t WS_R1 = WS_ROPE + 64 * 1024;
constexpr size_t WS_R2 = WS_R1 + 256 * 1024;
constexpr size_t WS_IDX = WS_R2 + 256 * 1024;
constexpr size_t WS_VSEL = WS_IDX + 512 * 1024;
constexpr size_t WS_RSEL = WS_VSEL + 512 * 1024;
constexpr size_t WS_INV = 4 * MiB;
constexpr size_t WS_AFFT = 6 * MiB;
constexpr size_t WS_WSP = 10 * MiB;
constexpr size_t WS_WPT = 10 * MiB + 512 * 1024;
constexpr size_t WS_WRT = 11 * MiB;
constexpr size_t WS_W1T = 12 * MiB;
constexpr size_t WS_W2T = 30 * MiB;
constexpr size_t WS_W3T = 34 * MiB;
constexpr size_t WS_WUP = 40 * MiB;
constexpr size_t WS_WDN = 104 * MiB;
constexpr size_t WS_XB = 136 * MiB;
constexpr size_t WS_GATES = 264 * MiB;
constexpr size_t WS_H = WS_GATES;
constexpr size_t WS_XB8 = 520 * MiB;
constexpr size_t WS_W1G8_OFF = 3 * MiB;
constexpr float HSCALE = 16.0f, W8SCALE = 64.0f;
constexpr float GSCALE = 32.0f;
constexpr size_t WS_Q = 648 * MiB;
constexpr size_t WS_K = WS_Q + 64 * MiB;
constexpr size_t WS_V = WS_K + 16 * MiB;
constexpr size_t WS_U = WS_V + 16 * MiB;
constexpr size_t WS_VS = WS_U + 32 * MiB;
constexpr size_t WS_P = WS_VS + 32 * MiB;
constexpr size_t WS_ACT = 840 * MiB;
constexpr size_t WS_MERGED = WS_Q;
constexpr size_t WS_Y = WS_Q;
constexpr size_t WS_END = 968 * MiB;
static_assert(WS_P + 32 * MiB == WS_ACT && WS_ACT + 128 * MiB == WS_END, "ws map");

DEVI unsigned f2bf(float f) { unsigned u = __builtin_bit_cast(unsigned, f); return (u + 0x7fffu + ((u >> 16) & 1u)) >> 16; }
DEVI unsigned pk2(float lo, float hi) { return f2bf(lo) | (f2bf(hi) << 16); }
DEVI float bf2f(unsigned short h) { return __builtin_bit_cast(float, (unsigned)h << 16); }
DEVI float bflo(unsigned w) { return __builtin_bit_cast(float, w << 16); }
DEVI float bfhi(unsigned w) { return __builtin_bit_cast(float, w & 0xffff0000u); }
DEVI int dpp_qx1(int v) { return __builtin_amdgcn_update_dpp(0, v, 0xB1, 0xF, 0xF, true); }
DEVI int dpp_qx2(int v) { return __builtin_amdgcn_update_dpp(0, v, 0x4E, 0xF, 0xF, true); }
DEVI int dpp_hmir(int v) { return __builtin_amdgcn_update_dpp(0, v, 0x141, 0xF, 0xF, true); }
DEVI int dpp_mir(int v) { return __builtin_amdgcn_update_dpp(0, v, 0x140, 0xF, 0xF, true); }
DEVI int swz_x16(int v) { return __builtin_amdgcn_ds_swizzle(v, 0x401F); }
DEVI float xor16_f(float v) { return __builtin_bit_cast(float, swz_x16(__builtin_bit_cast(int, v))); }
DEVI float sum32_f(float v) { unsigned a = __builtin_bit_cast(unsigned, v), b = a; asm volatile("" : "+v"(b)); auto r = __builtin_amdgcn_permlane32_swap(a, b, false, false); const unsigned r0 = r[0], r1 = r[1]; return __builtin_bit_cast(float, r0) + __builtin_bit_cast(float, r1); }
DEVI int sum32_i(int v) { unsigned a = (unsigned)v, b = a; asm volatile("" : "+v"(b)); auto r = __builtin_amdgcn_permlane32_swap(a, b, false, false); return (int)(r[0] + r[1]); }
DEVI float wave_sum(float v) {
    v += __builtin_bit_cast(float, dpp_qx1(__builtin_bit_cast(int, v))); v += __builtin_bit_cast(float, dpp_qx2(__builtin_bit_cast(int, v)));
    v += __builtin_bit_cast(float, dpp_hmir(__builtin_bit_cast(int, v))); v += __builtin_bit_cast(float, dpp_mir(__builtin_bit_cast(int, v)));
    v += xor16_f(v); return sum32_f(v);
}
DEVI int wave_sum_i(int v) {
    v += dpp_qx1(v); v += dpp_qx2(v); v += dpp_hmir(v); v += dpp_mir(v); v += swz_x16(v); return sum32_i(v);
}

__host__ __device__ __forceinline__ int g1_logical(int pos) {
    const int pn = pos >> 8, p = pos & 255, bj = p >> 7, wc = (p >> 5) & 3, r = p & 31, fq = r >> 3, low = r & 7;
    const int d = 32 * (fq >> 1) + 16 * bj + 8 * (fq & 1) + low;
    if (pn < 2) return 64 * (4 * pn + wc) + d;
    if (pn == 2) { if (wc < 2) return 512 + 64 * wc + d; return 640 + (wc - 2) * 64 + bj * 32 + r; }
    return pos;
}
__host__ __device__ __forceinline__ int g1_pos(int c) {
    if (c < 640) { const int head = c >> 6, d = c & 63, a = d >> 5, hf = (d >> 4) & 1, f8 = (d >> 3) & 1, low = d & 7;
        const int fq = 2 * a + f8, r = 8 * fq + low, pn = (c < 512) ? (head >> 2) : 2, wc = (c < 512) ? (head & 3) : (head - 8);
        return 256 * pn + 128 * hf + 32 * wc + r; }
    if (c < 768) { const int v = c - 640, wc = 2 + (v >> 6), bj = (v >> 5) & 1, r = v & 31; return 512 + 128 * bj + 32 * wc + r; }
    return c;
}

DEVI float dppf_qx1(float v) { return __builtin_bit_cast(float, dpp_qx1(__builtin_bit_cast(int, v))); }
DEVI float dppf_qx2(float v) { return __builtin_bit_cast(float, dpp_qx2(__builtin_bit_cast(int, v))); }
DEVI float dppf_hmir(float v) { return __builtin_bit_cast(float, dpp_hmir(__builtin_bit_cast(int, v))); }
DEVI float dppf_mir(float v) { return __builtin_bit_cast(float, dpp_mir(__builtin_bit_cast(int, v))); }
DEVI float row16_sum(float v) { v += dppf_qx1(v); v += dppf_qx2(v); v += dppf_hmir(v); v += dppf_mir(v); return v; }
DEVI float row16_max(float v) { v = fmaxf(v, dppf_qx1(v)); v = fmaxf(v, dppf_qx2(v)); v = fmaxf(v, dppf_hmir(v)); v = fmaxf(v, dppf_mir(v)); return v; }

DEVI unsigned pk4_fp8(const f32x4 v) { int p = 0; p = __builtin_amdgcn_cvt_pk_fp8_f32(v.x, v.y, p, false); p = __builtin_amdgcn_cvt_pk_fp8_f32(v.z, v.w, p, true); return (unsigned)p; }

#define GAS __attribute__((address_space(1)))
#define LAS __attribute__((address_space(3)))
#define LDS_WAIT() asm volatile("s_waitcnt lgkmcnt(0)" ::: "memory")
#define VM_WAIT() asm volatile("s_waitcnt vmcnt(0)" ::: "memory")
typedef GAS unsigned gu32;
#define RLX_AGENT __ATOMIC_RELAXED, __HIP_MEMORY_SCOPE_AGENT
constexpr int NWAVES = 8;
DEVI int lane_id_v() { int l; asm volatile("v_mbcnt_lo_u32_b32 %0, -1, 0\n\tv_mbcnt_hi_u32_b32 %0, -1, %0" : "=v"(l)); return l; }

namespace pg8 {
constexpr int BM = 256, BK = 64, HALF = 128, HTB = HALF * BK * 2, STAGE_BYTES = 8 * HTB, NXCD = 8, WGM = 8, GIDX_OFF = STAGE_BYTES;
__host__ __device__ __forceinline__ int lds_byte(int r, int c) { const int st = (r >> 4) * 2 + (c >> 5), rr = r & 15, cc = c & 31, ob = rr * 64 + cc * 2; return st * 1024 + (ob ^ (((ob >> 9) & 1) << 5)); }
__host__ __device__ __forceinline__ void stage_rc(int b, int& R, int& C) { const int st = b / 1024, sb = b % 1024, swz = sb ^ (((sb >> 9) & 1) << 5); R = (st >> 1) * 16 + swz / 64; C = (st & 1) * 32 + (swz % 64) / 2; }
__host__ __device__ __forceinline__ int perm32(int rho) { const int n = rho >> 4, i = rho & 15; return 8 * (i >> 2) + 4 * n + (i & 3); }
struct Unit { int pm, pn; };
struct Gemm { const bf16* A; const bf16* Bt; int K; };
struct StaticOrder {
    int nM, nN, nwg, G, c;
    __device__ void init(int M_, int N_, int G_, int c_) { nM = M_ / BM; nN = N_ / BM; nwg = nM * nN; G = G_; c = c_; }
    __device__ bool next(int i, Unit& u) const {
        const long L = (long)i * G + c; if (L >= nwg) return false;
        int wgid = (int)L; { const int q = nwg / NXCD, r = nwg % NXCD, xcd = wgid % NXCD, off = wgid / NXCD; wgid = (xcd < r ? xcd * (q + 1) : r * (q + 1) + (xcd - r) * q) + off; }
        const int nig = WGM * nN, gid = wgid / nig, fm = gid * WGM, gsz = (nM - fm) < WGM ? (nM - fm) : WGM;
        u.pm = fm + ((wgid % nig) % gsz); u.pn = (wgid % nig) / gsz; return true;
    }
};
struct MoeOrder {
    int NJ, G, c;
    __device__ bool next(int i, Unit& u) const {
        const long L = (long)i * G + c; const int per = 32 * NJ; if (L >= (long)NE * per) return false;
        const int e = (int)(L / per), w = (int)(L % per), x = w & 7, q = w >> 3, b = x * 4 + q / NJ, j = q % NJ;
        u.pm = e * 32 + b; u.pn = e * NJ + j; return true;
    }
};
DEVI unsigned cvt_pk_bf16(float lo, float hi) { unsigned r; asm volatile("v_cvt_pk_bf16_f32 %0, %1, %2" : "=v"(r) : "v"(lo), "v"(hi)); return r; }
typedef f32x4 Acc[2][2][4][2];

struct NoHook { DEVI void operator()(int) const {} };
typedef int v4i_t __attribute__((ext_vector_type(4))); typedef int v8i_t __attribute__((ext_vector_type(8)));
DEVI v8i_t cat8(const v4i_t x, const v4i_t y) { return __builtin_shufflevector(x, y, 0, 1, 2, 3, 4, 5, 6, 7); }
template <class Epi, class Sched, bool GATHER, class Hook = NoHook>
DEVI void gemm_phase(LAS unsigned char* lds, const Gemm g, const Sched& S, const Epi& E, const int* __restrict__ gidx, int tid, int mode = 0, const Hook& H = Hook(), const float* __restrict__ rs = nullptr) {
    asm volatile("" : "+v"(tid));
    const int wid = __builtin_amdgcn_readfirstlane(tid >> 6), lane = tid & 63, wr = wid >> 2, wc = wid & 3, fr = lane & 15, fq = lane >> 4;
    int K = g.K; asm volatile("" : "+s"(K));
    const int nt = K / BK;
    unsigned voffA[2], voffB[2]; int RA[2]; unsigned CA2[2];
#pragma unroll
    for (int i = 0; i < 2; ++i) { int R, C; stage_rc(tid * 16 + i * 8192, R, C); const int Rb = (R & ~31) + perm32(R & 31);
        voffA[i] = (unsigned)(R * K + C) * 2u; voffB[i] = (unsigned)(Rb * K + C) * 2u; RA[i] = R; CA2[i] = (unsigned)C * 2u; }
    const size_t kstep = (size_t)(BK * 2);
    const size_t hstep = (size_t)HALF * K * 2;
    const size_t tstep = 2 * hstep;
    const unsigned ldsw = (unsigned)wid * 1024u;
    const int aoff = lds_byte(wr * 64 + fr, fq * 8), boff = lds_byte(wc * 32 + fr, fq * 8);
#define PG8_SA(b, h) (((b) * 2 + (h)) * HTB)
#define PG8_SB(b, h) ((4 + (b) * 2 + (h)) * HTB)
#define PG8_STAGE(bufoff, gbase, voff) do { _Pragma("unroll") for (int _i = 0; _i < 2; ++_i) \
        __builtin_amdgcn_global_load_lds((const unsigned*)((const char*)(gbase) + (voff)[_i]), (LAS unsigned*)(lds + (bufoff) + ldsw + _i * 8192), 16, 0, 0); } while (0)
#define PG8_STAGEA(bufoff, kbase, h, V) do { if constexpr (GATHER) { PG8_STAGE(bufoff, kbase, (V)[h]); } else { PG8_STAGE(bufoff, (kbase) + (h) * hstep, voffA); } } while (0)
#define PG8_LDA(dst, b, h) do { if constexpr (Epi::FP8) { _Pragma("unroll") for (int m = 0; m < 4; ++m) dst##8[m] = cat8(*(const LAS v4i_t*)(lds + PG8_SA(b, h) + aoff + m * 2048), *(const LAS v4i_t*)(lds + PG8_SA(b, h) + aoff + m * 2048 + 1024)); } \
        else { _Pragma("unroll") for (int m = 0; m < 4; ++m) _Pragma("unroll") for (int k = 0; k < 2; ++k) dst[m][k] = *(const LAS bf16x8*)(lds + PG8_SA(b, h) + aoff + m * 2048 + k * 1024); } } while (0)
#define PG8_LDB(dst, b, h) do { if constexpr (Epi::FP8) { _Pragma("unroll") for (int n = 0; n < 2; ++n) dst##8[n] = cat8(*(const LAS v4i_t*)(lds + PG8_SB(b, h) + boff + n * 2048), *(const LAS v4i_t*)(lds + PG8_SB(b, h) + boff + n * 2048 + 1024)); } \
        else { _Pragma("unroll") for (int n = 0; n < 2; ++n) _Pragma("unroll") for (int k = 0; k < 2; ++k) dst[n][k] = *(const LAS bf16x8*)(lds + PG8_SB(b, h) + boff + n * 2048 + k * 1024); } } while (0)
#define PG8_MMA(ai, bj, At, Bt) do { __builtin_amdgcn_s_setprio(1); _Pragma("unroll") for (int m = 0; m < 4; ++m) _Pragma("unroll") for (int n = 0; n < 2; ++n) { \
        if constexpr (Epi::FP8) { asm volatile("v_mfma_scale_f32_16x16x128_f8f6f4 %0, %1, %2, %0, %3, %3 op_sel_hi:[0,0,0]" : "+v"(acc[ai][bj][m][n]) : "v"(Bt##8[n]), "v"(At##8[m]), "v"(one_scale)); } \
        else { _Pragma("unroll") for (int k = 0; k < 2; ++k) acc[ai][bj][m][n] = __builtin_amdgcn_mfma_f32_16x16x32_bf16(Bt[n][k], At[m][k], acc[ai][bj][m][n], 0, 0, 0); } } \
        __builtin_amdgcn_s_setprio(0); } while (0)
#define PG8_WAIT_V(n) asm volatile("s_waitcnt vmcnt(" #n ")" ::: "memory")
#define PG8_WAIT_L(n) asm volatile("s_waitcnt lgkmcnt(" #n ")" ::: "memory")
#define PG8_BAR __builtin_amdgcn_s_barrier()
#define PG8_SCHED __builtin_amdgcn_sched_barrier(0)
#define PG8_LOADV(dst, un) do { _Pragma("unroll") for (int _h = 0; _h < 2; ++_h) _Pragma("unroll") for (int _i = 0; _i < 2; ++_i) \
        dst[_h][_i] = (unsigned)gidx[(un).pm * 256 + _h * 128 + RA[_i]] * (unsigned)(K * 2) + CA2[_i]; } while (0)
#define PG8_DMAV(un) do { _Pragma("unroll") for (int _h = 0; _h < 2; ++_h) _Pragma("unroll") for (int _i = 0; _i < 2; ++_i) \
        __builtin_amdgcn_global_load_lds((const unsigned*)(gidx + (un).pm * 256 + _h * 128 + RA[_i]), (LAS unsigned*)(lds + GIDX_OFF + ((_h * 2 + _i) * 8 + wid) * 256), 4, 0, 0); } while (0)
#define PG8_READV(dst) do { _Pragma("unroll") for (int _h = 0; _h < 2; ++_h) _Pragma("unroll") for (int _i = 0; _i < 2; ++_i) \
        dst[_h][_i] = *(const LAS unsigned*)(lds + GIDX_OFF + ((_h * 2 + _i) * 8 + wid) * 256 + lane * 4) * (unsigned)(K * 2) + CA2[_i]; } while (0)
    Unit cur, nxt; int ui = 0;
    if (!S.next(0, cur)) return;
    Acc acc;
#pragma unroll
    for (int a = 0; a < 2; ++a)
#pragma unroll
        for (int b = 0; b < 2; ++b)
#pragma unroll
            for (int m = 0; m < 4; ++m)
#pragma unroll
                for (int n = 0; n < 2; ++n) acc[a][b][m][n] = (f32x4){0.f, 0.f, 0.f, 0.f};
    bf16x8 At[4][2], B0[2][2], B1[2][2];
    v8i_t At8[4], B08[2], B18[2];
    int one_scale = 0x7f7f7f7f; asm volatile("" : "+v"(one_scale));
    float rsv[8] = {0.f, 0.f, 0.f, 0.f, 0.f, 0.f, 0.f, 0.f};
    unsigned vAc[2][2] = {{0u, 0u}, {0u, 0u}};
    if constexpr (GATHER) { PG8_LOADV(vAc, cur); }
    const char* cA = GATHER ? (const char*)g.A : (const char*)g.A + (size_t)cur.pm * tstep; const char* cB = (const char*)g.Bt + (size_t)cur.pn * tstep;
    PG8_STAGE(PG8_SB(0, 0), cB, voffB); PG8_STAGE(PG8_SB(0, 1), cB + hstep, voffB); PG8_STAGEA(PG8_SA(0, 0), cA, 0, vAc); PG8_STAGEA(PG8_SA(0, 1), cA, 1, vAc);
    if (wr == 1) PG8_BAR;
    PG8_WAIT_V(2); PG8_BAR;
    PG8_STAGE(PG8_SB(1, 0), cB + kstep, voffB); PG8_STAGEA(PG8_SA(1, 0), cA + kstep, 0, vAc); PG8_STAGE(PG8_SB(1, 1), cB + hstep + kstep, voffB);
    PG8_WAIT_V(6); PG8_BAR;
    for (;;) {
        const bool has_next = S.next(ui + 1, nxt);
        if constexpr (GATHER) { if (has_next) { PG8_DMAV(nxt); } }
        const char* nA = GATHER ? (const char*)g.A : (has_next ? (const char*)g.A + (size_t)nxt.pm * tstep : cA);
        const char* nB = has_next ? (const char*)g.Bt + (size_t)nxt.pn * tstep : cB;
        for (int t = 0; t < nt; t += 2) {
            if constexpr (Epi::HAS_MID) { if ((t == Epi::MID0 || t == Epi::MID1) && !(mode & 2)) E.mid(acc, cur, t, wr, wc, fr, fq); }
            const bool last = (t == nt - 2);
            if constexpr (Epi::HAS_RS) { if (last) {
#pragma unroll
                for (int k = 0; k < 8; ++k) rsv[k] = rs[cur.pm * BM + (k >> 2) * HALF + wr * 64 + (k & 3) * 16 + fr]; } }
            const char* a1 = cA + (size_t)(t + 1) * kstep;
            const char* a2 = last ? nA : cA + (size_t)(t + 2) * kstep; const char* b2 = last ? nB : cB + (size_t)(t + 2) * kstep;
            const char* a3 = a2 + kstep; const char* b3 = b2 + kstep;
            PG8_LDB(B0, 0, 0); PG8_LDB(B1, 0, 1); PG8_SCHED; PG8_LDA(At, 0, 0); PG8_STAGEA(PG8_SA(1, 1), a1, 1, vAc);
            PG8_WAIT_V(8); PG8_WAIT_L(0); PG8_BAR; PG8_MMA(0, 0, At, B0); PG8_MMA(0, 1, At, B1); PG8_BAR; PG8_SCHED;
            if constexpr (GATHER) { if (last && has_next) { PG8_READV(vAc); } }
            PG8_LDA(At, 0, 1); PG8_STAGE(PG8_SB(0, 0), b2, voffB); PG8_STAGE(PG8_SB(0, 1), b2 + hstep, voffB); PG8_STAGEA(PG8_SA(0, 0), a2, 0, vAc);
            PG8_WAIT_V(8); PG8_WAIT_L(0); PG8_BAR; PG8_MMA(1, 0, At, B0); PG8_MMA(1, 1, At, B1); PG8_BAR; PG8_SCHED;
            PG8_LDB(B0, 1, 0); PG8_LDB(B1, 1, 1); PG8_SCHED; PG8_LDA(At, 1, 0); PG8_STAGEA(PG8_SA(0, 1), a2, 1, vAc);
            PG8_WAIT_V(8); PG8_WAIT_L(0); PG8_BAR; PG8_MMA(0, 0, At, B0); PG8_MMA(0, 1, At, B1); PG8_BAR; PG8_SCHED;
            PG8_LDA(At, 1, 1); PG8_STAGE(PG8_SB(1, 0), b3, voffB); PG8_STAGE(PG8_SB(1, 1), b3 + hstep, voffB); PG8_STAGEA(PG8_SA(1, 0), a3, 0, vAc);
            PG8_WAIT_V(8); PG8_WAIT_L(0); PG8_BAR; PG8_MMA(1, 0, At, B0); PG8_MMA(1, 1, At, B1); PG8_BAR; PG8_SCHED;
        }
        if (wr == 0) PG8_BAR;
        if constexpr (Epi::FP8) asm volatile("s_nop 15\n\ts_nop 15" ::: "memory");
        if (!(mode & 1)) E(acc, cur, wr, wc, fr, fq, rsv);
        H(ui);
        if (!has_next) break;
#pragma unroll
        for (int a = 0; a < 2; ++a)
#pragma unroll
            for (int b = 0; b < 2; ++b)
#pragma unroll
                for (int m = 0; m < 4; ++m)
#pragma unroll
                    for (int n = 0; n < 2; ++n) acc[a][b][m][n] = (f32x4){0.f, 0.f, 0.f, 0.f};
        cur = nxt; cA = nA; cB = nB; ++ui;
        if (wr == 1) PG8_BAR;
    }
    PG8_WAIT_V(0);
    PG8_BAR;
#undef PG8_SA
#undef PG8_SB
#undef PG8_STAGE
#undef PG8_STAGEA
#undef PG8_LDA
#undef PG8_LDB
#undef PG8_MMA
#undef PG8_WAIT_V
#undef PG8_WAIT_L
#undef PG8_BAR
#undef PG8_SCHED
#undef PG8_LOADV
#undef PG8_DMAV
#undef PG8_READV
}

DEVI u32x4 pack8(const f32x4 a, const f32x4 b) { u32x4 w; w.x = cvt_pk_bf16(a[0], a[1]); w.y = cvt_pk_bf16(a[2], a[3]); w.z = cvt_pk_bf16(b[0], b[1]); w.w = cvt_pk_bf16(b[2], b[3]); return w; }
DEVI float sigm(float v) { v = fmaxf(v, -30.f); return __builtin_amdgcn_rcpf(1.0f + __expf(-v)); }

struct EpiG1 {
    static constexpr bool HAS_MID = false, HAS_RS = false, FP8 = false; static constexpr int MID0 = -1, MID1 = -1;
    const float* r1; const float* rope; const float* g_q; const float* g_k;
    bf16 *Q, *Kb, *V, *U, *VS, *P;
    DEVI void mid(Acc&, const Unit&, int, int, int, int, int) const {}
    DEVI void operator()(const Acc& acc, const Unit& u, int wr, int wc, int fr, int fq, const float (&rsv)[8]) const {
        asm volatile("" : "+v"(fr), "+v"(fq));
        const int row0 = u.pm * BM + wr * 64 + fr, pn = u.pn;
        float r1v[8];
#pragma unroll
        for (int k = 0; k < 8; ++k) r1v[k] = r1[row0 + (k >> 2) * HALF + (k & 3) * 16];
        if (pn < 2 || (pn == 2 && wc < 2)) {
            const bool isq = pn < 2; const float* g = isq ? g_q : g_k; const int a = fq >> 1, f0 = 8 * (fq & 1);
            f32x4 g1[2], g2[2];
#pragma unroll
            for (int n = 0; n < 2; ++n) { g1[n] = *(const f32x4*)(g + 32 * a + f0 + 4 * n); g2[n] = *(const f32x4*)(g + 32 * a + 16 + f0 + 4 * n); }
            const float osc = isq ? C2 : 1.0f;
#pragma unroll
            for (int ai = 0; ai < 2; ++ai) {
#pragma unroll
                for (int mh = 0; mh < 2; ++mh) {
                f32x4 rp4[2][4];
#pragma unroll
                for (int m2 = 0; m2 < 2; ++m2) { const int tpos_ = (row0 + ai * HALF + (mh * 2 + m2) * 16) & (S - 1), pos_ = a ? (tpos_ & 63) : (tpos_ >> 6); const f32x4* rq = (const f32x4*)(rope + 2 * (pos_ * 16 + f0));
#pragma unroll
                    for (int q = 0; q < 4; ++q) rp4[m2][q] = rq[q]; }
#pragma unroll
                for (int m2 = 0; m2 < 2; ++m2) { const int m = mh * 2 + m2;
                    const int row = row0 + ai * HALF + m * 16; const float rs = r1v[ai * 4 + m];
                    f32x4 v[2][2]; float ss = 0.f;
#pragma unroll
                    for (int bj = 0; bj < 2; ++bj)
#pragma unroll
                        for (int n = 0; n < 2; ++n) { v[bj][n] = acc[ai][bj][m][n] * rs; ss += v[bj][n][0] * v[bj][n][0] + v[bj][n][1] * v[bj][n][1] + v[bj][n][2] * v[bj][n][2] + v[bj][n][3] * v[bj][n][3]; }
                    ss += xor16_f(ss); ss = sum32_f(ss);
                    const float rn = __builtin_amdgcn_rsqf(ss * (1.0f / 64) + EPS) * osc;
                    const f32x4* rp = rp4[m2];
                    f32x4 o1[2], o2[2];
#pragma unroll
                    for (int n = 0; n < 2; ++n) { const f32x4 cs0 = rp[2 * n], cs1 = rp[2 * n + 1];
                        const f32x4 x1 = v[0][n] * rn * g1[n], x2 = v[1][n] * rn * g2[n];
                        const f32x4 c = (f32x4){cs0[0], cs0[2], cs1[0], cs1[2]}, s = (f32x4){cs0[1], cs0[3], cs1[1], cs1[3]};
                        o1[n] = x1 * c - x2 * s; o2[n] = x2 * c + x1 * s; }
                    bf16* dst = isq ? (Q + (size_t)row * QW + 64 * (4 * pn + wc)) : (Kb + (size_t)row * KVW + 64 * wc);
                    *(u32x4*)(dst + 32 * a + f0) = pack8(o1[0], o1[1]); *(u32x4*)(dst + 32 * a + 16 + f0) = pack8(o2[0], o2[1]);
                } } }
        } else {
            bf16* base; int ld, cb;
            if (pn == 2) { base = V; ld = KVW; cb = (wc - 2) * 64 + 8 * fq; }
            else if (pn == 3) { base = U; ld = SGW; cb = 32 * wc + 8 * fq; }
            else if (pn == 4) { base = VS; ld = SGW; cb = 32 * wc + 8 * fq; }
            else { base = P; ld = PLW; cb = 32 * wc + 8 * fq; }
            const int bjs = (pn == 2) ? 32 : HALF;
#pragma unroll
            for (int ai = 0; ai < 2; ++ai)
#pragma unroll
                for (int m = 0; m < 4; ++m) {
                    const int row = row0 + ai * HALF + m * 16; const float rs = r1v[ai * 4 + m];
#pragma unroll
                    for (int bj = 0; bj < 2; ++bj) *(u32x4*)(base + (size_t)row * ld + cb + bj * bjs) = pack8(acc[ai][bj][m][0] * rs, acc[ai][bj][m][1] * rs);
                }
        }
    }
};
struct EpiGate {
    static constexpr int NSTORE = 8;
    static constexpr bool HAS_MID = false, HAS_RS = false, FP8 = true; static constexpr int MID0 = -1, MID1 = -1;
    const float* r1; unsigned char* GATES8;
    DEVI void mid(Acc&, const Unit&, int, int, int, int, int) const {}
    DEVI void operator()(const Acc& acc, const Unit& u, int wr, int wc, int fr, int fq, const float (&rsv)[8]) const {
        asm volatile("" : "+v"(fr), "+v"(fq));
        const int row0 = u.pm * BM + wr * 64 + fr, pn = u.pn;
        float r1v[8];
#pragma unroll
        for (int k = 0; k < 8; ++k) r1v[k] = r1[row0 + (k >> 2) * HALF + (k & 3) * 16];
        {
            unsigned char* gbase = GATES8 + (size_t)(pn >> 2) * 1024 + (pn & 3) * 256 + 64 * wc + 16 * fq;
#pragma unroll
            for (int ai = 0; ai < 2; ++ai)
#pragma unroll
                for (int m = 0; m < 4; ++m) {
                    const int row = row0 + ai * HALF + m * 16; const float rs = r1v[ai * 4 + m] * (-1.4426950408889634f / GSCALE); u32x4 w;
#pragma unroll
                    for (int bj = 0; bj < 2; ++bj)
#pragma unroll
                        for (int n = 0; n < 2; ++n) { unsigned pkd = 0u;
#pragma unroll
                            for (int i = 0; i < 4; ++i) { const float e = __builtin_amdgcn_exp2f(acc[ai][bj][m][n][i] * rs);
                                const float q = fmaxf(__builtin_amdgcn_rcpf(__builtin_fmaf(e, 1.0f / 255.0f, 1.0f / 255.0f)), 1.0f);
                                pkd = __builtin_amdgcn_cvt_pk_u8_f32(q, i, pkd); }
                            w[2 * bj + n] = pkd; }
                    *(u32x4*)(gbase + (size_t)row * GW) = w;
                }
        }
    }
};
struct EpiG2 {
    static constexpr bool HAS_MID = true, HAS_RS = false, FP8 = false; static constexpr int MID0 = 8, MID1 = 12;
    const unsigned char* GATES8; bf16* MERGED;
    DEVI static float ub(unsigned w, int i) { return (float)((w >> (8 * i)) & 0xffu); }
    DEVI void mid(Acc& acc, const Unit& u, int t, int wr, int wc, int fr, int fq) const {
        asm volatile("" : "+v"(fr), "+v"(fq));
        const int row0 = u.pm * BM + wr * 64 + fr; const unsigned char* gp0 = GATES8 + ((t == MID0) ? 0 : 1024) + u.pn * 256 + 64 * wc + 16 * fq;
        u32x4 ga8[8], gb8[8];
#pragma unroll
        for (int k = 0; k < 8; ++k) { const unsigned char* gp = gp0 + (size_t)(row0 + (k >> 2) * HALF + (k & 3) * 16) * GW; ga8[k] = *(const u32x4*)gp; gb8[k] = *(const u32x4*)(gp + 1024); }
        asm volatile("" : "+v"(ga8[0]), "+v"(ga8[1]), "+v"(ga8[2]), "+v"(ga8[3]), "+v"(ga8[4]), "+v"(ga8[5]), "+v"(ga8[6]), "+v"(ga8[7]),
                          "+v"(gb8[0]), "+v"(gb8[1]), "+v"(gb8[2]), "+v"(gb8[3]), "+v"(gb8[4]), "+v"(gb8[5]), "+v"(gb8[6]), "+v"(gb8[7]));
#pragma unroll
        for (int ai = 0; ai < 2; ++ai)
#pragma unroll
            for (int m = 0; m < 4; ++m) { const u32x4 ga = ga8[ai * 4 + m], gb = gb8[ai * 4 + m];
#pragma unroll
                for (int bj = 0; bj < 2; ++bj)
#pragma unroll
                    for (int n = 0; n < 2; ++n)
#pragma unroll
                        for (int i = 0; i < 4; ++i) acc[ai][bj][m][n][i] *= ub(ga[2 * bj + n], i) * __builtin_amdgcn_rcpf(ub(gb[2 * bj + n], i)); }
    }
    DEVI void operator()(const Acc& acc, const Unit& u, int wr, int wc, int fr, int fq, const float (&rsv)[8]) const {
        asm volatile("" : "+v"(fr), "+v"(fq));
        const int row0 = u.pm * BM + wr * 64 + fr, col0 = u.pn * BM + wc * 32 + 8 * fq; const unsigned char* gp0 = GATES8 + 2048 + u.pn * 256 + 64 * wc + 16 * fq;
        u32x4 gc8[8];
#pragma unroll
        for (int k = 0; k < 8; ++k) gc8[k] = *(const u32x4*)(gp0 + (size_t)(row0 + (k >> 2) * HALF + (k & 3) * 16) * GW);
#pragma unroll
        for (int ai = 0; ai < 2; ++ai)
#pragma unroll
            for (int m = 0; m < 4; ++m) { const size_t ro = (size_t)(row0 + ai * HALF + m * 16); const u32x4 gc = gc8[ai * 4 + m];
#pragma unroll
                for (int bj = 0; bj < 2; ++bj) { f32x4 v0 = acc[ai][bj][m][0], v1 = acc[ai][bj][m][1];
#pragma unroll
                    for (int i = 0; i < 4; ++i) { v0[i] *= ub(gc[2 * bj], i) * (1.0f / 255.0f); v1[i] *= ub(gc[2 * bj + 1], i) * (1.0f / 255.0f); }
                    *(u32x4*)(MERGED + ro * D + col0 + bj * HALF) = pack8(v0, v1); } }
    }
};
struct EpiG3 {
    static constexpr bool HAS_MID = false, HAS_RS = false, FP8 = false; static constexpr int MID0 = -1, MID1 = -1;
    bf16* xb; unsigned char* xb8;
    DEVI void mid(Acc&, const Unit&, int, int, int, int, int) const {}
    DEVI void operator()(const Acc& acc, const Unit& u, int wr, int wc, int fr, int fq, const float (&rsv)[8]) const {
        asm volatile("" : "+v"(fr), "+v"(fq));
        const int row0 = u.pm * BM + wr * 64 + fr, col0 = u.pn * BM + wc * 32 + 8 * fq;
        u32x4 xo16[16];
#pragma unroll
        for (int k = 0; k < 16; ++k) xo16[k] = *(const u32x4*)(xb + (size_t)(row0 + (k >> 3) * HALF + ((k >> 1) & 3) * 16) * D + col0 + (k & 1) * HALF);
#pragma unroll
        for (int ai = 0; ai < 2; ++ai)
#pragma unroll
            for (int m = 0; m < 4; ++m) { const size_t ro = (size_t)(row0 + ai * HALF + m * 16) * D + col0;
#pragma unroll
                for (int bj = 0; bj < 2; ++bj) { const size_t o = ro + bj * HALF; const u32x4 xo = xo16[ai * 8 + m * 2 + bj];
                    const f32x4 x0 = (f32x4){bflo(xo[0]), bfhi(xo[0]), bflo(xo[1]), bfhi(xo[1])} + acc[ai][bj][m][0], x1 = (f32x4){bflo(xo[2]), bfhi(xo[2]), bflo(xo[3]), bfhi(xo[3])} + acc[ai][bj][m][1];
                    *(u32x4*)(xb + o) = pack8(x0, x1); u32x2 o8; o8.x = pk4_fp8(x0); o8.y = pk4_fp8(x1); *(u32x2*)(xb8 + o) = o8; } }
    }
};
struct EpiUp {
    static constexpr bool HAS_MID = false, HAS_RS = true, FP8 = true; static constexpr int MID0 = -1, MID1 = -1;
    const float* RSEL; unsigned char* H;
    DEVI void mid(Acc&, const Unit&, int, int, int, int, int) const {}
    DEVI void operator()(const Acc& acc, const Unit& u, int wr, int wc, int fr, int fq, const float (&rsv)[8]) const {
        asm volatile("" : "+v"(fr), "+v"(fq));
        const int slot0 = u.pm * BM + wr * 64 + fr, f0 = (u.pn & 7) * 128 + 32 * wc + 8 * fq;
#pragma unroll
        for (int ai = 0; ai < 2; ++ai)
#pragma unroll
            for (int m = 0; m < 4; ++m) { const int slot = slot0 + ai * HALF + m * 16; const float rs = rsv[ai * 4 + m] * (1.0f / W8SCALE); f32x4 h[2];
#pragma unroll
                for (int n = 0; n < 2; ++n)
#pragma unroll
                    for (int i = 0; i < 4; ++i) { const float a = acc[ai][0][m][n][i] * rs, b = acc[ai][1][m][n][i] * (rs * HSCALE);
                        h[n][i] = __builtin_amdgcn_fmed3f(a * __builtin_amdgcn_rcpf(1.0f + __expf(-a)) * b, -448.f, 448.f); }
                u32x2 o; o.x = pk4_fp8(h[0]); o.y = pk4_fp8(h[1]);
                *(u32x2*)(H + (size_t)slot * FF + f0) = o; }
    }
};
struct EpiDown {
    static constexpr bool HAS_MID = false, HAS_RS = true, FP8 = true; static constexpr int MID0 = -1, MID1 = -1;
    const float* VSEL; bf16* Y;
    DEVI void mid(Acc&, const Unit&, int, int, int, int, int) const {}
    DEVI void operator()(const Acc& acc, const Unit& u, int wr, int wc, int fr, int fq, const float (&rsv)[8]) const {
        asm volatile("" : "+v"(fr), "+v"(fq));
        const int slot0 = u.pm * BM + wr * 64 + fr, col0 = (u.pn & 3) * 256 + 32 * wc + 8 * fq;
#pragma unroll
        for (int ai = 0; ai < 2; ++ai)
#pragma unroll
            for (int m = 0; m < 4; ++m) { const int slot = slot0 + ai * HALF + m * 16; const float vs = rsv[ai * 4 + m] * (1.0f / (HSCALE * W8SCALE));
#pragma unroll
                for (int bj = 0; bj < 2; ++bj) *(u32x4*)(Y + (size_t)slot * D + col0 + bj * HALF) = pack8(acc[ai][bj][m][0] * vs, acc[ai][bj][m][1] * vs); }
    }
};
}

namespace attn_body {
typedef __hip_bfloat16 hbf16;
using s16x4=__attribute__((ext_vector_type(4)))short;
using f32x16=__attribute__((ext_vector_type(16)))float;
constexpr int SEQ=S,HD=64,QP=QW,KP=KVW,OP=1024;
constexpr int NW=8,QBLK=32,QB=QBLK*NW,KVBLK=64,NQB=SEQ/QB;
__device__ __forceinline__ int crow(int r,int hi){return (r&3)+8*(r>>2)+4*hi;}
#define SBAR() __builtin_amdgcn_sched_barrier(0)
constexpr int NSLOT=3, SLOTB=8192;
constexpr int LDS_K=0, LDS_V=NSLOT*SLOTB, LDS_WS=2*NSLOT*SLOTB, LDS_OST=LDS_WS+NW*64*4, LDS_BYTES=LDS_OST+NW*4096;
constexpr float C2=0.125f*1.4426950408889634f;
__device__ __forceinline__ void glds16(const void*gsrc,unsigned lds_dst){unsigned keep;
  asm volatile("s_mov_b32 %0, m0\n\ts_mov_b32 m0, %2\n\ts_nop 0\n\tglobal_load_lds_dwordx4 %1, off\n\ts_mov_b32 m0, %0":"=&s"(keep):"v"(gsrc),"s"(lds_dst):"memory");}
__device__ __forceinline__ float max3f(float a,float b,float c){float r;asm("v_max3_f32 %0, %1, %2, %3":"=v"(r):"v"(a),"v"(b),"v"(c));return r;}
__device__ __forceinline__ float max2f(float a,float b){float r;asm("v_max_f32_e32 %0, %1, %2":"=v"(r):"v"(a),"v"(b));return r;}
__device__ __forceinline__ float fadd_s(float a,float b){float r;asm("v_add_f32_e32 %0, %1, %2":"=v"(r):"v"(a),"v"(b));return r;}
__device__ __forceinline__ float fsub_s(float a,float b){float r;asm("v_sub_f32_e32 %0, %1, %2":"=v"(r):"v"(a),"v"(b));return r;}
typedef float f32x2_t __attribute__((ext_vector_type(2))); typedef __bf16 bf16x2_t __attribute__((ext_vector_type(2)));
__device__ __forceinline__ unsigned cvtpk_s(float lo,float hi){f32x2_t v={lo,hi};bf16x2_t b=__builtin_convertvector(v,bf16x2_t);return __builtin_bit_cast(unsigned,b);}
#define WAIT_BAR(N) asm volatile("s_waitcnt vmcnt(" #N ") lgkmcnt(0)\n\ts_barrier":::"memory")

__device__ __forceinline__ void qkt(f32x16&p0,f32x16&p1,const char*Kslot,const bf16x8*qr,const f32x16&negm,int r32,int hi){
  const char*kb=Kslot+hi*1024+r32*16;
  #pragma unroll
  for(int d0=0;d0<4;++d0){
    const bf16x8 b0=*reinterpret_cast<const bf16x8*>(kb+d0*2048);
    const bf16x8 b1=*reinterpret_cast<const bf16x8*>(kb+d0*2048+512);
    if(d0==0){p0=__builtin_amdgcn_mfma_f32_32x32x16_bf16(b0,qr[0],negm,0,0,0);p1=__builtin_amdgcn_mfma_f32_32x32x16_bf16(b1,qr[0],negm,0,0,0);}
    else{p0=__builtin_amdgcn_mfma_f32_32x32x16_bf16(b0,qr[d0],p0,0,0,0);p1=__builtin_amdgcn_mfma_f32_32x32x16_bf16(b1,qr[d0],p1,0,0,0);}}
}
typedef __attribute__((address_space(3))) const char* lds_cptr;
typedef short v4i16_t __attribute__((ext_vector_type(4)));
__device__ __forceinline__ void kload8(bf16x8*kf,lds_cptr kp){
  kf[0]=*(const __attribute__((address_space(3))) bf16x8*)(kp);      kf[1]=*(const __attribute__((address_space(3))) bf16x8*)(kp+512);
  kf[2]=*(const __attribute__((address_space(3))) bf16x8*)(kp+2048); kf[3]=*(const __attribute__((address_space(3))) bf16x8*)(kp+2560);
  kf[4]=*(const __attribute__((address_space(3))) bf16x8*)(kp+4096); kf[5]=*(const __attribute__((address_space(3))) bf16x8*)(kp+4608);
  kf[6]=*(const __attribute__((address_space(3))) bf16x8*)(kp+6144); kf[7]=*(const __attribute__((address_space(3))) bf16x8*)(kp+6656);
}
__device__ __forceinline__ void kload2(bf16x8*kf,lds_cptr kp,int j){ kf[2*j]=*(const __attribute__((address_space(3))) bf16x8*)(kp+j*2048); kf[2*j+1]=*(const __attribute__((address_space(3))) bf16x8*)(kp+j*2048+512); }
__device__ __forceinline__ s16x4 vtr(lds_cptr p){ return __builtin_bit_cast(s16x4,__builtin_amdgcn_ds_read_tr16_b64_v4i16((__attribute__((address_space(3))) v4i16_t*)p)); }
__device__ __forceinline__ float rowmax(const f32x16&p0,const f32x16&p1){
  float a=max3f(p0[0],p0[1],p1[0]),b=max3f(p0[2],p0[3],p1[1]);a=max3f(a,p1[2],p1[3]);
  #pragma unroll
  for(int r=4;r<16;r+=4){a=max3f(a,p0[r],p0[r+1]);b=max3f(b,p0[r+2],p0[r+3]);a=max3f(a,p1[r],p1[r+1]);b=max3f(b,p1[r+2],p1[r+3]);}
  const float m=max2f(a,b);
  auto rr=__builtin_amdgcn_permlane32_swap(__float_as_uint(m),__float_as_uint(m),false,false);
  return max2f(__uint_as_float(rr[0]),__uint_as_float(rr[1]));
}
__device__ __forceinline__ void pv(f32x16*o,int vb,bf16x8 pa0,bf16x8 pa1,bf16x8 pa2,bf16x8 pa3){
  #pragma unroll
  for(int d0=0;d0<2;++d0){s16x4 lo[4],hi[4];
    #pragma unroll
    for(int ks=0;ks<4;++ks){
      asm volatile("ds_read_b64_tr_b16 %0,%1 offset:%c2":"=&v"(lo[ks]):"v"(vb),"i"(d0*4096+ks*1024):"memory");
      asm volatile("ds_read_b64_tr_b16 %0,%1 offset:%c2":"=&v"(hi[ks]):"v"(vb),"i"(d0*4096+ks*1024+512):"memory");}
    asm volatile("s_waitcnt lgkmcnt(0)":::"memory");SBAR();
    #define PK(k) (bf16x8){lo[k][0],lo[k][1],lo[k][2],lo[k][3],hi[k][0],hi[k][1],hi[k][2],hi[k][3]}
    o[d0]=__builtin_amdgcn_mfma_f32_32x32x16_bf16(pa0,PK(0),o[d0],0,0,0);
    o[d0]=__builtin_amdgcn_mfma_f32_32x32x16_bf16(pa1,PK(1),o[d0],0,0,0);
    o[d0]=__builtin_amdgcn_mfma_f32_32x32x16_bf16(pa2,PK(2),o[d0],0,0,0);
    o[d0]=__builtin_amdgcn_mfma_f32_32x32x16_bf16(pa3,PK(3),o[d0],0,0,0);
    #undef PK
  }
}

#ifndef ATTN_STORE16
#define ATTN_STORE16(p,v) (*(u32x4*)(p)=(v))
#endif
template<int THRL> __device__ __forceinline__ void attn_unit(int b,int h,int qb,const hbf16*Q,const hbf16*__restrict__ K,const hbf16*__restrict__ V,hbf16*O,char*shm,int tid){
  const int lane=tid&63,r32=lane&31,hi=lane>>5; const int wid=__builtin_amdgcn_readfirstlane(tid>>6);
  const long rowbase=(long)b*SEQ; const int q0=qb*QB;
  const hbf16*Qw=Q+(rowbase+q0+wid*QBLK)*QP+h*HD;
  const hbf16*Kh=K+rowbase*KP+(h>>2)*HD,*Vh=V+rowbase*KP+(h>>2)*HD;
  const unsigned lds0=(unsigned)(uintptr_t)shm;
  float*wsf=(float*)(shm+LDS_WS)+wid*64;
  const hbf16*ksrc=Kh+(long)lane*KP+wid*8;
  const hbf16*vsrc=Vh+(long)(16*(wid&3)+(lane>>2))*KP+(wid>>2)*32+(lane&3)*8;
  const unsigned kdst=lds0+LDS_K+wid*1024, vdst=lds0+LDS_V+wid*1024;
  #define DMA_K(t,slot) glds16(ksrc+(long)(t)*KVBLK*KP,(unsigned)__builtin_amdgcn_readfirstlane(kdst+(slot)))
  #define DMA_V(t,slot) glds16(vsrc+(long)(t)*KVBLK*KP,(unsigned)__builtin_amdgcn_readfirstlane(vdst+(slot)))
  const int vb0=(int)(lds0+LDS_V)+((lane>>4)&1)*32+(lane&3)*8+(4*hi+((lane&15)>>2))*64;
  const char*Kbase=shm+LDS_K; bf16x8 kf[8];
  const lds_cptr shm3=(lds_cptr)shm; const lds_cptr kp0=shm3+LDS_K+hi*1024+r32*16; const lds_cptr vp0=shm3+LDS_V+((lane>>4)&1)*32+(lane&3)*8+(4*hi+((lane&15)>>2))*64;
  constexpr int NT=SEQ/KVBLK;
  DMA_K(0,0);DMA_V(0,0);DMA_K(1,SLOTB);
  bf16x8 qr[4];
  #pragma unroll
  for(int d0=0;d0<4;++d0)qr[d0]=*reinterpret_cast<const bf16x8*>(&Qw[(long)r32*QP+d0*16+hi*8]);
  float mhat=0.f,l_reg=0.f;f32x16 o[2],negm;{float z_=0.f;asm volatile("":"+v"(z_));
  _Pragma("unroll") for(int r=0;r<16;++r){o[0][r]=z_;o[1][r]=z_;negm[r]=z_;}}asm volatile("":"+v"(negm));
  #define CMASK(P0,P1,t) do{}while(0)
  bool resc=false;
  #define START(P0,P1) do{ const float rm=rowmax(P0,P1); resc=false; \
    { const float dl=rm; mhat=fadd_s(mhat,dl); \
      _Pragma("unroll") for(int r=0;r<16;++r){P0[r]=fsub_s(P0[r],dl);P1[r]=fsub_s(P1[r],dl);} \
      _Pragma("unroll") for(int r=0;r<16;++r)negm[r]=-mhat; asm volatile("":"+v"(negm)); } \
    _Pragma("unroll") for(int r=0;r<16;++r)P0[r]=__builtin_amdgcn_exp2f(P0[r]); }while(0)
  #define RESC() do{ if(resc){ asm volatile("s_waitcnt lgkmcnt(0)":::"memory"); \
      _Pragma("unroll") for(int d_=0;d_<2;++d_) _Pragma("unroll") for(int r=0;r<16;++r)o[d_][r]*=wsf[crow(r,hi)]; } }while(0)
  f32x16 pA0,pA1,pB0,pB1;
  int sl_prev=0,sl_cur=0,sl_next=SLOTB;
  #define ROT() do{sl_prev=sl_cur;sl_cur=sl_next;sl_next=(sl_next==(NSLOT-1)*SLOTB)?0:sl_next+SLOTB;}while(0)
  DMA_K(2,2*SLOTB);
  WAIT_BAR(3);
  qkt(pA0,pA1,Kbase,qr,negm,r32,hi);asm volatile("s_nop 15\n\ts_nop 7":"+v"(pA0),"+v"(pA1));CMASK(pA0,pA1,0);
  START(pA0,pA1);
  _Pragma("unroll") for(int r=0;r<16;++r)pA1[r]=__builtin_amdgcn_exp2f(pA1[r]);
  WAIT_BAR(0);
  DMA_K(3,0);DMA_V(1,SLOTB);
  ROT();
  kload8(kf,kp0+sl_cur);
  WAIT_BAR(2);
  s16x4 vlo[8],vhi[8]; u32x4 pw0,pw1,pw2,pw3;
  #define PKW(P,B) cvtpk_s(P[B],P[B+1])
  #define PAF(k) __builtin_bit_cast(bf16x8,pw##k)
  #define VFR(i) (bf16x8){vlo[i][0],vlo[i][1],vlo[i][2],vlo[i][3],vhi[i][0],vhi[i][1],vhi[i][2],vhi[i][3]}
  #define PIN(x) asm volatile("":"+v"(x))
  #define MX3(a,b,c) __builtin_fmaxf(__builtin_fmaxf((a),(b)),(c))
  #define GAPA(MF,A0,A1,A2,A3,W0,W1,PW) do{ MF; sacc+=A0; sacc+=A1; sacc+=A2; sacc+=A3; PIN(sacc); W0; W1; PIN(PW); SBAR(); }while(0)
  #define EX(v) __builtin_amdgcn_exp2f(v)
  #define GAPB(MF,X,B) do{ MF; X[B]=EX(X[B]); X[B+1]=EX(X[B+1]); X[B+2]=EX(X[B+2]); X[B+3]=EX(X[B+3]); PIN(X); SBAR(); }while(0)
  #define VRD(i) do{ vlo[i]=vtr(vp_+(((i)>>2)*4096+((i)&3)*1024)); vhi[i]=vtr(vp_+(((i)>>2)*4096+((i)&3)*1024+512)); }while(0)
  #define KRD(G,j) do{ if(G){ kload2(kf,kp0+sl_next,j); SBAR(); } }while(0)
  #define STEP(C0,C1,P0,P1,t,GK,GV,GL) do{ SBAR(); \
    const lds_cptr vp_=vp0+sl_prev; \
    VRD(0); SBAR(); float sacc=(P0[0]+P0[1]); \
    GAPA(C0=__builtin_amdgcn_mfma_f32_32x32x16_bf16(kf[0],qr[0],negm,0,0,0), P0[2],P0[3],P0[4],P0[5],     pw0[0]=PKW(P0,0), pw0[1]=PKW(P0,2), pw0); \
    VRD(4); SBAR(); GAPA(C1=__builtin_amdgcn_mfma_f32_32x32x16_bf16(kf[1],qr[0],negm,0,0,0), P0[6],P0[7],P0[8],P0[9],     pw0[2]=PKW(P0,4), pw0[3]=PKW(P0,6), pw0); \
    VRD(1); SBAR(); GAPA(C0=__builtin_amdgcn_mfma_f32_32x32x16_bf16(kf[2],qr[1],C0,0,0,0),   P0[10],P0[11],P0[12],P0[13], pw1[0]=PKW(P0,8), pw1[1]=PKW(P0,10), pw1); \
    VRD(5); SBAR(); GAPA(C1=__builtin_amdgcn_mfma_f32_32x32x16_bf16(kf[3],qr[1],C1,0,0,0),   P0[14],P0[15],P1[0],P1[1],   pw1[2]=PKW(P0,12),pw1[3]=PKW(P0,14), pw1); \
    VRD(2); SBAR(); GAPA(C0=__builtin_amdgcn_mfma_f32_32x32x16_bf16(kf[4],qr[2],C0,0,0,0),   P1[2],P1[3],P1[4],P1[5],     pw2[0]=PKW(P1,0), pw2[1]=PKW(P1,2), pw2); \
    VRD(6); SBAR(); GAPA(C1=__builtin_amdgcn_mfma_f32_32x32x16_bf16(kf[5],qr[2],C1,0,0,0),   P1[6],P1[7],P1[8],P1[9],     pw2[2]=PKW(P1,4), pw2[3]=PKW(P1,6), pw2); \
    VRD(3); SBAR(); GAPA(C0=__builtin_amdgcn_mfma_f32_32x32x16_bf16(kf[6],qr[3],C0,0,0,0),   P1[10],P1[11],P1[12],P1[13], pw3[0]=PKW(P1,8), pw3[1]=PKW(P1,10), pw3); \
    VRD(7); SBAR(); GAPA(C1=__builtin_amdgcn_mfma_f32_32x32x16_bf16(kf[7],qr[3],C1,0,0,0),   P1[14],P1[15],0.f,0.f,       pw3[2]=PKW(P1,12),pw3[3]=PKW(P1,14), pw3); \
    l_reg+=sacc; \
    if(GK){DMA_K((t)+3,sl_cur);} if(GV){DMA_V((t)+1,sl_next);} \
    CMASK(C0,C1,t); \
    { float a=MX3(C0[0],C0[1],C1[0]),b=MX3(C0[2],C0[3],C1[1]); a=MX3(a,C1[2],C1[3]); \
      _Pragma("unroll") for(int r=4;r<16;r+=4){a=MX3(a,C0[r],C0[r+1]);b=MX3(b,C0[r+2],C0[r+3]);a=MX3(a,C1[r],C1[r+1]);b=MX3(b,C1[r+2],C1[r+3]);} \
      float rm=__builtin_fmaxf(a,b); { auto rr=__builtin_amdgcn_permlane32_swap(__float_as_uint(rm),__float_as_uint(rm),false,false); rm=__builtin_fmaxf(__uint_as_float(rr[0]),__uint_as_float(rr[1])); } \
      resc=false; \
      if(__builtin_expect(__any(rm>(float)THRL),0)){ const float dl=__builtin_fmaxf(rm,0.f); mhat+=dl; \
        _Pragma("unroll") for(int r=0;r<16;++r){C0[r]-=dl;C1[r]-=dl;} \
        _Pragma("unroll") for(int r=0;r<16;++r)negm[r]=-mhat; asm volatile("":"+v"(negm)); \
        const float f=__builtin_amdgcn_exp2f(-dl); l_reg*=f; if(hi==0)wsf[r32]=f; resc=true; } } \
    SBAR(); \
    GAPB(o[0]=__builtin_amdgcn_mfma_f32_32x32x16_bf16(PAF(0),VFR(0),o[0],0,0,0), C0,0); \
    GAPB(o[1]=__builtin_amdgcn_mfma_f32_32x32x16_bf16(PAF(0),VFR(4),o[1],0,0,0), C0,4); \
    KRD(GL,0); GAPB(o[0]=__builtin_amdgcn_mfma_f32_32x32x16_bf16(PAF(1),VFR(1),o[0],0,0,0), C0,8); \
    KRD(GL,1); GAPB(o[1]=__builtin_amdgcn_mfma_f32_32x32x16_bf16(PAF(1),VFR(5),o[1],0,0,0), C0,12); \
    KRD(GL,2); GAPB(o[0]=__builtin_amdgcn_mfma_f32_32x32x16_bf16(PAF(2),VFR(2),o[0],0,0,0), C1,0); \
    KRD(GL,3); GAPB(o[1]=__builtin_amdgcn_mfma_f32_32x32x16_bf16(PAF(2),VFR(6),o[1],0,0,0), C1,4); \
    GAPB(o[0]=__builtin_amdgcn_mfma_f32_32x32x16_bf16(PAF(3),VFR(3),o[0],0,0,0), C1,8); \
    GAPB(o[1]=__builtin_amdgcn_mfma_f32_32x32x16_bf16(PAF(3),VFR(7),o[1],0,0,0), C1,12); \
    }while(0)
  int t=1;
  for(;t+5<NT;t+=2){
    STEP(pB0,pB1,pA0,pA1,t,true,true,true);     WAIT_BAR(2); RESC(); ROT();
    STEP(pA0,pA1,pB0,pB1,t+1,true,true,true);   WAIT_BAR(2); RESC(); ROT();
  }
  #define ENDW(tt) do{ if((tt)+3<NT){WAIT_BAR(2);} else if((tt)+2<NT){WAIT_BAR(1);} else {WAIT_BAR(0);} }while(0)
  for(;t+1<NT;t+=2){
    STEP(pB0,pB1,pA0,pA1,t,(t+3<NT),(t+1<NT),(t+1<NT));       ENDW(t);   RESC(); ROT();
    STEP(pA0,pA1,pB0,pB1,t+1,(t+4<NT),(t+2<NT),(t+2<NT));     ENDW(t+1); RESC(); ROT();
  }
  STEP(pB0,pB1,pA0,pA1,NT-1,false,false,false); RESC();
  { float sacc=pB0[0]+pB0[1]; _Pragma("unroll") for(int r=2;r<16;++r)sacc+=pB0[r]; _Pragma("unroll") for(int r=0;r<16;++r)sacc+=pB1[r]; l_reg+=sacc;
    pw0=(u32x4){PKW(pB0,0),PKW(pB0,2),PKW(pB0,4),PKW(pB0,6)};pw1=(u32x4){PKW(pB0,8),PKW(pB0,10),PKW(pB0,12),PKW(pB0,14)};pw2=(u32x4){PKW(pB1,0),PKW(pB1,2),PKW(pB1,4),PKW(pB1,6)};pw3=(u32x4){PKW(pB1,8),PKW(pB1,10),PKW(pB1,12),PKW(pB1,14)};
    SBAR(); pv(o,vb0+sl_cur,PAF(0),PAF(1),PAF(2),PAF(3)); }
  #undef PKW
  #undef PAF
  #undef VFR
  #undef PIN
  #undef MX3
  #undef GAPA
  #undef GAPB
  #undef EX
  #undef VRD
  #undef KRD
  #undef STEP
  #undef ENDW
  {auto rr=__builtin_amdgcn_permlane32_swap(__float_as_uint(l_reg),__float_as_uint(l_reg),false,false);l_reg=__uint_as_float(rr[0])+__uint_as_float(rr[1]);}
  if(hi==0)wsf[32+r32]=l_reg;asm volatile("s_waitcnt lgkmcnt(0)":::"memory");
  float rli[16];
  #pragma unroll
  for(int r=0;r<16;++r)rli[r]=__builtin_amdgcn_rcpf(wsf[32+crow(r,hi)]);
  hbf16*Ow=O+(rowbase+q0+wid*QBLK)*OP+h*HD;
  { hbf16*stg=(hbf16*)(shm+LDS_OST)+wid*2048;
    #pragma unroll
    for(int r=0;r<16;++r){const int orow=crow(r,hi);
      #pragma unroll
      for(int d0=0;d0<2;++d0)stg[orow*64+d0*32+r32]=__float2bfloat16(o[d0][r]*rli[r]);}
    asm volatile("s_waitcnt lgkmcnt(0)":::"memory");
    #pragma unroll
    for(int i=0;i<4;++i){const int row=i*8+(lane>>3),ch=lane&7; const u32x4 v=*(const u32x4*)(stg+row*64+ch*8); ATTN_STORE16(Ow+(long)row*OP+ch*8,v);} }
  asm volatile("s_waitcnt lgkmcnt(0)\n\ts_barrier":::"memory");
  #undef DMA_K
  #undef DMA_V
  #undef CMASK
  #undef START
  #undef RESC
  #undef ROT
}
constexpr int ATTN_LDS_BYTES=LDS_BYTES;
struct AttnTensors { const hbf16* Q; const hbf16* K; const hbf16* V; hbf16* O; };
template<int THRL=8> __device__ __forceinline__ void attn_phase(char*lds,const AttnTensors&T,int vcu,int G,int tid){
  for(int L=vcu;L<NB*8;L+=G){ const int b=L>>3,h=L&7;
    for(int qb=0;qb<NQB;++qb) attn_unit<THRL>(b,h,qb,T.Q,T.K,T.V,T.O,lds,tid); }
}
#undef SBAR
#undef WAIT_BAR
}


namespace mix {
constexpr int VS_STRIDE = 544, P_STRIDE = 528;
constexpr int VS_OFF = 0, P_OFF = 128 * VS_STRIDE, P_ROWS = 143, LDS_END = P_OFF + P_ROWS * P_STRIDE;
typedef short v4i16_t __attribute__((ext_vector_type(4)));
typedef short s16x4 __attribute__((ext_vector_type(4)));
DEVI s16x4 vtr(const LAS unsigned char* p) { return __builtin_bit_cast(s16x4, __builtin_amdgcn_ds_read_tr16_b64_v4i16((LAS v4i16_t*)p)); }
DEVI void mix_phase(LAS unsigned char* lds, int c0, int cstep, const bf16* VS, const bf16* U, const bf16* P, bf16* ACT, const float* g_sgu, const bf16* WSP, const float* b_sp, const bf16* WPT, int wave, int lane) {
    const int fr = lane & 15, fq = lane >> 4, sg = wave >> 1, ph = wave & 1, tid = wave * 64 + lane;
    bf16x8 wsp[4][4];
    { const bf16* wb = WSP + ((size_t)sg * 128 + 64 * ph + fr) * 128 + 8 * fq;
#pragma unroll
      for (int ks = 0; ks < 4; ++ks)
#pragma unroll
          for (int pb = 0; pb < 4; ++pb) wsp[ks][pb] = *(const bf16x8*)(wb + (size_t)16 * pb * 128 + 32 * ks); }
    const f32x4 gs = *(const f32x4*)(g_sgu + 4 * lane);
    float bias4[4];
#pragma unroll
    for (int pb = 0; pb < 4; ++pb) bias4[pb] = b_sp[sg * 128 + 64 * ph + 16 * pb + fr];
    for (int chunk = c0; chunk < M / 128; chunk += cstep) {
        const size_t row0 = (size_t)chunk * 128; const int tpos0 = (chunk & 15) * 128;
#pragma unroll 1
        for (int h8 = 0; h8 < 2; ++h8) { u32x2 w[8];
#pragma unroll
            for (int i = 0; i < 8; ++i) w[i] = *(const u32x2*)(VS + (row0 + wave * 16 + h8 * 8 + i) * SGW + 4 * lane);
#pragma unroll
            for (int i = 0; i < 8; ++i) { const float v0 = bflo(w[i].x), v1 = bfhi(w[i].x), v2 = bflo(w[i].y), v3 = bfhi(w[i].y);
                const float ss = wave_sum(v0 * v0 + v1 * v1 + v2 * v2 + v3 * v3); const float r = __builtin_amdgcn_rsqf(ss * (1.0f / SGW) + EPS);
                u32x2 o; o.x = pk2(v0 * r * gs[0], v1 * r * gs[1]); o.y = pk2(v2 * r * gs[2], v3 * r * gs[3]);
                *(LAS u32x2*)(lds + VS_OFF + (wave * 16 + h8 * 8 + i) * VS_STRIDE + 8 * lane) = o; } }
#pragma unroll 1
        for (int bt = 0; bt < 3; ++bt) { u32x4 pv[3];
#pragma unroll
            for (int it = 0; it < 3; ++it) { const int pc = tid + (bt * 3 + it) * 512, j = pc >> 5, c = pc & 31, tp = tpos0 - 8 + j;
                pv[it] = (u32x4){0u, 0u, 0u, 0u}; if (pc < P_ROWS * 32 && tp >= 0 && tp < S) pv[it] = *(const u32x4*)(P + ((long)row0 - 8 + j) * PLW + 8 * c); }
#pragma unroll
            for (int it = 0; it < 3; ++it) { const int pc = tid + (bt * 3 + it) * 512; if (pc < P_ROWS * 32) *(LAS u32x4*)(lds + P_OFF + (pc >> 5) * P_STRIDE + 16 * (pc & 31)) = pv[it]; } }
        u32x2 uw[4][4];
        { const unsigned uo = (unsigned)(((unsigned)row0 + 64 * ph + fr) * SGW + 64 * sg + 4 * fq) * 2u;
#pragma unroll
          for (int pb = 0; pb < 4; ++pb)
#pragma unroll
              for (int cb = 0; cb < 4; ++cb) uw[pb][cb] = *(const u32x2*)((const char*)U + (uo + (unsigned)(16 * pb * SGW + 16 * cb) * 2u)); }
        LDS_WAIT(); __syncthreads();
        { f32x4 acc[4][4];
#pragma unroll
          for (int a = 0; a < 4; ++a)
#pragma unroll
              for (int b = 0; b < 4; ++b) acc[a][b] = (f32x4){0.f, 0.f, 0.f, 0.f};
          const LAS unsigned char* abase = lds + VS_OFF + (8 * fq + (fr >> 2)) * VS_STRIDE + (64 * sg + 4 * (fr & 3)) * 2;
#pragma unroll
          for (int ks = 0; ks < 4; ++ks) {
              bf16x8 af[4];
#pragma unroll
              for (int cb = 0; cb < 4; ++cb) { const s16x4 lo = vtr(abase + 32 * ks * VS_STRIDE + 32 * cb), hi = vtr(abase + (32 * ks + 4) * VS_STRIDE + 32 * cb);
                  af[cb] = (bf16x8){lo[0], lo[1], lo[2], lo[3], hi[0], hi[1], hi[2], hi[3]}; }
#pragma unroll
              for (int cb = 0; cb < 4; ++cb)
#pragma unroll
                  for (int pb = 0; pb < 4; ++pb) acc[cb][pb] = __builtin_amdgcn_mfma_f32_16x16x32_bf16(af[cb], wsp[ks][pb], acc[cb][pb], 0, 0, 0);
          }
#pragma unroll
          for (int pb = 0; pb < 4; ++pb) { const int p = 64 * ph + 16 * pb + fr; const float bias = bias4[pb];
#pragma unroll
              for (int cb = 0; cb < 4; ++cb) { const int ch = 64 * sg + 16 * cb + 4 * fq; const u32x2 u2 = uw[pb][cb];
                  u32x2 o; o.x = pk2(bflo(u2.x) * (acc[cb][pb][0] + bias), bfhi(u2.x) * (acc[cb][pb][1] + bias)); o.y = pk2(bflo(u2.y) * (acc[cb][pb][2] + bias), bfhi(u2.y) * (acc[cb][pb][3] + bias));
                  *(u32x2*)((char*)ACT + (unsigned)((((unsigned)row0 + p) * 1024 + 512 + ch) * 2u)) = o; } } }
        { const int t = 16 * wave + fr, tp = tpos0 + t;
#pragma unroll 1
          for (int g = 0; g < 4; ++g) { const int wd = 2 << g, lo_off = wd >> 1, hi_off = wd - 1 - lo_off;
              bf16x8 wf[2][4];
#pragma unroll
              for (int ks = 0; ks < 2; ++ks)
#pragma unroll
                  for (int db = 0; db < 4; ++db) wf[ks][db] = *(const bf16x8*)(WPT + ((size_t)g * 64 + 16 * db + fr) * 64 + 32 * ks + 8 * fq);
              int lo = tp - lo_off; if (lo < 0) lo = 0; int hi = tp + hi_off; if (hi > S - 1) hi = S - 1; const float icnt = 1.0f / (float)(hi - lo + 1);
              f32x4 acc[4];
#pragma unroll
              for (int a = 0; a < 4; ++a) acc[a] = (f32x4){0.f, 0.f, 0.f, 0.f};
#pragma unroll
              for (int ks = 0; ks < 2; ++ks) { const LAS unsigned char* pb_ = lds + P_OFF + (64 * g + 32 * ks + 8 * fq) * 2;
                  float sum[8];
#pragma unroll
                  for (int i = 0; i < 8; ++i) sum[i] = 0.f;
#pragma unroll 1
                  for (int j = -lo_off; j <= hi_off; ++j) { const u32x4 v = *(const LAS u32x4*)(pb_ + (t + 8 + j) * P_STRIDE);
                      sum[0] += bflo(v[0]); sum[1] += bfhi(v[0]); sum[2] += bflo(v[1]); sum[3] += bfhi(v[1]); sum[4] += bflo(v[2]); sum[5] += bfhi(v[2]); sum[6] += bflo(v[3]); sum[7] += bfhi(v[3]); }
                  const u32x4 c0 = *(const LAS u32x4*)(pb_ + (t + 8) * P_STRIDE);
                  u32x4 dw; dw[0] = pk2(sum[0] * icnt - bflo(c0[0]), sum[1] * icnt - bfhi(c0[0])); dw[1] = pk2(sum[2] * icnt - bflo(c0[1]), sum[3] * icnt - bfhi(c0[1]));
                  dw[2] = pk2(sum[4] * icnt - bflo(c0[2]), sum[5] * icnt - bfhi(c0[2])); dw[3] = pk2(sum[6] * icnt - bflo(c0[3]), sum[7] * icnt - bfhi(c0[3]));
                  const bf16x8 dfr = __builtin_bit_cast(bf16x8, dw);
#pragma unroll
                  for (int db = 0; db < 4; ++db) acc[db] = __builtin_amdgcn_mfma_f32_16x16x32_bf16(wf[ks][db], dfr, acc[db], 0, 0, 0); }
#pragma unroll
              for (int db = 0; db < 4; ++db) { u32x2 o; o.x = pk2(acc[db][0], acc[db][1]); o.y = pk2(acc[db][2], acc[db][3]);
                  *(u32x2*)((char*)ACT + (unsigned)((((unsigned)row0 + t) * 1024 + 768 + 64 * g + 16 * db + 4 * fq) * 2u)) = o; } } }
        LDS_WAIT(); __syncthreads();
    }
}
}

#define XB_TMO      128
#define XB_XCNT(j)  (256  + 64 * (j))
#define XB_XSUB(j)  (1280 + 64 * (j))
#define XB_XGEN(j)  (2304 + 64 * (j))
#define XB_TOP      3328
#define XB_TOPGEN   3392
#define XCD_BAR_WORDS 3456
#define XB_SPIN_CAP (1u << 21)
DEVI unsigned xb_ld(unsigned* p)              { return __hip_atomic_load(p, __ATOMIC_RELAXED, __HIP_MEMORY_SCOPE_AGENT); }
DEVI unsigned xb_add(unsigned* p, unsigned v) { return __hip_atomic_fetch_add(p, v, __ATOMIC_RELAXED, __HIP_MEMORY_SCOPE_AGENT); }
DEVI unsigned xb_xcc_id() { return (unsigned)__builtin_amdgcn_s_getreg((3 << 11) | 20) & 0xFu; }
#define XB_SPIN(cond, bar) do { unsigned _sp = 0; while (cond) { __builtin_amdgcn_s_sleep(1); \
    if ((++_sp & 255u) == 0u) { if (xb_ld(&(bar)[XB_TMO])) break; if (_sp > XB_SPIN_CAP) { atomicAdd(&(bar)[XB_TMO], 1u); break; } } } } while (0)
struct XcdBarrier { unsigned* bar; unsigned x; volatile LAS unsigned* st; };
DEVI XcdBarrier xcd_barrier_post(unsigned* bar, volatile LAS unsigned* st) {
    XcdBarrier b; b.bar = bar; b.x = xb_xcc_id(); b.st = st;
    if (threadIdx.x == 0) (void)xb_add(&bar[XB_XCNT(b.x)], 1u);
    return b;
}
DEVI void xcd_barrier_complete(unsigned* bar, unsigned x, unsigned& nloc, unsigned& nx) {
    const unsigned G = gridDim.x * gridDim.y * gridDim.z;
    unsigned sum, cnt, mine, sp = 0u;
    for (;;) {
        sum = 0u; cnt = 0u; mine = 0u;
#pragma unroll
        for (unsigned j = 0; j < 16; ++j) { const unsigned c = xb_ld(&bar[XB_XCNT(j)]); sum += c; cnt += (c > 0u) ? 1u : 0u; mine = (j == x) ? c : mine; }
        if (sum == G) break;
        __builtin_amdgcn_s_sleep(1);
        if ((++sp & 255u) == 0u) { if (xb_ld(&bar[XB_TMO])) break; if (sp > XB_SPIN_CAP) { atomicAdd(&bar[XB_TMO], 1u); break; } }
    }
    nloc = mine > 0u ? mine : 1u; nx = cnt > 0u ? cnt : 1u;
}
DEVI void xcd_barrier(const XcdBarrier& b, int tid) {
    asm volatile("s_waitcnt vmcnt(0)" ::: "memory");
    __syncthreads();
    if (tid == 0) {
        unsigned* bar = b.bar; unsigned bx = b.x;
        asm volatile("" : "+s"(bar), "+s"(bx));
        __builtin_amdgcn_s_waitcnt(0);
        unsigned nloc = b.st[0], nx = b.st[1];
        if (nloc == 0u) { xcd_barrier_complete(bar, bx, nloc, nx); b.st[0] = nloc; b.st[1] = nx; }
        const unsigned old = xb_add(&bar[XB_XSUB(bx)], 1u);
        const unsigned gen = old / nloc;
        if (old + 1u == (gen + 1u) * nloc) {
            __builtin_amdgcn_fence(__ATOMIC_RELEASE, "agent");
            asm volatile("s_waitcnt vmcnt(0)" ::: "memory");
            const unsigned og = xb_add(&bar[XB_TOP], 1u);
            const unsigned tg = og / nx;
            if (og + 1u == (tg + 1u) * nx) xb_add(&bar[XB_TOPGEN], 1u);
            else XB_SPIN(xb_ld(&bar[XB_TOPGEN]) == tg, bar);
            __builtin_amdgcn_fence(__ATOMIC_ACQUIRE, "agent");
            xb_add(&bar[XB_XGEN(bx)], 1u);
            asm volatile("s_waitcnt vmcnt(0)" ::: "memory");
        } else {
            XB_SPIN(xb_ld(&bar[XB_XGEN(bx)]) == gen, bar);
            __builtin_amdgcn_fence(__ATOMIC_ACQUIRE, "agent");
            asm volatile("s_waitcnt vmcnt(0)" ::: "memory");
        }
    }
    __syncthreads();
}

constexpr int RING_BYTES = 131072;
constexpr int MISC_OFF = 147456, LDS_BYTES = 147456 + 512;
constexpr int CW_BAR = 4096;
static_assert((CW_BAR + XCD_BAR_WORDS) * 4 <= (int)MiB, "ctl");

struct MkArgs {
    const float* in[20]; float* out; unsigned char* ws;
    int ph_lo, ph_hi, sub, mode;
};
typedef const __attribute__((address_space(4))) MkArgs* KArgs;
#define KARGS() ({ KArgs _p = (KArgs)__builtin_amdgcn_kernarg_segment_ptr(); asm volatile("" : "+s"(_p)); _p; })
struct ConvHook {
    int at, l, gw, ngw;
    struct Item { const float* src; const float* ks; unsigned char* out; };
    DEVI static Item decode(int it, int lane, const float* wg, const float* wu, const float* wd, const float* gf, unsigned char* ws) {
        constexpr int I_UP = NE * 64 * 8; Item t; const int r = lane >> 3, j = lane & 7;
        if (it < I_UP) { const int e = it >> 9, q = it & 511, kb = q >> 6, nb = q & 63;
            t.src = ((nb >> 2) & 1 ? wu : wg) + (size_t)e * D * FF + (size_t)(kb * 128 + 16 * j) * FF + (nb >> 3) * 128 + (nb & 3) * 32 + r; t.ks = gf + kb * 128 + 16 * j;
            t.out = ws + WS_WUP + ((size_t)e * 2048 + nb * 32 + r) * D + kb * 128 + 16 * j; }
        else { const int rr = it - I_UP, e = rr >> 8, q = rr & 255, kb = q >> 5, nb = q & 31;
            t.src = wd + (size_t)e * FF * D + (size_t)(kb * 128 + 16 * j) * D + nb * 32 + r; t.ks = nullptr;
            t.out = ws + WS_WDN + ((size_t)e * 1024 + nb * 32 + r) * FF + kb * 128 + 16 * j; }
        return t;
    }
    DEVI static void load(const Item& t, float (&v)[4][16], f32x4 (&g)[4]) {
#pragma unroll
        for (int c = 0; c < 4; ++c)
#pragma unroll
            for (int i = 0; i < 16; ++i) v[c][i] = t.src[i * 1024 + 8 * c];
        if (t.ks) {
#pragma unroll
            for (int q = 0; q < 4; ++q) g[q] = *(const f32x4*)(t.ks + 4 * q); }
        else {
#pragma unroll
            for (int q = 0; q < 4; ++q) g[q] = (f32x4){1.f, 1.f, 1.f, 1.f}; }
    }
    DEVI static void store(const Item& t, float (&v)[4][16], f32x4 (&g)[4]) {
#pragma unroll
        for (int c = 0; c < 4; ++c) { u32x4 o;
#pragma unroll
            for (int q = 0; q < 4; ++q) { f32x4 x; x[0] = v[c][4 * q] * (g[q][0] * W8SCALE); x[1] = v[c][4 * q + 1] * (g[q][1] * W8SCALE); x[2] = v[c][4 * q + 2] * (g[q][2] * W8SCALE); x[3] = v[c][4 * q + 3] * (g[q][3] * W8SCALE); o[q] = pk4_fp8(x); }
            *(u32x4*)(t.out + (size_t)8 * c * 1024) = o; }
    }
    DEVI void operator()(int ui) const {
        if (ui != at) return;
        KArgs ka = KARGS(); unsigned char* ws = ka->ws; const int lane = lane_id_v();
        const float* wg = ka->in[16] + (size_t)l * NE * D * FF; const float* wu = ka->in[17] + (size_t)l * NE * D * FF; const float* wd = ka->in[18] + (size_t)l * NE * FF * D;
        const float* gf = ka->in[14] + l * D;
        constexpr int I_ALL = NE * 64 * 8 + NE * 32 * 8;
        if (ngw * 6 == I_ALL) {
            float va[4][16], vb[4][16]; f32x4 ga[4], gb[4];
            const Item t0 = decode(gw, lane, wg, wu, wd, gf, ws), t1 = decode(gw + ngw, lane, wg, wu, wd, gf, ws);
            load(t0, va, ga); load(t1, vb, gb);
            const Item t2 = decode(gw + 2 * ngw, lane, wg, wu, wd, gf, ws); store(t0, va, ga); load(t2, va, ga);
            const Item t3 = decode(gw + 3 * ngw, lane, wg, wu, wd, gf, ws); store(t1, vb, gb); load(t3, vb, gb);
            const Item t4 = decode(gw + 4 * ngw, lane, wg, wu, wd, gf, ws); store(t2, va, ga); load(t4, va, ga);
            const Item t5 = decode(gw + 5 * ngw, lane, wg, wu, wd, gf, ws); store(t3, vb, gb); load(t5, vb, gb);
            store(t4, va, ga); store(t5, vb, gb);
        } else {
            float va[4][16]; f32x4 ga[4];
            for (int it = gw; it < I_ALL; it += ngw) { const Item t = decode(it, lane, wg, wu, wd, gf, ws); load(t, va, ga); store(t, va, ga); }
        }
    }
};

constexpr int PH_PER_LAYER = 9, PH_TOTAL = 1 + DEPTH * PH_PER_LAYER;

DEVI void tr_item(const float* src, int ld, int col, const float* kscale, bf16* out0, int ldo, int k0, LAS float* scr, int lane) {
#pragma unroll 8
    for (int i = 0; i < 32; ++i) { const int kk = 2 * i + (lane >> 5); float v = src[(size_t)(k0 + kk) * ld + col]; if (kscale) v *= kscale[k0 + kk]; scr[kk * 33 + (lane & 31)] = v; }
    LDS_WAIT(); asm volatile("" ::: "memory");
    const int c = lane & 7;
#pragma unroll
    for (int j = 0; j < 4; ++j) { const int n = (lane >> 3) + 8 * j; const LAS float* s = scr + (8 * c) * 33 + n;
        u32x4 o; o.x = pk2(s[0 * 33], s[1 * 33]); o.y = pk2(s[2 * 33], s[3 * 33]); o.z = pk2(s[4 * 33], s[5 * 33]); o.w = pk2(s[6 * 33], s[7 * 33]);
        *(u32x4*)(out0 + (size_t)n * ldo + 8 * c) = o; }
    LDS_WAIT(); asm volatile("" ::: "memory");
}


#ifndef REP_G1
#define REP_G1 1
#endif
#ifndef REP_CONV
#define REP_CONV 1
#endif
#ifndef REP_ATTN
#define REP_ATTN 1
#endif
#ifndef REP_MIX
#define REP_MIX 1
#endif
#ifndef REP_G2
#define REP_G2 1
#endif
#ifndef REP_G3L0
#define REP_G3L0 1
#endif
#ifndef REP_ROUTER
#define REP_ROUTER 1
#endif
#ifndef REP_TOPK
#define REP_TOPK 1
#endif
#ifndef REP_UP
#define REP_UP 1
#endif
#ifndef REP_DOWN
#define REP_DOWN 1
#endif
DEVI void tr_item8(const float* src, int ld, int col, const float* kscale, unsigned char* out0, int ldo, int k0, LAS float* scr, int lane) {
#pragma unroll 8
    for (int i = 0; i < 32; ++i) { const int kk = 2 * i + (lane >> 5); scr[kk * 33 + (lane & 31)] = src[(size_t)(k0 + kk) * ld + col] * kscale[k0 + kk] * GSCALE; }
    LDS_WAIT(); asm volatile("" ::: "memory");
    const int c = lane & 7;
#pragma unroll
    for (int j = 0; j < 4; ++j) { const int n = (lane >> 3) + 8 * j; const LAS float* s = scr + (8 * c) * 33 + n;
        int lo = 0, hi = 0; lo = __builtin_amdgcn_cvt_pk_fp8_f32(s[0 * 33], s[1 * 33], lo, false); lo = __builtin_amdgcn_cvt_pk_fp8_f32(s[2 * 33], s[3 * 33], lo, true);
        hi = __builtin_amdgcn_cvt_pk_fp8_f32(s[4 * 33], s[5 * 33], hi, false); hi = __builtin_amdgcn_cvt_pk_fp8_f32(s[6 * 33], s[7 * 33], hi, true);
        u32x2 o; o.x = (unsigned)lo; o.y = (unsigned)hi; *(u32x2*)(out0 + (size_t)n * ldo + 8 * c) = o; }
    LDS_WAIT(); asm volatile("" ::: "memory");
}
__global__ void __launch_bounds__(NWAVES * 64, 2) mk_fwd(MkArgs args) {
    extern __shared__ __attribute__((aligned(16))) unsigned char lds_raw[];
    LAS unsigned char* lds = (LAS unsigned char*)lds_raw;
    volatile LAS unsigned* MISC = (volatile LAS unsigned*)(lds + MISC_OFF);
    const int wave = __builtin_amdgcn_readfirstlane((int)threadIdx.x >> 6);
    const int G = gridDim.x; const int vcu = (G % 8 == 0) ? ((int)blockIdx.x % 8) * (G / 8) + (int)blockIdx.x / 8 : (int)blockIdx.x;
    gu32* ctl; { KArgs ka0 = KARGS(); ctl = (gu32*)(ka0->ws + WS_CTL); }
    { const int t0 = wave * 64 + lane_id_v(); if (t0 < 128) MISC[t0] = 0u; }
    __syncthreads();
    int lo, hi; { KArgs ka0 = KARGS(); lo = ka0->ph_lo; hi = ka0->ph_hi; }
    const bool use_bar = (hi - lo) > 1;
    XcdBarrier bar; bar.bar = (unsigned*)(ctl + CW_BAR); bar.x = 0; bar.st = nullptr;
    if (use_bar) bar = xcd_barrier_post((unsigned*)(ctl + CW_BAR), MISC + 8);
#define IN(k) (lo <= (k) && (k) < hi)
#define LAUNDER_BX() int bx = (int)blockIdx.x; asm volatile("" : "+s"(bx))
#define SEAM(k) do { if (IN(k) && IN((k) + 1)) xcd_barrier(bar, wave * 64 + lane_id_v()); } while (0)
    const int NGW = G * NWAVES;
    if (IN(0)) {
            KArgs ka = KARGS(); unsigned char* ws = ka->ws;
        const int lane = lane_id_v(), tid = wave * 64 + lane, gw = vcu * NWAVES + wave;
        LAS float* scr = (LAS float*)(lds + wave * 16384);
        { const int i = blockIdx.x * 512 + tid; if (i < 64 * 16) { const int pos = i >> 4, f = i & 15; const float freq = powf(10000.0f, -(float)(2 * f) / 32.0f); const float ang = (float)pos * freq;
            ((float*)(ws + WS_ROPE))[2 * i] = cosf(ang); ((float*)(ws + WS_ROPE))[2 * i + 1] = sinf(ang); } }
        constexpr int I_W1 = 16 * 48, I_G8 = 16 * 96, I_A = 8 * 32, I_B = 4 * 32, I_C = 4 * 32, I_W3 = 16 * 32, I_L = I_W1 + I_G8 + I_A + I_B + I_C + I_W3;
        for (int it = gw; it < DEPTH * I_L; it += NGW) {
            const int l = it / I_L; int r = it % I_L;
            bf16* w1t = (bf16*)(ws + WS_W1T) + (size_t)l * INW * D; bf16* w2t = (bf16*)(ws + WS_W2T) + (size_t)l * D * D; bf16* w3t = (bf16*)(ws + WS_W3T) + (size_t)l * D * D;
            if (r < I_W1) { const int kb = r % 16, nb = r / 16, n0 = nb * 32; tr_item(ka->in[2] + (size_t)l * D * INW, INW, g1_logical(n0 + (lane & 31)), ka->in[1] + l * D, w1t + (size_t)n0 * D + kb * 64, D, kb * 64, scr, lane); continue; } r -= I_W1;
            if (r < I_G8) { const int kb = r % 16, nb = r / 16, n0 = nb * 32; tr_item8(ka->in[2] + (size_t)l * D * INW, INW, 1536 + n0 + (lane & 31), ka->in[1] + l * D, (unsigned char*)(ws + WS_W1T + (size_t)l * INW * D * 2 + WS_W1G8_OFF) + (size_t)n0 * D + kb * 64, D, kb * 64, scr, lane); continue; } r -= I_G8;
            if (r < I_A) { const int kb = r % 8, n0 = (r / 8) * 32; tr_item(ka->in[10] + (size_t)l * QW * D, D, n0 + (lane & 31), nullptr, w2t + (size_t)n0 * D + kb * 64, D, kb * 64, scr, lane); continue; } r -= I_A;
            if (r < I_B) { const int kb = r % 4, n0 = (r / 4) * 32; tr_item(ka->in[11] + (size_t)l * SGW * D, D, n0 + (lane & 31), nullptr, w2t + (size_t)n0 * D + 512 + kb * 64, D, kb * 64, scr, lane); continue; } r -= I_B;
            if (r < I_C) { const int kb = r % 4, n0 = (r / 4) * 32; tr_item(ka->in[12] + (size_t)l * PLW * D, D, n0 + (lane & 31), nullptr, w2t + (size_t)n0 * D + 768 + kb * 64, D, kb * 64, scr, lane); continue; } r -= I_C;
            { const int kb = r % 16, n0 = (r / 16) * 32; tr_item(ka->in[13] + (size_t)l * D * D, D, n0 + (lane & 31), nullptr, w3t + (size_t)n0 * D + kb * 64, D, kb * 64, scr, lane); }
        }
        { bf16* WSPo = (bf16*)(ws + WS_WSP); bf16* WPTo = (bf16*)(ws + WS_WPT);
          for (int i = (int)blockIdx.x * 512 + tid; i < DEPTH * 4 * 128 * 128; i += G * 512) WSPo[i] = (bf16)f2bf(ka->in[6][i]);
          for (int i = (int)blockIdx.x * 512 + tid; i < DEPTH * 4 * 64 * 64; i += G * 512) { const int c = i & 63, dd = (i >> 6) & 63, lg = i >> 12;
              WPTo[i] = (bf16)f2bf(ka->in[8][((size_t)lg * 64 + c) * 64 + dd] * ka->in[9][lg * 64 + dd]); } }
        { bf16* WRTo = (bf16*)(ws + WS_WRT);
          for (int i = (int)blockIdx.x * 512 + tid; i < DEPTH * NE * D; i += G * 512) { const int k = i & (D - 1), e = (i >> 10) & 15, ll = i >> 14;
              const float w = ka->in[14][ll * D + k] * ka->in[15][((size_t)ll * D + k) * NE + e]; const unsigned hi = f2bf(w); const float rem = w - __builtin_bit_cast(float, hi << 16);
              WRTo[((size_t)ll * 2 * NE + e) * D + k] = (bf16)hi; WRTo[((size_t)ll * 2 * NE + NE + e) * D + k] = (bf16)f2bf(rem); } }
        for (int m = gw; m < M; m += 2 * NGW) {
            const int m2 = m + NGW; const bool has2 = m2 < M;
            const f32x4* xr = (const f32x4*)((ka->in[0]) + (size_t)m * D) + lane; const f32x4* xr2 = (const f32x4*)((ka->in[0]) + (size_t)(has2 ? m2 : m) * D) + lane; f32x4 v[4], v2[4]; float s = 0.f, s2 = 0.f;
#pragma unroll
            for (int j = 0; j < 4; ++j) { v[j] = xr[64 * j]; v2[j] = xr2[64 * j]; }
#pragma unroll
            for (int j = 0; j < 4; ++j) { s += v[j].x * v[j].x + v[j].y * v[j].y + v[j].z * v[j].z + v[j].w * v[j].w; s2 += v2[j].x * v2[j].x + v2[j].y * v2[j].y + v2[j].z * v2[j].z + v2[j].w * v2[j].w; }
            s = wave_sum(s); s2 = wave_sum(s2);
            u32x2* o = (u32x2*)(((bf16*)(ws + WS_XB)) + (size_t)m * D) + lane; u32x2* o2 = (u32x2*)(((bf16*)(ws + WS_XB)) + (size_t)m2 * D) + lane;
#pragma unroll
            for (int j = 0; j < 4; ++j) { u32x2 w; w.x = pk2(v[j].x, v[j].y); w.y = pk2(v[j].z, v[j].w); o[64 * j] = w; if (has2) { u32x2 w2; w2.x = pk2(v2[j].x, v2[j].y); w2.y = pk2(v2[j].z, v2[j].w); o2[64 * j] = w2; } }
            { unsigned* o8 = (unsigned*)(ws + WS_XB8 + (size_t)m * D) + lane; unsigned* o82 = (unsigned*)(ws + WS_XB8 + (size_t)m2 * D) + lane;
#pragma unroll
              for (int j = 0; j < 4; ++j) { o8[64 * j] = pk4_fp8(v[j]); if (has2) o82[64 * j] = pk4_fp8(v2[j]); } }
            if (lane == 0) { ((float*)(ws + WS_R1))[m] = 1.0f / sqrtf(s * (1.0f / D) + EPS); if (has2) ((float*)(ws + WS_R1))[m2] = 1.0f / sqrtf(s2 * (1.0f / D) + EPS); }
        }
    }
    SEAM(0);

    for (int l = 0; l < DEPTH; ++l) {
        const int pb = 1 + l * PH_PER_LAYER;
#ifndef NO_G1
        for (int rr_ = 0; rr_ < REP_G1; ++rr_)
        if (IN(pb + 0)) {
            { KArgs ka = KARGS(); unsigned char* ws = ka->ws;
              LAUNDER_BX(); pg8::Gemm g{((bf16*)(ws + WS_XB)), ((const bf16*)(ws + WS_W1T) + (size_t)l * INW * D), D}; pg8::StaticOrder So; So.init(M, QW + 2 * KVW + 2 * SGW + PLW, G, bx);
              pg8::EpiG1 E{((float*)(ws + WS_R1)), ((float*)(ws + WS_ROPE)), ka->in[3] + l * 64, ka->in[4] + l * 64, ((bf16*)(ws + WS_Q)), ((bf16*)(ws + WS_K)), ((bf16*)(ws + WS_V)), ((bf16*)(ws + WS_U)), ((bf16*)(ws + WS_VS)), ((bf16*)(ws + WS_P))};
              const int n_u = (256 * 6 - bx + G - 1) / G;
              const ConvHook CH{(ka->mode & 16) ? -1 : ((vcu & 7) % (n_u > 0 ? n_u : 1)), l, vcu * NWAVES + wave, NGW};
              pg8::gemm_phase<pg8::EpiG1, pg8::StaticOrder, false, ConvHook>(lds, g, So, E, nullptr, wave * 64 + lane_id_v(), ka->mode, CH); }
            { KArgs ka = KARGS(); unsigned char* ws = ka->ws;
              LAUNDER_BX();
              pg8::Gemm g{((const bf16*)(ws + WS_XB8)), ((const bf16*)(ws + WS_W1T + (size_t)l * INW * D * 2 + WS_W1G8_OFF)), D / 2}; pg8::StaticOrder So; So.init(M, GW, G, bx);
              pg8::EpiGate E{((float*)(ws + WS_R1)), (unsigned char*)(ws + WS_GATES)};
              pg8::gemm_phase<pg8::EpiGate, pg8::StaticOrder, false>(lds, g, So, E, nullptr, wave * 64 + lane_id_v(), ka->mode); }
        }
#endif
        SEAM(pb + 0);
        if (IN(pb + 1)) {
            KArgs ka = KARGS(); unsigned char* ws = ka->ws;
#ifndef NO_ATTN
            for (int rr_ = 0; rr_ < REP_ATTN; ++rr_)
            if (ka->sub & 2) {
                const int tl = wave * 64 + lane_id_v();
                const attn_body::AttnTensors AT{(const attn_body::hbf16*)((bf16*)(ws + WS_Q)), (const attn_body::hbf16*)((bf16*)(ws + WS_K)), (const attn_body::hbf16*)((bf16*)(ws + WS_V)), (attn_body::hbf16*)((bf16*)(ws + WS_ACT))};
                int vl = vcu; asm volatile("" : "+s"(vl));
                attn_body::attn_phase<8>((char*)lds_raw, AT, vl, G, tl);
            }
#endif
#ifndef NO_MIX
            for (int rr_ = 0; rr_ < REP_MIX; ++rr_)
            if (ka->sub & 4) {
                const int lane = lane_id_v(); int vl = vcu; asm volatile("" : "+s"(vl));
                const bf16* WSP = (const bf16*)(ws + WS_WSP) + (size_t)l * 4 * 128 * 128; const bf16* WPT = (const bf16*)(ws + WS_WPT) + (size_t)l * 4 * 64 * 64;
                mix::mix_phase(lds, vl, G, ((bf16*)(ws + WS_VS)), ((bf16*)(ws + WS_U)), ((bf16*)(ws + WS_P)), ((bf16*)(ws + WS_ACT)), ka->in[5] + l * SGW, WSP, ka->in[7] + l * 4 * 128, WPT, wave, lane);
            }
#endif
        }
        SEAM(pb + 1);
#ifndef NO_G2
        for (int rr_ = 0; rr_ < REP_G2; ++rr_)
        if (IN(pb + 2)) {
            KArgs ka = KARGS(); unsigned char* ws = ka->ws;
            LAUNDER_BX(); pg8::Gemm g{((bf16*)(ws + WS_ACT)), ((const bf16*)(ws + WS_W2T) + (size_t)l * D * D), D}; pg8::StaticOrder So; So.init(M, D, G, bx);
            pg8::EpiG2 E{(const unsigned char*)(ws + WS_GATES), ((bf16*)(ws + WS_MERGED))};
            pg8::gemm_phase<pg8::EpiG2, pg8::StaticOrder, false>(lds, g, So, E, nullptr, wave * 64 + lane_id_v(), ka->mode);
        }
#endif
        SEAM(pb + 2);
#ifndef NO_G3
        for (int rr_ = 0; rr_ < (l == 0 ? REP_G3L0 : 1); ++rr_)
        if (IN(pb + 3)) {
            KArgs ka = KARGS(); unsigned char* ws = ka->ws;
            LAUNDER_BX(); pg8::Gemm g{((bf16*)(ws + WS_MERGED)), ((const bf16*)(ws + WS_W3T) + (size_t)l * D * D), D}; pg8::StaticOrder So; So.init(M, D, G, bx);
            pg8::EpiG3 E{((bf16*)(ws + WS_XB)), (unsigned char*)(ws + WS_XB8)};
            pg8::gemm_phase<pg8::EpiG3, pg8::StaticOrder, false>(lds, g, So, E, nullptr, wave * 64 + lane_id_v(), ka->mode);
        }
#endif
        SEAM(pb + 3);
        for (int rr_ = 0; rr_ < REP_ROUTER; ++rr_)
        if (IN(pb + 4)) {
            KArgs ka = KARGS(); unsigned char* ws = ka->ws;
            const int lane = lane_id_v(), fr = lane & 15, fq = lane >> 4, gw = vcu * NWAVES + wave;
            const bf16* wh = (const bf16*)(ws + WS_WRT) + (size_t)l * 2 * NE * D + (size_t)fr * D + 8 * fq; const bf16* wl = wh + NE * D;
            const bf16* xbp = (const bf16*)(ws + WS_XB); float* AFFTp = (float*)(ws + WS_AFFT); float* r2p = (float*)(ws + WS_R2);
            for (int tile = gw; tile < M / 16; tile += NGW) {
                const int row0 = tile * 16; const bf16* xa = xbp + (size_t)(row0 + fr) * D + 8 * fq;
                f32x4 acc = (f32x4){0.f, 0.f, 0.f, 0.f}; float ss = 0.f;
#pragma unroll 8
                for (int ks = 0; ks < 32; ++ks) {
                    const bf16x8 a = *(const bf16x8*)(xa + 32 * ks); const bf16x8 bh = *(const bf16x8*)(wh + 32 * ks), bl = *(const bf16x8*)(wl + 32 * ks);
                    acc = __builtin_amdgcn_mfma_f32_16x16x32_bf16(a, bh, acc, 0, 0, 0); acc = __builtin_amdgcn_mfma_f32_16x16x32_bf16(a, bl, acc, 0, 0, 0);
#pragma unroll
                    for (int j = 0; j < 8; ++j) { const float v = bf2f((unsigned short)a[j]); ss += v * v; }
                }
                ss += xor16_f(ss); ss = sum32_f(ss);
                const float r = 1.0f / sqrtf(ss * (1.0f / D) + EPS);
                f32x4 aff;
#pragma unroll
                for (int rg = 0; rg < 4; ++rg) { const float rt = __builtin_bit_cast(float, __builtin_amdgcn_ds_bpermute((4 * fq + rg) * 4, __builtin_bit_cast(int, r)));
                    const float lg = acc[rg] * rt; const float mx = row16_max(lg); const float pe = expf(lg - mx); aff[rg] = pe / row16_sum(pe); }
                const int b = row0 >> 11, s0 = row0 & (S - 1);
                *(f32x4*)(AFFTp + ((size_t)b * NE + fr) * S + s0 + 4 * fq) = aff;
                if (fq == 0) r2p[row0 + fr] = r;
            }
        }
        SEAM(pb + 4);
        for (int rr_ = 0; rr_ < REP_TOPK; ++rr_)
        if (IN(pb + 5)) {
            KArgs ka = KARGS(); unsigned char* ws = ka->ws;
            const int lane = lane_id_v(), gw = vcu * NWAVES + wave;
            for (int u = gw; u < NB * NE; u += NGW) {
                const int b = u / NE, e = u % NE;
                const float* a = ((float*)(ws + WS_AFFT)) + (size_t)u * S; unsigned key[32];
#pragma unroll
                for (int j = 0; j < 32; ++j) key[j] = __builtin_bit_cast(unsigned, a[64 * j + lane]);
                float r2v[32];
#pragma unroll
                for (int j = 0; j < 32; ++j) r2v[j] = ((const float*)(ws + WS_R2))[b * S + 64 * j + lane];
                unsigned T = 0;
                for (int bit = 31; bit >= 0; --bit) { const unsigned cand = T | (1u << bit); int cnt = 0;
#pragma unroll
                    for (int j = 0; j < 32; ++j) cnt += (key[j] >= cand) ? 1 : 0;
                    cnt = wave_sum_i(cnt);
                    if (cnt >= CAP) T = cand; }
                int cgt = 0;
#pragma unroll
                for (int j = 0; j < 32; ++j) cgt += (key[j] > T) ? 1 : 0;
                cgt = wave_sum_i(cgt);
                const int need_eq = CAP - cgt; int eq_base = 0, base = 0;
                const size_t slot0 = ((size_t)e * NB + b) * CAP;
                short* inv = ((short*)(ws + WS_INV)) + (size_t)u * S;
#pragma unroll
                for (int j = 0; j < 32; ++j) {
                    const bool iseq = key[j] == T; const unsigned long long eqb = __ballot(iseq);
                    const int eqrank = eq_base + __builtin_popcountll(eqb & ((1ull << lane) - 1ull)); eq_base += __builtin_popcountll(eqb);
                    const bool sel = (key[j] > T) || (iseq && eqrank < need_eq);
                    const unsigned long long sb = __ballot(sel);
                    const int pos = base + __builtin_popcountll(sb & ((1ull << lane) - 1ull)); base += __builtin_popcountll(sb);
                    const int sp = 64 * j + lane;
                    if (sel) { ((int*)(ws + WS_IDX))[slot0 + pos] = b * S + sp; ((float*)(ws + WS_VSEL))[slot0 + pos] = __builtin_bit_cast(float, key[j]); ((float*)(ws + WS_RSEL))[slot0 + pos] = r2v[j]; }
                    inv[sp] = sel ? (short)pos : (short)-1;
                }
            }
        }
        SEAM(pb + 5);
#ifndef NO_UP
        for (int rr_ = 0; rr_ < REP_UP; ++rr_)
        if (IN(pb + 6)) {
            KArgs ka = KARGS(); unsigned char* ws = ka->ws;
            LAUNDER_BX(); pg8::Gemm g{((const bf16*)(ws + WS_XB8)), ((const bf16*)(ws + WS_WUP)), D / 2}; pg8::MoeOrder So{8, G, bx};
            pg8::EpiUp E{((float*)(ws + WS_RSEL)), (unsigned char*)(ws + WS_H)};
            pg8::gemm_phase<pg8::EpiUp, pg8::MoeOrder, true>(lds, g, So, E, ((int*)(ws + WS_IDX)), wave * 64 + lane_id_v(), ka->mode, pg8::NoHook(), (const float*)(ws + WS_RSEL));
        }
#endif
        SEAM(pb + 6);
#ifndef NO_DOWN
        for (int rr_ = 0; rr_ < REP_DOWN; ++rr_)
        if (IN(pb + 7)) {
            KArgs ka = KARGS(); unsigned char* ws = ka->ws;
            LAUNDER_BX(); pg8::Gemm g{((const bf16*)(ws + WS_H)), ((const bf16*)(ws + WS_WDN)), FF / 2}; pg8::MoeOrder So{4, G, bx};
            pg8::EpiDown E{((float*)(ws + WS_VSEL)), ((bf16*)(ws + WS_Y))};
            pg8::gemm_phase<pg8::EpiDown, pg8::MoeOrder, false>(lds, g, So, E, nullptr, wave * 64 + lane_id_v(), ka->mode, pg8::NoHook(), (const float*)(ws + WS_VSEL));
        }
#endif
        SEAM(pb + 7);
        if (IN(pb + 8)) {
            KArgs ka = KARGS(); unsigned char* ws = ka->ws;
            const int lane = lane_id_v(), gw = vcu * NWAVES + wave; const bool last_layer = (l == DEPTH - 1);
            bf16* xbp = (bf16*)(ws + WS_XB); const bf16* Yp = (const bf16*)(ws + WS_Y); const short* INVp = (const short*)(ws + WS_INV); float* r1p = (float*)(ws + WS_R1);
            f32x4 gfin[4];
#pragma unroll
            for (int j = 0; j < 4; ++j) gfin[j] = last_layer ? *((const f32x4*)ka->in[19] + lane + 64 * j) : (f32x4){1.f, 1.f, 1.f, 1.f};
            for (int m = gw; m < M; m += NGW) {
                const int b = m >> 11, sp = m & (S - 1);
                const int myc = INVp[((size_t)b * NE + (lane & 15)) * S + sp];
                u32x2* xr = (u32x2*)(xbp + (size_t)m * D) + lane; f32x4 v[4];
#pragma unroll
                for (int j = 0; j < 4; ++j) { const u32x2 w = xr[64 * j]; v[j] = (f32x4){bflo(w.x), bfhi(w.x), bflo(w.y), bfhi(w.y)}; }
                unsigned emask = (unsigned)(__ballot(myc >= 0) & 0xffffull);
                while (emask) {
                    u32x2 y[4][4]; int ne = 0;
#pragma unroll
                    for (int q = 0; q < 4; ++q) { if (emask) { const int e = __builtin_ctz(emask); emask &= emask - 1u; const int c = __builtin_amdgcn_readlane(myc, e);
                            const u32x2* yr = (const u32x2*)(Yp + (((size_t)e * NB + b) * CAP + c) * D) + lane;
#pragma unroll
                            for (int j = 0; j < 4; ++j) y[q][j] = yr[64 * j]; ne = q + 1; }
                        else {
#pragma unroll
                            for (int j = 0; j < 4; ++j) y[q][j] = (u32x2){0u, 0u}; } }
#pragma unroll
                    for (int q = 0; q < 4; ++q)
#pragma unroll
                        for (int j = 0; j < 4; ++j) { v[j].x += bflo(y[q][j].x); v[j].y += bfhi(y[q][j].x); v[j].z += bflo(y[q][j].y); v[j].w += bfhi(y[q][j].y); }
                }
                if (last_layer) {
                    float ss = 0.f;
#pragma unroll
                    for (int j = 0; j < 4; ++j) ss += v[j].x * v[j].x + v[j].y * v[j].y + v[j].z * v[j].z + v[j].w * v[j].w;
                    ss = wave_sum(ss); const float r = 1.0f / sqrtf(ss * (1.0f / D) + EPS);
                    f32x4* orow = (f32x4*)(ka->out + (size_t)m * D) + lane;
#pragma unroll
                    for (int j = 0; j < 4; ++j) orow[64 * j] = v[j] * r * gfin[j];
                } else {
                    float ss = 0.f;
                    unsigned* x8r = (unsigned*)(ws + WS_XB8 + (size_t)m * D) + lane;
#pragma unroll
                    for (int j = 0; j < 4; ++j) { u32x2 w; w.x = pk2(v[j].x, v[j].y); w.y = pk2(v[j].z, v[j].w); xr[64 * j] = w; x8r[64 * j] = pk4_fp8(v[j]);
                        const float a0 = bflo(w.x), a1 = bfhi(w.x), a2 = bflo(w.y), a3 = bfhi(w.y); ss += a0 * a0 + a1 * a1 + a2 * a2 + a3 * a3; }
                    ss = wave_sum(ss);
                    if (lane == 0) r1p[m] = 1.0f / sqrtf(ss * (1.0f / D) + EPS);
                }
            }
        }
        SEAM(pb + 8);
    }
#undef IN
#undef SEAM
}

#ifndef OPT_G1
#define OPT_G1 1
#endif
#ifndef OPT_G2
#define OPT_G2 1
#endif
#ifndef OPT_G3
#define OPT_G3 1
#endif
#ifndef OPT_UP
#define OPT_UP 1
#endif
#ifndef OPT_DOWN
#define OPT_DOWN 1
#endif
extern "C" void kernel_launch(void* const* d_in, const int* in_sizes, int n_in, void* d_out, int out_size, void* d_ws, size_t ws_size, hipStream_t stream) {
    if (n_in != 20 || ws_size < WS_END) { fprintf(stderr, "kernel_launch: unexpected n_in %d / ws_size %zu\n", n_in, ws_size); return; }
    static int grid = 0;
    if (grid == 0) {
        int dev = 0, cus = 0;
        if (hipGetDevice(&dev) != hipSuccess || hipDeviceGetAttribute(&cus, hipDeviceAttributeMultiprocessorCount, dev) != hipSuccess) { grid = -1; return; }
        if (hipFuncSetAttribute((const void*)mk_fwd, hipFuncAttributeMaxDynamicSharedMemorySize, LDS_BYTES) != hipSuccess) { fprintf(stderr, "hipFuncSetAttribute failed\n"); grid = -1; return; }
        (void)hipGetLastError();
        grid = cus;
    }
    if (grid < 0) return;
    unsigned char* ws = (unsigned char*)d_ws;
    static_assert((CW_BAR + XCD_BAR_WORDS) * 4 <= 32768, "barrier words inside the cleared block");
    (void)hipMemsetAsync(ws + WS_CTL, 0, 32768, stream);
    MkArgs a{};
    for (int i = 0; i < 20; ++i) a.in[i] = (const float*)d_in[i];
    a.out = (float*)d_out; a.ws = ws;
    auto run = [&](int lo, int hi, int sub, int mode = 0) { MkArgs b = a; b.ph_lo = lo; b.ph_hi = hi; b.sub = sub; b.mode = mode; hipLaunchKernelGGL(mk_fwd, dim3(grid), dim3(NWAVES * 64), LDS_BYTES, stream, b); };
#ifndef MK_MULTI
#define MK_MULTI 0
#endif
    if (!MK_MULTI) { run(0, PH_TOTAL, 7); return; }
#ifndef PROBE_DUP_PH
#define PROBE_DUP_PH -1
#endif
#ifndef PROBE_DUP_MODE
#define PROBE_DUP_MODE 0
#endif
#ifndef PROBE_DUP_SUB
#define PROBE_DUP_SUB 7
#endif
    if (MK_MULTI == 2) {
        run(0, 1, 0); if (PROBE_DUP_PH == -2) run(0, 1, 0);
        for (int l = 0; l < DEPTH; ++l) { const int pb = 1 + l * PH_PER_LAYER;
            for (int k = 0; k < PH_PER_LAYER; ++k) { run(pb + k, pb + k + 1, 7);
                if (k == PROBE_DUP_PH && (k != 3 || PROBE_DUP_MODE != 0) && k != 8) run(pb + k, pb + k + 1, PROBE_DUP_SUB, PROBE_DUP_MODE); } }
        return;
    }
}
```

```cpp
#include <hip/hip_runtime.h>
#include <hip/hip_bf16.h>
#include <stdint.h>
#include <stdio.h>

#define DEVI __device__ __forceinline__
typedef unsigned short bf16;
typedef short bf16x8 __attribute__((ext_vector_type(8)));
typedef float f32x4 __attribute__((ext_vector_type(4)));
typedef unsigned u32x4 __attribute__((ext_vector_type(4)));
typedef unsigned u32x2 __attribute__((ext_vector_type(2)));

constexpr int NB = 32, S = 2048, D = 1024, M = NB * S, DEPTH = 2;
constexpr int INW = 4608, QW = 512, KVW = 128, SGW = 256, PLW = 256, GW = 3072;
constexpr int NE = 16, CAP = 256, FF = 1024, NSLOT = NB * NE * CAP;
constexpr float EPS = 1e-6f;
constexpr float C2 = 0.125f * 1.4426950408889634f;

constexpr size_t MiB = 1u << 20;
constexpr size_t WS_CTL = 0;
constexpr size_t WS_ROPE = 1 * MiB;
constexpr size_t WS_R1 = WS_ROPE + 64 * 1024;
constexpr size_t WS_R2 = WS_R1 + 256 * 1024;
constexpr size_t WS_IDX = WS_R2 + 256 * 1024;
constexpr size_t WS_VSEL = WS_IDX + 512 * 1024;
constexpr size_t WS_RSEL = WS_VSEL + 512 * 1024;
constexpr size_t WS_INV = 4 * MiB;
constexpr size_t WS_AFFT = 6 * MiB;
constexpr size_t WS_WSP = 10 * MiB;
constexpr size_t WS_WPT = 10 * MiB + 512 * 1024;
constexpr size_t WS_WRT = 11 * MiB;
constexpr size_t WS_W1T = 12 * MiB;
constexpr size_t WS_W2T = 30 * MiB;
constexpr size_t WS_W3T = 34 * MiB;
constexpr size_t WS_WUP = 40 * MiB;
constexpr size_t WS_WDN = 104 * MiB;
constexpr size_t WS_XB = 136 * MiB;
constexpr size_t WS_GATES = 264 * MiB;
constexpr size_t WS_H = WS_GATES;
constexpr size_t WS_XB8 = 520 * MiB;
constexpr size_t WS_W1G8_OFF = 3 * MiB;
constexpr float HSCALE = 16.0f, W8SCALE = 64.0f;
constexpr float GSCALE = 32.0f;
constexpr size_t WS_Q = 648 * MiB;
constexpr size_t WS_K = WS_Q + 64 * MiB;
constexpr size_t WS_V = WS_K + 16 * MiB;
constexpr size_t WS_U = WS_V + 16 * MiB;
constexpr size_t WS_VS = WS_U + 32 * MiB;
constexpr size_t WS_P = WS_VS + 32 * MiB;
constexpr size_t WS_ACT = 840 * MiB;
constexpr size_t WS_MERGED = WS_Q;
constexpr size_t WS_Y = WS_Q;
constexpr size_t WS_END = 968 * MiB;
static_assert(WS_P + 32 * MiB == WS_ACT && WS_ACT + 128 * MiB == WS_END, "ws map");

DEVI unsigned f2bf(float f) { unsigned u = __builtin_bit_cast(unsigned, f); return (u + 0x7fffu + ((u >> 16) & 1u)) >> 16; }
DEVI unsigned pk2(float lo, float hi) { return f2bf(lo) | (f2bf(hi) << 16); }
DEVI float bf2f(unsigned short h) { return __builtin_bit_cast(float, (unsigned)h << 16); }
DEVI float bflo(unsigned w) { return __builtin_bit_cast(float, w << 16); }
DEVI float bfhi(unsigned w) { return __builtin_bit_cast(float, w & 0xffff0000u); }
DEVI int dpp_qx1(int v) { return __builtin_amdgcn_update_dpp(0, v, 0xB1, 0xF, 0xF, true); }
DEVI int dpp_qx2(int v) { return __builtin_amdgcn_update_dpp(0, v, 0x4E, 0xF, 0xF, true); }
DEVI int dpp_hmir(int v) { return __builtin_amdgcn_update_dpp(0, v, 0x141, 0xF, 0xF, true); }
DEVI int dpp_mir(int v) { return __builtin_amdgcn_update_dpp(0, v, 0x140, 0xF, 0xF, true); }
DEVI int swz_x16(int v) { return __builtin_amdgcn_ds_swizzle(v, 0x401F); }
DEVI float xor16_f(float v) { return __builtin_bit_cast(float, swz_x16(__builtin_bit_cast(int, v))); }
DEVI float sum32_f(float v) { unsigned a = __builtin_bit_cast(unsigned, v), b = a; asm volatile("" : "+v"(b)); auto r = __builtin_amdgcn_permlane32_swap(a, b, false, false); const unsigned r0 = r[0], r1 = r[1]; return __builtin_bit_cast(float, r0) + __builtin_bit_cast(float, r1); }
DEVI int sum32_i(int v) { unsigned a = (unsigned)v, b = a; asm volatile("" : "+v"(b)); auto r = __builtin_amdgcn_permlane32_swap(a, b, false, false); return (int)(r[0] + r[1]); }
DEVI float wave_sum(float v) {
    v += __builtin_bit_cast(float, dpp_qx1(__builtin_bit_cast(int, v))); v += __builtin_bit_cast(float, dpp_qx2(__builtin_bit_cast(int, v)));
    v += __builtin_bit_cast(float, dpp_hmir(__builtin_bit_cast(int, v))); v += __builtin_bit_cast(float, dpp_mir(__builtin_bit_cast(int, v)));
    v += xor16_f(v); return sum32_f(v);
}
DEVI int wave_sum_i(int v) {
    v += dpp_qx1(v); v += dpp_qx2(v); v += dpp_hmir(v); v += dpp_mir(v); v += swz_x16(v); return sum32_i(v);
}

__host__ __device__ __forceinline__ int g1_logical(int pos) {
    const int pn = pos >> 8, p = pos & 255, bj = p >> 7, wc = (p >> 5) & 3, r = p & 31, fq = r >> 3, low = r & 7;
    const int d = 32 * (fq >> 1) + 16 * bj + 8 * (fq & 1) + low;
    if (pn < 2) return 64 * (4 * pn + wc) + d;
    if (pn == 2) { if (wc < 2) return 512 + 64 * wc + d; return 640 + (wc - 2) * 64 + bj * 32 + r; }
    return pos;
}
__host__ __device__ __forceinline__ int g1_pos(int c) {
    if (c < 640) { const int head = c >> 6, d = c & 63, a = d >> 5, hf = (d >> 4) & 1, f8 = (d >> 3) & 1, low = d & 7;
        const int fq = 2 * a + f8, r = 8 * fq + low, pn = (c < 512) ? (head >> 2) : 2, wc = (c < 512) ? (head & 3) : (head - 8);
        return 256 * pn + 128 * hf + 32 * wc + r; }
    if (c < 768) { const int v = c - 640, wc = 2 + (v >> 6), bj = (v >> 5) & 1, r = v & 31; return 512 + 128 * bj + 32 * wc + r; }
    return c;
}

DEVI float dppf_qx1(float v) { return __builtin_bit_cast(float, dpp_qx1(__builtin_bit_cast(int, v))); }
DEVI float dppf_qx2(float v) { return __builtin_bit_cast(float, dpp_qx2(__builtin_bit_cast(int, v))); }
DEVI float dppf_hmir(float v) { return __builtin_bit_cast(float, dpp_hmir(__builtin_bit_cast(int, v))); }
DEVI float dppf_mir(float v) { return __builtin_bit_cast(float, dpp_mir(__builtin_bit_cast(int, v))); }
DEVI float row16_sum(float v) { v += dppf_qx1(v); v += dppf_qx2(v); v += dppf_hmir(v); v += dppf_mir(v); return v; }
DEVI float row16_max(float v) { v = fmaxf(v, dppf_qx1(v)); v = fmaxf(v, dppf_qx2(v)); v = fmaxf(v, dppf_hmir(v)); v = fmaxf(v, dppf_mir(v)); return v; }

DEVI unsigned pk4_fp8(const f32x4 v) { int p = 0; p = __builtin_amdgcn_cvt_pk_fp8_f32(v.x, v.y, p, false); p = __builtin_amdgcn_cvt_pk_fp8_f32(v.z, v.w, p, true); return (unsigned)p; }

#define GAS __attribute__((address_space(1)))
#define LAS __attribute__((address_space(3)))
#define LDS_WAIT() asm volatile("s_waitcnt lgkmcnt(0)" ::: "memory")
#define VM_WAIT() asm volatile("s_waitcnt vmcnt(0)" ::: "memory")
typedef GAS unsigned gu32;
#define RLX_AGENT __ATOMIC_RELAXED, __HIP_MEMORY_SCOPE_AGENT
constexpr int NWAVES = 8;
DEVI int lane_id_v() { int l; asm volatile("v_mbcnt_lo_u32_b32 %0, -1, 0\n\tv_mbcnt_hi_u32_b32 %0, -1, %0" : "=v"(l)); return l; }

namespace pg8 {
constexpr int BM = 256, BK = 64, HALF = 128, HTB = HALF * BK * 2, STAGE_BYTES = 8 * HTB, NXCD = 8, WGM = 8, GIDX_OFF = STAGE_BYTES;
__host__ __device__ __forceinline__ int lds_byte(int r, int c) { const int st = (r >> 4) * 2 + (c >> 5), rr = r & 15, cc = c & 31, ob = rr * 64 + cc * 2; return st * 1024 + (ob ^ (((ob >> 9) & 1) << 5)); }
__host__ __device__ __forceinline__ void stage_rc(int b, int& R, int& C) { const int st = b / 1024, sb = b % 1024, swz = sb ^ (((sb >> 9) & 1) << 5); R = (st >> 1) * 16 + swz / 64; C = (st & 1) * 32 + (swz % 64) / 2; }
__host__ __device__ __forceinline__ int perm32(int rho) { const int n = rho >> 4, i = rho & 15; return 8 * (i >> 2) + 4 * n + (i & 3); }
struct Unit { int pm, pn; };
struct Gemm { const bf16* A; const bf16* Bt; int K; };
struct StaticOrder {
    int nM, nN, nwg, G, c;
    __device__ void init(int M_, int N_, int G_, int c_) { nM = M_ / BM; nN = N_ / BM; nwg = nM * nN; G = G_; c = c_; }
    __device__ bool next(int i, Unit& u) const {
        const long L = (long)i * G + c; if (L >= nwg) return false;
        int wgid = (int)L; { const int q = nwg / NXCD, r = nwg % NXCD, xcd = wgid % NXCD, off = wgid / NXCD; wgid = (xcd < r ? xcd * (q + 1) : r * (q + 1) + (xcd - r) * q) + off; }
        const int nig = WGM * nN, gid = wgid / nig, fm = gid * WGM, gsz = (nM - fm) < WGM ? (nM - fm) : WGM;
        u.pm = fm + ((wgid % nig) % gsz); u.pn = (wgid % nig) / gsz; return true;
    }
};
struct MoeOrder {
    int NJ, G, c;
    __device__ bool next(int i, Unit& u) const {
        const long L = (long)i * G + c; const int per = 32 * NJ; if (L >= (long)NE * per) return false;
        const int e = (int)(L / per), w = (int)(L % per), x = w & 7, q = w >> 3, b = x * 4 + q / NJ, j = q % NJ;
        u.pm = e * 32 + b; u.pn = e * NJ + j; return true;
    }
};
DEVI unsigned cvt_pk_bf16(float lo, float hi) { unsigned r; asm volatile("v_cvt_pk_bf16_f32 %0, %1, %2" : "=v"(r) : "v"(lo), "v"(hi)); return r; }
typedef f32x4 Acc[2][2][4][2];

struct NoHook { DEVI void operator()(int) const {} };
typedef int v4i_t __attribute__((ext_vector_type(4))); typedef int v8i_t __attribute__((ext_vector_type(8)));
DEVI v8i_t cat8(const v4i_t x, const v4i_t y) { return __builtin_shufflevector(x, y, 0, 1, 2, 3, 4, 5, 6, 7); }
template <class Epi, class Sched, bool GATHER, class Hook = NoHook>
DEVI void gemm_phase(LAS unsigned char* lds, const Gemm g, const Sched& S, const Epi& E, const int* __restrict__ gidx, int tid, int mode = 0, const Hook& H = Hook(), const float* __restrict__ rs = nullptr) {
    asm volatile("" : "+v"(tid));
    const int wid = __builtin_amdgcn_readfirstlane(tid >> 6), lane = tid & 63, wr = wid >> 2, wc = wid & 3, fr = lane & 15, fq = lane >> 4;
    int K = g.K; asm volatile("" : "+s"(K));
    const int nt = K / BK;
    unsigned voffA[2], voffB[2]; int RA[2]; unsigned CA2[2];
#pragma unroll
    for (int i = 0; i < 2; ++i) { int R, C; stage_rc(tid * 16 + i * 8192, R, C); const int Rb = (R & ~31) + perm32(R & 31);
        voffA[i] = (unsigned)(R * K + C) * 2u; voffB[i] = (unsigned)(Rb * K + C) * 2u; RA[i] = R; CA2[i] = (unsigned)C * 2u; }
    const size_t kstep = (size_t)(BK * 2);
    const size_t hstep = (size_t)HALF * K * 2;
    const size_t tstep = 2 * hstep;
    const unsigned ldsw = (unsigned)wid * 1024u;
    const int aoff = lds_byte(wr * 64 + fr, fq * 8), boff = lds_byte(wc * 32 + fr, fq * 8);
#define PG8_SA(b, h) (((b) * 2 + (h)) * HTB)
#define PG8_SB(b, h) ((4 + (b) * 2 + (h)) * HTB)
#define PG8_STAGE(bufoff, gbase, voff) do { _Pragma("unroll") for (int _i = 0; _i < 2; ++_i) \
        __builtin_amdgcn_global_load_lds((const unsigned*)((const char*)(gbase) + (voff)[_i]), (LAS unsigned*)(lds + (bufoff) + ldsw + _i * 8192), 16, 0, 0); } while (0)
#define PG8_STAGEA(bufoff, kbase, h, V) do { if constexpr (GATHER) { PG8_STAGE(bufoff, kbase, (V)[h]); } else { PG8_STAGE(bufoff, (kbase) + (h) * hstep, voffA); } } while (0)
#define PG8_LDA(dst, b, h) do { if constexpr (Epi::FP8) { _Pragma("unroll") for (int m = 0; m < 4; ++m) dst##8[m] = cat8(*(const LAS v4i_t*)(lds + PG8_SA(b, h) + aoff + m * 2048), *(const LAS v4i_t*)(lds + PG8_SA(b, h) + aoff + m * 2048 + 1024)); } \
        else { _Pragma("unroll") for (int m = 0; m < 4; ++m) _Pragma("unroll") for (int k = 0; k < 2; ++k) dst[m][k] = *(const LAS bf16x8*)(lds + PG8_SA(b, h) + aoff + m * 2048 + k * 1024); } } while (0)
#define PG8_LDB(dst, b, h) do { if constexpr (Epi::FP8) { _Pragma("unroll") for (int n = 0; n < 2; ++n) dst##8[n] = cat8(*(const LAS v4i_t*)(lds + PG8_SB(b, h) + boff + n * 2048), *(const LAS v4i_t*)(lds + PG8_SB(b, h) + boff + n * 2048 + 1024)); } \
        else { _Pragma("unroll") for (int n = 0; n < 2; ++n) _Pragma("unroll") for (int k = 0; k < 2; ++k) dst[n][k] = *(const LAS bf16x8*)(lds + PG8_SB(b, h) + boff + n * 2048 + k * 1024); } } while (0)
#define PG8_MMA(ai, bj, At, Bt) do { __builtin_amdgcn_s_setprio(1); _Pragma("unroll") for (int m = 0; m < 4; ++m) _Pragma("unroll") for (int n = 0; n < 2; ++n) { \
        if constexpr (Epi::FP8) { asm volatile("v_mfma_scale_f32_16x16x128_f8f6f4 %0, %1, %2, %0, %3, %3 op_sel_hi:[0,0,0]" : "+v"(acc[ai][bj][m][n]) : "v"(Bt##8[n]), "v"(At##8[m]), "v"(one_scale)); } \
        else { _Pragma("unroll") for (int k = 0; k < 2; ++k) acc[ai][bj][m][n] = __builtin_amdgcn_mfma_f32_16x16x32_bf16(Bt[n][k], At[m][k], acc[ai][bj][m][n], 0, 0, 0); } } \
        __builtin_amdgcn_s_setprio(0); } while (0)
#define PG8_WAIT_V(n) asm volatile("s_waitcnt vmcnt(" #n ")" ::: "memory")
#define PG8_WAIT_L(n) asm volatile("s_waitcnt lgkmcnt(" #n ")" ::: "memory")
#define PG8_BAR __builtin_amdgcn_s_barrier()
#define PG8_SCHED __builtin_amdgcn_sched_barrier(0)
#define PG8_LOADV(dst, un) do { _Pragma("unroll") for (int _h = 0; _h < 2; ++_h) _Pragma("unroll") for (int _i = 0; _i < 2; ++_i) \
        dst[_h][_i] = (unsigned)gidx[(un).pm * 256 + _h * 128 + RA[_i]] * (unsigned)(K * 2) + CA2[_i]; } while (0)
#define PG8_DMAV(un) do { _Pragma("unroll") for (int _h = 0; _h < 2; ++_h) _Pragma("unroll") for (int _i = 0; _i < 2; ++_i) \
        __builtin_amdgcn_global_load_lds((const unsigned*)(gidx + (un).pm * 256 + _h * 128 + RA[_i]), (LAS unsigned*)(lds + GIDX_OFF + ((_h * 2 + _i) * 8 + wid) * 256), 4, 0, 0); } while (0)
#define PG8_READV(dst) do { _Pragma("unroll") for (int _h = 0; _h < 2; ++_h) _Pragma("unroll") for (int _i = 0; _i < 2; ++_i) \
        dst[_h][_i] = *(const LAS unsigned*)(lds + GIDX_OFF + ((_h * 2 + _i) * 8 + wid) * 256 + lane * 4) * (unsigned)(K * 2) + CA2[_i]; } while (0)
    Unit cur, nxt; int ui = 0;
    if (!S.next(0, cur)) return;
    Acc acc;
#pragma unroll
    for (int a = 0; a < 2; ++a)
#pragma unroll
        for (int b = 0; b < 2; ++b)
#pragma unroll
            for (int m = 0; m < 4; ++m)
#pragma unroll
                for (int n = 0; n < 2; ++n) acc[a][b][m][n] = (f32x4){0.f, 0.f, 0.f, 0.f};
    bf16x8 At[4][2], B0[2][2], B1[2][2];
    v8i_t At8[4], B08[2], B18[2];
    int one_scale = 0x7f7f7f7f; asm volatile("" : "+v"(one_scale));
    float rsv[8] = {0.f, 0.f, 0.f, 0.f, 0.f, 0.f, 0.f, 0.f};
    unsigned vAc[2][2] = {{0u, 0u}, {0u, 0u}};
    if constexpr (GATHER) { PG8_LOADV(vAc, cur); }
    const char* cA = GATHER ? (const char*)g.A : (const char*)g.A + (size_t)cur.pm * tstep; const char* cB = (const char*)g.Bt + (size_t)cur.pn * tstep;
    PG8_STAGE(PG8_SB(0, 0), cB, voffB); PG8_STAGE(PG8_SB(0, 1), cB + hstep, voffB); PG8_STAGEA(PG8_SA(0, 0), cA, 0, vAc); PG8_STAGEA(PG8_SA(0, 1), cA, 1, vAc);
    if (wr == 1) PG8_BAR;
    PG8_WAIT_V(2); PG8_BAR;
    PG8_STAGE(PG8_SB(1, 0), cB + kstep, voffB); PG8_STAGEA(PG8_SA(1, 0), cA + kstep, 0, vAc); PG8_STAGE(PG8_SB(1, 1), cB + hstep + kstep, voffB);
    PG8_WAIT_V(6); PG8_BAR;
    for (;;) {
        const bool has_next = S.next(ui + 1, nxt);
        if constexpr (GATHER) { if (has_next) { PG8_DMAV(nxt); } }
        const char* nA = GATHER ? (const char*)g.A : (has_next ? (const char*)g.A + (size_t)nxt.pm * tstep : cA);
        const char* nB = has_next ? (const char*)g.Bt + (size_t)nxt.pn * tstep : cB;
        for (int t = 0; t < nt; t += 2) {
            if constexpr (Epi::HAS_MID) { if ((t == Epi::MID0 || t == Epi::MID1) && !(mode & 2)) E.mid(acc, cur, t, wr, wc, fr, fq); }
            const bool last = (t == nt - 2);
            if constexpr (Epi::HAS_RS) { if (last) {
#pragma unroll
                for (int k = 0; k < 8; ++k) rsv[k] = rs[cur.pm * BM + (k >> 2) * HALF + wr * 64 + (k & 3) * 16 + fr]; } }
            const char* a1 = cA + (size_t)(t + 1) * kstep;
            const char* a2 = last ? nA : cA + (size_t)(t + 2) * kstep; const char* b2 = last ? nB : cB + (size_t)(t + 2) * kstep;
            const char* a3 = a2 + kstep; const char* b3 = b2 + kstep;
            PG8_LDB(B0, 0, 0); PG8_LDB(B1, 0, 1); PG8_SCHED; PG8_LDA(At, 0, 0); PG8_STAGEA(PG8_SA(1, 1), a1, 1, vAc);
            PG8_WAIT_V(8); PG8_WAIT_L(0); PG8_BAR; PG8_MMA(0, 0, At, B0); PG8_MMA(0, 1, At, B1); PG8_BAR; PG8_SCHED;
            if constexpr (GATHER) { if (last && has_next) { PG8_READV(vAc); } }
            PG8_LDA(At, 0, 1); PG8_STAGE(PG8_SB(0, 0), b2, voffB); PG8_STAGE(PG8_SB(0, 1), b2 + hstep, voffB); PG8_STAGEA(PG8_SA(0, 0), a2, 0, vAc);
            PG8_WAIT_V(8); PG8_WAIT_L(0); PG8_BAR; PG8_MMA(1, 0, At, B0); PG8_MMA(1, 1, At, B1); PG8_BAR; PG8_SCHED;
            PG8_LDB(B0, 1, 0); PG8_LDB(B1, 1, 1); PG8_SCHED; PG8_LDA(At, 1, 0); PG8_STAGEA(PG8_SA(0, 1), a2, 1, vAc);
            PG8_WAIT_V(8); PG8_WAIT_L(0); PG8_BAR; PG8_MMA(0, 0, At, B0); PG8_MMA(0, 1, At, B1); PG8_BAR; PG8_SCHED;
            PG8_LDA(At, 1, 1); PG8_STAGE(PG8_SB(1, 0), b3, voffB); PG8_STAGE(PG8_SB(1, 1), b3 + hstep, voffB); PG8_STAGEA(PG8_SA(1, 0), a3, 0, vAc);
            PG8_WAIT_V(8); PG8_WAIT_L(0); PG8_BAR; PG8_MMA(1, 0, At, B0); PG8_MMA(1, 1, At, B1); PG8_BAR; PG8_SCHED;
        }
        if (wr == 0) PG8_BAR;
        if constexpr (Epi::FP8) asm volatile("s_nop 15\n\ts_nop 15" ::: "memory");
        if (!(mode & 1)) E(acc, cur, wr, wc, fr, fq, rsv);
        H(ui);
        if (!has_next) break;
#pragma unroll
        for (int a = 0; a < 2; ++a)
#pragma unroll
            for (int b = 0; b < 2; ++b)
#pragma unroll
                for (int m = 0; m < 4; ++m)
#pragma unroll
                    for (int n = 0; n < 2; ++n) acc[a][b][m][n] = (f32x4){0.f, 0.f, 0.f, 0.f};
        cur = nxt; cA = nA; cB = nB; ++ui;
        if (wr == 1) PG8_BAR;
    }
    PG8_WAIT_V(0);
    PG8_BAR;
#undef PG8_SA
#undef PG8_SB
#undef PG8_STAGE
#undef PG8_STAGEA
#undef PG8_LDA
#undef PG8_LDB
#undef PG8_MMA
#undef PG8_WAIT_V
#undef PG8_WAIT_L
#undef PG8_BAR
#undef PG8_SCHED
#undef PG8_LOADV
#undef PG8_DMAV
#undef PG8_READV
}

DEVI u32x4 pack8(const f32x4 a, const f32x4 b) { u32x4 w; w.x = cvt_pk_bf16(a[0], a[1]); w.y = cvt_pk_bf16(a[2], a[3]); w.z = cvt_pk_bf16(b[0], b[1]); w.w = cvt_pk_bf16(b[2], b[3]); return w; }
DEVI float sigm(float v) { v = fmaxf(v, -30.f); return __builtin_amdgcn_rcpf(1.0f + __expf(-v)); }

struct EpiG1 {
    static constexpr bool HAS_MID = false, HAS_RS = false, FP8 = false; static constexpr int MID0 = -1, MID1 = -1;
    const float* r1; const float* rope; const float* g_q; const float* g_k;
    bf16 *Q, *Kb, *V, *U, *VS, *P;
    DEVI void mid(Acc&, const Unit&, int, int, int, int, int) const {}
    DEVI void operator()(const Acc& acc, const Unit& u, int wr, int wc, int fr, int fq, const float (&rsv)[8]) const {
        asm volatile("" : "+v"(fr), "+v"(fq));
        const int row0 = u.pm * BM + wr * 64 + fr, pn = u.pn;
        float r1v[8];
#pragma unroll
        for (int k = 0; k < 8; ++k) r1v[k] = r1[row0 + (k >> 2) * HALF + (k & 3) * 16];
        if (pn < 2 || (pn == 2 && wc < 2)) {
            const bool isq = pn < 2; const float* g = isq ? g_q : g_k; const int a = fq >> 1, f0 = 8 * (fq & 1);
            f32x4 g1[2], g2[2];
#pragma unroll
            for (int n = 0; n < 2; ++n) { g1[n] = *(const f32x4*)(g + 32 * a + f0 + 4 * n); g2[n] = *(const f32x4*)(g + 32 * a + 16 + f0 + 4 * n); }
            const float osc = isq ? C2 : 1.0f;
#pragma unroll
            for (int ai = 0; ai < 2; ++ai) {
#pragma unroll
                for (int mh = 0; mh < 2; ++mh) {
                f32x4 rp4[2][4];
#pragma unroll
                for (int m2 = 0; m2 < 2; ++m2) { const int tpos_ = (row0 + ai * HALF + (mh * 2 + m2) * 16) & (S - 1), pos_ = a ? (tpos_ & 63) : (tpos_ >> 6); const f32x4* rq = (const f32x4*)(rope + 2 * (pos_ * 16 + f0));
#pragma unroll
                    for (int q = 0; q < 4; ++q) rp4[m2][q] = rq[q]; }
#pragma unroll
                for (int m2 = 0; m2 < 2; ++m2) { const int m = mh * 2 + m2;
                    const int row = row0 + ai * HALF + m * 16; const float rs = r1v[ai * 4 + m];
                    f32x4 v[2][2]; float ss = 0.f;
#pragma unroll
                    for (int bj = 0; bj < 2; ++bj)
#pragma unroll
                        for (int n = 0; n < 2; ++n) { v[bj][n] = acc[ai][bj][m][n] * rs; ss += v[bj][n][0] * v[bj][n][0] + v[bj][n][1] * v[bj][n][1] + v[bj][n][2] * v[bj][n][2] + v[bj][n][3] * v[bj][n][3]; }
                    ss += xor16_f(ss); ss = sum32_f(ss);
                    const float rn = __builtin_amdgcn_rsqf(ss * (1.0f / 64) + EPS) * osc;
                    const f32x4* rp = rp4[m2];
                    f32x4 o1[2], o2[2];
#pragma unroll
                    for (int n = 0; n < 2; ++n) { const f32x4 cs0 = rp[2 * n], cs1 = rp[2 * n + 1];
                        const f32x4 x1 = v[0][n] * rn * g1[n], x2 = v[1][n] * rn * g2[n];
                        const f32x4 c = (f32x4){cs0[0], cs0[2], cs1[0], cs1[2]}, s = (f32x4){cs0[1], cs0[3], cs1[1], cs1[3]};
                        o1[n] = x1 * c - x2 * s; o2[n] = x2 * c + x1 * s; }
                    bf16* dst = isq ? (Q + (size_t)row * QW + 64 * (4 * pn + wc)) : (Kb + (size_t)row * KVW + 64 * wc);
                    *(u32x4*)(dst + 32 * a + f0) = pack8(o1[0], o1[1]); *(u32x4*)(dst + 32 * a + 16 + f0) = pack8(o2[0], o2[1]);
                } } }
        } else {
            bf16* base; int ld, cb;
            if (pn == 2) { base = V; ld = KVW; cb = (wc - 2) * 64 + 8 * fq; }
            else if (pn == 3) { base = U; ld = SGW; cb = 32 * wc + 8 * fq; }
            else if (pn == 4) { base = VS; ld = SGW; cb = 32 * wc + 8 * fq; }
            else { base = P; ld = PLW; cb = 32 * wc + 8 * fq; }
            const int bjs = (pn == 2) ? 32 : HALF;
#pragma unroll
            for (int ai = 0; ai < 2; ++ai)
#pragma unroll
                for (int m = 0; m < 4; ++m) {
                    const int row = row0 + ai * HALF + m * 16; const float rs = r1v[ai * 4 + m];
#pragma unroll
                    for (int bj = 0; bj < 2; ++bj) *(u32x4*)(base + (size_t)row * ld + cb + bj * bjs) = pack8(acc[ai][bj][m][0] * rs, acc[ai][bj][m][1] * rs);
                }
        }
    }
};
struct EpiGate {
    static constexpr int NSTORE = 8;
    static constexpr bool HAS_MID = false, HAS_RS = false, FP8 = true; static constexpr int MID0 = -1, MID1 = -1;
    const float* r1; unsigned char* GATES8;
    DEVI void mid(Acc&, const Unit&, int, int, int, int, int) const {}
    DEVI void operator()(const Acc& acc, const Unit& u, int wr, int wc, int fr, int fq, const float (&rsv)[8]) const {
        asm volatile("" : "+v"(fr), "+v"(fq));
        const int row0 = u.pm * BM + wr * 64 + fr, pn = u.pn;
        float r1v[8];
#pragma unroll
        for (int k = 0; k < 8; ++k) r1v[k] = r1[row0 + (k >> 2) * HALF + (k & 3) * 16];
        {
            unsigned char* gbase = GATES8 + (size_t)(pn >> 2) * 1024 + (pn & 3) * 256 + 64 * wc + 16 * fq;
#pragma unroll
            for (int ai = 0; ai < 2; ++ai)
#pragma unroll
                for (int m = 0; m < 4; ++m) {
                    const int row = row0 + ai * HALF + m * 16; const float rs = r1v[ai * 4 + m] * (-1.4426950408889634f / GSCALE); u32x4 w;
#pragma unroll
                    for (int bj = 0; bj < 2; ++bj)
#pragma unroll
                        for (int n = 0; n < 2; ++n) { unsigned pkd = 0u;
#pragma unroll
                            for (int i = 0; i < 4; ++i) { const float e = __builtin_amdgcn_exp2f(acc[ai][bj][m][n][i] * rs);
                                const float q = fmaxf(__builtin_amdgcn_rcpf(__builtin_fmaf(e, 1.0f / 255.0f, 1.0f / 255.0f)), 1.0f);
                                pkd = __builtin_amdgcn_cvt_pk_u8_f32(q, i, pkd); }
                            w[2 * bj + n] = pkd; }
                    *(u32x4*)(gbase + (size_t)row * GW) = w;
                }
        }
    }
};
struct EpiG2 {
    static constexpr bool HAS_MID = true, HAS_RS = false, FP8 = false; static constexpr int MID0 = 8, MID1 = 12;
    const unsigned char* GATES8; bf16* MERGED;
    DEVI static float ub(unsigned w, int i) { return (float)((w >> (8 * i)) & 0xffu); }
    DEVI void mid(Acc& acc, const Unit& u, int t, int wr, int wc, int fr, int fq) const {
        asm volatile("" : "+v"(fr), "+v"(fq));
        const int row0 = u.pm * BM + wr * 64 + fr; const unsigned char* gp0 = GATES8 + ((t == MID0) ? 0 : 1024) + u.pn * 256 + 64 * wc + 16 * fq;
        u32x4 ga8[8], gb8[8];
#pragma unroll
        for (int k = 0; k < 8; ++k) { const unsigned char* gp = gp0 + (size_t)(row0 + (k >> 2) * HALF + (k & 3) * 16) * GW; ga8[k] = *(const u32x4*)gp; gb8[k] = *(const u32x4*)(gp + 1024); }
        asm volatile("" : "+v"(ga8[0]), "+v"(ga8[1]), "+v"(ga8[2]), "+v"(ga8[3]), "+v"(ga8[4]), "+v"(ga8[5]), "+v"(ga8[6]), "+v"(ga8[7]),
                          "+v"(gb8[0]), "+v"(gb8[1]), "+v"(gb8[2]), "+v"(gb8[3]), "+v"(gb8[4]), "+v"(gb8[5]), "+v"(gb8[6]), "+v"(gb8[7]));
#pragma unroll
        for (int ai = 0; ai < 2; ++ai)
#pragma unroll
            for (int m = 0; m < 4; ++m) { const u32x4 ga = ga8[ai * 4 + m], gb = gb8[ai * 4 + m];
#pragma unroll
                for (int bj = 0; bj < 2; ++bj)
#pragma unroll
                    for (int n = 0; n < 2; ++n)
#pragma unroll
                        for (int i = 0; i < 4; ++i) acc[ai][bj][m][n][i] *= ub(ga[2 * bj + n], i) * __builtin_amdgcn_rcpf(ub(gb[2 * bj + n], i)); }
    }
    DEVI void operator()(const Acc& acc, const Unit& u, int wr, int wc, int fr, int fq, const float (&rsv)[8]) const {
        asm volatile("" : "+v"(fr), "+v"(fq));
        const int row0 = u.pm * BM + wr * 64 + fr, col0 = u.pn * BM + wc * 32 + 8 * fq; const unsigned char* gp0 = GATES8 + 2048 + u.pn * 256 + 64 * wc + 16 * fq;
        u32x4 gc8[8];
#pragma unroll
        for (int k = 0; k < 8; ++k) gc8[k] = *(const u32x4*)(gp0 + (size_t)(row0 + (k >> 2) * HALF + (k & 3) * 16) * GW);
#pragma unroll
        for (int ai = 0; ai < 2; ++ai)
#pragma unroll
            for (int m = 0; m < 4; ++m) { const size_t ro = (size_t)(row0 + ai * HALF + m * 16); const u32x4 gc = gc8[ai * 4 + m];
#pragma unroll
                for (int bj = 0; bj < 2; ++bj) { f32x4 v0 = acc[ai][bj][m][0], v1 = acc[ai][bj][m][1];
#pragma unroll
                    for (int i = 0; i < 4; ++i) { v0[i] *= ub(gc[2 * bj], i) * (1.0f / 255.0f); v1[i] *= ub(gc[2 * bj + 1], i) * (1.0f / 255.0f); }
                    *(u32x4*)(MERGED + ro * D + col0 + bj * HALF) = pack8(v0, v1); } }
    }
};
struct EpiG3 {
    static constexpr bool HAS_MID = false, HAS_RS = false, FP8 = false; static constexpr int MID0 = -1, MID1 = -1;
    bf16* xb; unsigned char* xb8;
    DEVI void mid(Acc&, const Unit&, int, int, int, int, int) const {}
    DEVI void operator()(const Acc& acc, const Unit& u, int wr, int wc, int fr, int fq, const float (&rsv)[8]) const {
        asm volatile("" : "+v"(fr), "+v"(fq));
        const int row0 = u.pm * BM + wr * 64 + fr, col0 = u.pn * BM + wc * 32 + 8 * fq;
        u32x4 xo16[16];
#pragma unroll
        for (int k = 0; k < 16; ++k) xo16[k] = *(const u32x4*)(xb + (size_t)(row0 + (k >> 3) * HALF + ((k >> 1) & 3) * 16) * D + col0 + (k & 1) * HALF);
#pragma unroll
        for (int ai = 0; ai < 2; ++ai)
#pragma unroll
            for (int m = 0; m < 4; ++m) { const size_t ro = (size_t)(row0 + ai * HALF + m * 16) * D + col0;
#pragma unroll
                for (int bj = 0; bj < 2; ++bj) { const size_t o = ro + bj * HALF; const u32x4 xo = xo16[ai * 8 + m * 2 + bj];
                    const f32x4 x0 = (f32x4){bflo(xo[0]), bfhi(xo[0]), bflo(xo[1]), bfhi(xo[1])} + acc[ai][bj][m][0], x1 = (f32x4){bflo(xo[2]), bfhi(xo[2]), bflo(xo[3]), bfhi(xo[3])} + acc[ai][bj][m][1];
                    *(u32x4*)(xb + o) = pack8(x0, x1); u32x2 o8; o8.x = pk4_fp8(x0); o8.y = pk4_fp8(x1); *(u32x2*)(xb8 + o) = o8; } }
    }
};
struct EpiUp {
    static constexpr bool HAS_MID = false, HAS_RS = true, FP8 = true; static constexpr int MID0 = -1, MID1 = -1;
    const float* RSEL; unsigned char* H;
    DEVI void mid(Acc&, const Unit&, int, int, int, int, int) const {}
    DEVI void operator()(const Acc& acc, const Unit& u, int wr, int wc, int fr, int fq, const float (&rsv)[8]) const {
        asm volatile("" : "+v"(fr), "+v"(fq));
        const int slot0 = u.pm * BM + wr * 64 + fr, f0 = (u.pn & 7) * 128 + 32 * wc + 8 * fq;
#pragma unroll
        for (int ai = 0; ai < 2; ++ai)
#pragma unroll
            for (int m = 0; m < 4; ++m) { const int slot = slot0 + ai * HALF + m * 16; const float rs = rsv[ai * 4 + m] * (1.0f / W8SCALE); f32x4 h[2];
#pragma unroll
                for (int n = 0; n < 2; ++n)
#pragma unroll
                    for (int i = 0; i < 4; ++i) { const float a = acc[ai][0][m][n][i] * rs, b = acc[ai][1][m][n][i] * (rs * HSCALE);
                        h[n][i] = __builtin_amdgcn_fmed3f(a * __builtin_amdgcn_rcpf(1.0f + __expf(-a)) * b, -448.f, 448.f); }
                u32x2 o; o.x = pk4_fp8(h[0]); o.y = pk4_fp8(h[1]);
                *(u32x2*)(H + (size_t)slot * FF + f0) = o; }
    }
};
struct EpiDown {
    static constexpr bool HAS_MID = false, HAS_RS = true, FP8 = true; static constexpr int MID0 = -1, MID1 = -1;
    const float* VSEL; bf16* Y;
    DEVI void mid(Acc&, const Unit&, int, int, int, int, int) const {}
    DEVI void operator()(const Acc& acc, const Unit& u, int wr, int wc, int fr, int fq, const float (&rsv)[8]) const {
        asm volatile("" : "+v"(fr), "+v"(fq));
        const int slot0 = u.pm * BM + wr * 64 + fr, col0 = (u.pn & 3) * 256 + 32 * wc + 8 * fq;
#pragma unroll
        for (int ai = 0; ai < 2; ++ai)
#pragma unroll
            for (int m = 0; m < 4; ++m) { const int slot = slot0 + ai * HALF + m * 16; const float vs = rsv[ai * 4 + m] * (1.0f / (HSCALE * W8SCALE));
#pragma unroll
                for (int bj = 0; bj < 2; ++bj) *(u32x4*)(Y + (size_t)slot * D + col0 + bj * HALF) = pack8(acc[ai][bj][m][0] * vs, acc[ai][bj][m][1] * vs); }
    }
};
}

namespace attn_body {
typedef __hip_bfloat16 hbf16;
using s16x4=__attribute__((ext_vector_type(4)))short;
using f32x16=__attribute__((ext_vector_type(16)))float;
constexpr int SEQ=S,HD=64,QP=QW,KP=KVW,OP=1024;
constexpr int NW=8,QBLK=32,QB=QBLK*NW,KVBLK=64,NQB=SEQ/QB;
__device__ __forceinline__ int crow(int r,int hi){return (r&3)+8*(r>>2)+4*hi;}
#define SBAR() __builtin_amdgcn_sched_barrier(0)
constexpr int NSLOT=3, SLOTB=8192;
constexpr int LDS_K=0, LDS_V=NSLOT*SLOTB, LDS_WS=2*NSLOT*SLOTB, LDS_OST=LDS_WS+NW*64*4, LDS_BYTES=LDS_OST+NW*4096;
constexpr float C2=0.125f*1.4426950408889634f;
__device__ __forceinline__ void glds16(const void*gsrc,unsigned lds_dst){unsigned keep;
  asm volatile("s_mov_b32 %0, m0\n\ts_mov_b32 m0, %2\n\ts_nop 0\n\tglobal_load_lds_dwordx4 %1, off\n\ts_mov_b32 m0, %0":"=&s"(keep):"v"(gsrc),"s"(lds_dst):"memory");}
__device__ __forceinline__ float max3f(float a,float b,float c){float r;asm("v_max3_f32 %0, %1, %2, %3":"=v"(r):"v"(a),"v"(b),"v"(c));return r;}
__device__ __forceinline__ float max2f(float a,float b){float r;asm("v_max_f32_e32 %0, %1, %2":"=v"(r):"v"(a),"v"(b));return r;}
__device__ __forceinline__ float fadd_s(float a,float b){float r;asm("v_add_f32_e32 %0, %1, %2":"=v"(r):"v"(a),"v"(b));return r;}
__device__ __forceinline__ float fsub_s(float a,float b){float r;asm("v_sub_f32_e32 %0, %1, %2":"=v"(r):"v"(a),"v"(b));return r;}
typedef float f32x2_t __attribute__((ext_vector_type(2))); typedef __bf16 bf16x2_t __attribute__((ext_vector_type(2)));
__device__ __forceinline__ unsigned cvtpk_s(float lo,float hi){f32x2_t v={lo,hi};bf16x2_t b=__builtin_convertvector(v,bf16x2_t);return __builtin_bit_cast(unsigned,b);}
#define WAIT_BAR(N) asm volatile("s_waitcnt vmcnt(" #N ") lgkmcnt(0)\n\ts_barrier":::"memory")

__device__ __forceinline__ void qkt(f32x16&p0,f32x16&p1,const char*Kslot,const bf16x8*qr,const f32x16&negm,int r32,int hi){
  const char*kb=Kslot+hi*1024+r32*16;
  #pragma unroll
  for(int d0=0;d0<4;++d0){
    const bf16x8 b0=*reinterpret_cast<const bf16x8*>(kb+d0*2048);
    const bf16x8 b1=*reinterpret_cast<const bf16x8*>(kb+d0*2048+512);
    if(d0==0){p0=__builtin_amdgcn_mfma_f32_32x32x16_bf16(b0,qr[0],negm,0,0,0);p1=__builtin_amdgcn_mfma_f32_32x32x16_bf16(b1,qr[0],negm,0,0,0);}
    else{p0=__builtin_amdgcn_mfma_f32_32x32x16_bf16(b0,qr[d0],p0,0,0,0);p1=__builtin_amdgcn_mfma_f32_32x32x16_bf16(b1,qr[d0],p1,0,0,0);}}
}
typedef __attribute__((address_space(3))) const char* lds_cptr;
typedef short v4i16_t __attribute__((ext_vector_type(4)));
__device__ __forceinline__ void kload8(bf16x8*kf,lds_cptr kp){
  kf[0]=*(const __attribute__((address_space(3))) bf16x8*)(kp);      kf[1]=*(const __attribute__((address_space(3))) bf16x8*)(kp+512);
  kf[2]=*(const __attribute__((address_space(3))) bf16x8*)(kp+2048); kf[3]=*(const __attribute__((address_space(3))) bf16x8*)(kp+2560);
  kf[4]=*(const __attribute__((address_space(3))) bf16x8*)(kp+4096); kf[5]=*(const __attribute__((address_space(3))) bf16x8*)(kp+4608);
  kf[6]=*(const __attribute__((address_space(3))) bf16x8*)(kp+6144); kf[7]=*(const __attribute__((address_space(3))) bf16x8*)(kp+6656);
}
__device__ __forceinline__ void kload2(bf16x8*kf,lds_cptr kp,int j){ kf[2*j]=*(const __attribute__((address_space(3))) bf16x8*)(kp+j*2048); kf[2*j+1]=*(const __attribute__((address_space(3))) bf16x8*)(kp+j*2048+512); }
__device__ __forceinline__ s16x4 vtr(lds_cptr p){ return __builtin_bit_cast(s16x4,__builtin_amdgcn_ds_read_tr16_b64_v4i16((__attribute__((address_space(3))) v4i16_t*)p)); }
__device__ __forceinline__ float rowmax(const f32x16&p0,const f32x16&p1){
  float a=max3f(p0[0],p0[1],p1[0]),b=max3f(p0[2],p0[3],p1[1]);a=max3f(a,p1[2],p1[3]);
  #pragma unroll
  for(int r=4;r<16;r+=4){a=max3f(a,p0[r],p0[r+1]);b=max3f(b,p0[r+2],p0[r+3]);a=max3f(a,p1[r],p1[r+1]);b=max3f(b,p1[r+2],p1[r+3]);}
  const float m=max2f(a,b);
  auto rr=__builtin_amdgcn_permlane32_swap(__float_as_uint(m),__float_as_uint(m),false,false);
  return max2f(__uint_as_float(rr[0]),__uint_as_float(rr[1]));
}
__device__ __forceinline__ void pv(f32x16*o,int vb,bf16x8 pa0,bf16x8 pa1,bf16x8 pa2,bf16x8 pa3){
  #pragma unroll
  for(int d0=0;d0<2;++d0){s16x4 lo[4],hi[4];
    #pragma unroll
    for(int ks=0;ks<4;++ks){
      asm volatile("ds_read_b64_tr_b16 %0,%1 offset:%c2":"=&v"(lo[ks]):"v"(vb),"i"(d0*4096+ks*1024):"memory");
      asm volatile("ds_read_b64_tr_b16 %0,%1 offset:%c2":"=&v"(hi[ks]):"v"(vb),"i"(d0*4096+ks*1024+512):"memory");}
    asm volatile("s_waitcnt lgkmcnt(0)":::"memory");SBAR();
    #define PK(k) (bf16x8){lo[k][0],lo[k][1],lo[k][2],lo[k][3],hi[k][0],hi[k][1],hi[k][2],hi[k][3]}
    o[d0]=__builtin_amdgcn_mfma_f32_32x32x16_bf16(pa0,PK(0),o[d0],0,0,0);
    o[d0]=__builtin_amdgcn_mfma_f32_32x32x16_bf16(pa1,PK(1),o[d0],0,0,0);
    o[d0]=__builtin_amdgcn_mfma_f32_32x32x16_bf16(pa2,PK(2),o[d0],0,0,0);
    o[d0]=__builtin_amdgcn_mfma_f32_32x32x16_bf16(pa3,PK(3),o[d0],0,0,0);
    #undef PK
  }
}

#ifndef ATTN_STORE16
#define ATTN_STORE16(p,v) (*(u32x4*)(p)=(v))
#endif
template<int THRL> __device__ __forceinline__ void attn_unit(int b,int h,int qb,const hbf16*Q,const hbf16*__restrict__ K,const hbf16*__restrict__ V,hbf16*O,char*shm,int tid){
  const int lane=tid&63,r32=lane&31,hi=lane>>5; const int wid=__builtin_amdgcn_readfirstlane(tid>>6);
  const long rowbase=(long)b*SEQ; const int q0=qb*QB;
  const hbf16*Qw=Q+(rowbase+q0+wid*QBLK)*QP+h*HD;
  const hbf16*Kh=K+rowbase*KP+(h>>2)*HD,*Vh=V+rowbase*KP+(h>>2)*HD;
  const unsigned lds0=(unsigned)(uintptr_t)shm;
  float*wsf=(float*)(shm+LDS_WS)+wid*64;
  const hbf16*ksrc=Kh+(long)lane*KP+wid*8;
  const hbf16*vsrc=Vh+(long)(16*(wid&3)+(lane>>2))*KP+(wid>>2)*32+(lane&3)*8;
  const unsigned kdst=lds0+LDS_K+wid*1024, vdst=lds0+LDS_V+wid*1024;
  #define DMA_K(t,slot) glds16(ksrc+(long)(t)*KVBLK*KP,(unsigned)__builtin_amdgcn_readfirstlane(kdst+(slot)))
  #define DMA_V(t,slot) glds16(vsrc+(long)(t)*KVBLK*KP,(unsigned)__builtin_amdgcn_readfirstlane(vdst+(slot)))
  const int vb0=(int)(lds0+LDS_V)+((lane>>4)&1)*32+(lane&3)*8+(4*hi+((lane&15)>>2))*64;
  const char*Kbase=shm+LDS_K; bf16x8 kf[8];
  const lds_cptr shm3=(lds_cptr)shm; const lds_cptr kp0=shm3+LDS_K+hi*1024+r32*16; const lds_cptr vp0=shm3+LDS_V+((lane>>4)&1)*32+(lane&3)*8+(4*hi+((lane&15)>>2))*64;
  constexpr int NT=SEQ/KVBLK;
  DMA_K(0,0);DMA_V(0,0);DMA_K(1,SLOTB);
  bf16x8 qr[4];
  #pragma unroll
  for(int d0=0;d0<4;++d0)qr[d0]=*reinterpret_cast<const bf16x8*>(&Qw[(long)r32*QP+d0*16+hi*8]);
  float mhat=0.f,l_reg=0.f;f32x16 o[2],negm;{float z_=0.f;asm volatile("":"+v"(z_));
  _Pragma("unroll") for(int r=0;r<16;++r){o[0][r]=z_;o[1][r]=z_;negm[r]=z_;}}asm volatile("":"+v"(negm));
  #define CMASK(P0,P1,t) do{}while(0)
  bool resc=false;
  #define START(P0,P1) do{ const float rm=rowmax(P0,P1); resc=false; \
    { const float dl=rm; mhat=fadd_s(mhat,dl); \
      _Pragma("unroll") for(int r=0;r<16;++r){P0[r]=fsub_s(P0[r],dl);P1[r]=fsub_s(P1[r],dl);} \
      _Pragma("unroll") for(int r=0;r<16;++r)negm[r]=-mhat; asm volatile("":"+v"(negm)); } \
    _Pragma("unroll") for(int r=0;r<16;++r)P0[r]=__builtin_amdgcn_exp2f(P0[r]); }while(0)
  #define RESC() do{ if(resc){ asm volatile("s_waitcnt lgkmcnt(0)":::"memory"); \
      _Pragma("unroll") for(int d_=0;d_<2;++d_) _Pragma("unroll") for(int r=0;r<16;++r)o[d_][r]*=wsf[crow(r,hi)]; } }while(0)
  f32x16 pA0,pA1,pB0,pB1;
  int sl_prev=0,sl_cur=0,sl_next=SLOTB;
  #define ROT() do{sl_prev=sl_cur;sl_cur=sl_next;sl_next=(sl_next==(NSLOT-1)*SLOTB)?0:sl_next+SLOTB;}while(0)
  DMA_K(2,2*SLOTB);
  WAIT_BAR(3);
  qkt(pA0,pA1,Kbase,qr,negm,r32,hi);asm volatile("s_nop 15\n\ts_nop 7":"+v"(pA0),"+v"(pA1));CMASK(pA0,pA1,0);
  START(pA0,pA1);
  _Pragma("unroll") for(int r=0;r<16;++r)pA1[r]=__builtin_amdgcn_exp2f(pA1[r]);
  WAIT_BAR(0);
  DMA_K(3,0);DMA_V(1,SLOTB);
  ROT();
  kload8(kf,kp0+sl_cur);
  WAIT_BAR(2);
  s16x4 vlo[8],vhi[8]; u32x4 pw0,pw1,pw2,pw3;
  #define PKW(P,B) cvtpk_s(P[B],P[B+1])
  #define PAF(k) __builtin_bit_cast(bf16x8,pw##k)
  #define VFR(i) (bf16x8){vlo[i][0],vlo[i][1],vlo[i][2],vlo[i][3],vhi[i][0],vhi[i][1],vhi[i][2],vhi[i][3]}
  #define PIN(x) asm volatile("":"+v"(x))
  #define MX3(a,b,c) __builtin_fmaxf(__builtin_fmaxf((a),(b)),(c))
  #define GAPA(MF,A0,A1,A2,A3,W0,W1,PW) do{ MF; sacc+=A0; sacc+=A1; sacc+=A2; sacc+=A3; PIN(sacc); W0; W1; PIN(PW); SBAR(); }while(0)
  #define EX(v) __builtin_amdgcn_exp2f(v)
  #define GAPB(MF,X,B) do{ MF; X[B]=EX(X[B]); X[B+1]=EX(X[B+1]); X[B+2]=EX(X[B+2]); X[B+3]=EX(X[B+3]); PIN(X); SBAR(); }while(0)
  #define VRD(i) do{ vlo[i]=vtr(vp_+(((i)>>2)*4096+((i)&3)*1024)); vhi[i]=vtr(vp_+(((i)>>2)*4096+((i)&3)*1024+512)); }while(0)
  #define KRD(G,j) do{ if(G){ kload2(kf,kp0+sl_next,j); SBAR(); } }while(0)
  #define STEP(C0,C1,P0,P1,t,GK,GV,GL) do{ SBAR(); \
    const lds_cptr vp_=vp0+sl_prev; \
    VRD(0); SBAR(); float sacc=(P0[0]+P0[1]); \
    GAPA(C0=__builtin_amdgcn_mfma_f32_32x32x16_bf16(kf[0],qr[0],negm,0,0,0), P0[2],P0[3],P0[4],P0[5],     pw0[0]=PKW(P0,0), pw0[1]=PKW(P0,2), pw0); \
    VRD(4); SBAR(); GAPA(C1=__builtin_amdgcn_mfma_f32_32x32x16_bf16(kf[1],qr[0],negm,0,0,0), P0[6],P0[7],P0[8],P0[9],     pw0[2]=PKW(P0,4), pw0[3]=PKW(P0,6), pw0); \
    VRD(1); SBAR(); GAPA(C0=__builtin_amdgcn_mfma_f32_32x32x16_bf16(kf[2],qr[1],C0,0,0,0),   P0[10],P0[11],P0[12],P0[13], pw1[0]=PKW(P0,8), pw1[1]=PKW(P0,10), pw1); \
    VRD(5); SBAR(); GAPA(C1=__builtin_amdgcn_mfma_f32_32x32x16_bf16(kf[3],qr[1],C1,0,0,0),   P0[14],P0[15],P1[0],P1[1],   pw1[2]=PKW(P0,12),pw1[3]=PKW(P0,14), pw1); \
    VRD(2); SBAR(); GAPA(C0=__builtin_amdgcn_mfma_f32_32x32x16_bf16(kf[4],qr[2],C0,0,0,0),   P1[2],P1[3],P1[4],P1[5],     pw2[0]=PKW(P1,0), pw2[1]=PKW(P1,2), pw2); \
    VRD(6); SBAR(); GAPA(C1=__builtin_amdgcn_mfma_f32_32x32x16_bf16(kf[5],qr[2],C1,0,0,0),   P1[6],P1[7],P1[8],P1[9],     pw2[2]=PKW(P1,4), pw2[3]=PKW(P1,6), pw2); \
    VRD(3); SBAR(); GAPA(C0=__builtin_amdgcn_mfma_f32_32x32x16_bf16(kf[6],qr[3],C0,0,0,0),   P1[10],P1[11],P1[12],P1[13], pw3[0]=PKW(P1,8), pw3[1]=PKW(P1,10), pw3); \
    VRD(7); SBAR(); GAPA(C1=__builtin_amdgcn_mfma_f32_32x32x16_bf16(kf[7],qr[3],C1,0,0,0),   P1[14],P1[15],0.f,0.f,       pw3[2]=PKW(P1,12),pw3[3]=PKW(P1,14), pw3); \
    l_reg+=sacc; \
    if(GK){DMA_K((t)+3,sl_cur);} if(GV){DMA_V((t)+1,sl_next);} \
    CMASK(C0,C1,t); \
    { float a=MX3(C0[0],C0[1],C1[0]),b=MX3(C0[2],C0[3],C1[1]); a=MX3(a,C1[2],C1[3]); \
      _Pragma("unroll") for(int r=4;r<16;r+=4){a=MX3(a,C0[r],C0[r+1]);b=MX3(b,C0[r+2],C0[r+3]);a=MX3(a,C1[r],C1[r+1]);b=MX3(b,C1[r+2],C1[r+3]);} \
      float rm=__builtin_fmaxf(a,b); { auto rr=__builtin_amdgcn_permlane32_swap(__float_as_uint(rm),__float_as_uint(rm),false,false); rm=__builtin_fmaxf(__uint_as_float(rr[0]),__uint_as_float(rr[1])); } \
      resc=false; \
      if(__builtin_expect(__any(rm>(float)THRL),0)){ const float dl=__builtin_fmaxf(rm,0.f); mhat+=dl; \
        _Pragma("unroll") for(int r=0;r<16;++r){C0[r]-=dl;C1[r]-=dl;} \
        _Pragma("unroll") for(int r=0;r<16;++r)negm[r]=-mhat; asm volatile("":"+v"(negm)); \
        const float f=__builtin_amdgcn_exp2f(-dl); l_reg*=f; if(hi==0)wsf[r32]=f; resc=true; } } \
    SBAR(); \
    GAPB(o[0]=__builtin_amdgcn_mfma_f32_32x32x16_bf16(PAF(0),VFR(0),o[0],0,0,0), C0,0); \
    GAPB(o[1]=__builtin_amdgcn_mfma_f32_32x32x16_bf16(PAF(0),VFR(4),o[1],0,0,0), C0,4); \
    KRD(GL,0); GAPB(o[0]=__builtin_amdgcn_mfma_f32_32x32x16_bf16(PAF(1),VFR(1),o[0],0,0,0), C0,8); \
    KRD(GL,1); GAPB(o[1]=__builtin_amdgcn_mfma_f32_32x32x16_bf16(PAF(1),VFR(5),o[1],0,0,0), C0,12); \
    KRD(GL,2); GAPB(o[0]=__builtin_amdgcn_mfma_f32_32x32x16_bf16(PAF(2),VFR(2),o[0],0,0,0), C1,0); \
    KRD(GL,3); GAPB(o[1]=__builtin_amdgcn_mfma_f32_32x32x16_bf16(PAF(2),VFR(6),o[1],0,0,0), C1,4); \
    GAPB(o[0]=__builtin_amdgcn_mfma_f32_32x32x16_bf16(PAF(3),VFR(3),o[0],0,0,0), C1,8); \
    GAPB(o[1]=__builtin_amdgcn_mfma_f32_32x32x16_bf16(PAF(3),VFR(7),o[1],0,0,0), C1,12); \
    }while(0)
  int t=1;
  for(;t+5<NT;t+=2){
    STEP(pB0,pB1,pA0,pA1,t,true,true,true);     WAIT_BAR(2); RESC(); ROT();
    STEP(pA0,pA1,pB0,pB1,t+1,true,true,true);   WAIT_BAR(2); RESC(); ROT();
  }
  #define ENDW(tt) do{ if((tt)+3<NT){WAIT_BAR(2);} else if((tt)+2<NT){WAIT_BAR(1);} else {WAIT_BAR(0);} }while(0)
  for(;t+1<NT;t+=2){
    STEP(pB0,pB1,pA0,pA1,t,(t+3<NT),(t+1<NT),(t+1<NT));       ENDW(t);   RESC(); ROT();
    STEP(pA0,pA1,pB0,pB1,t+1,(t+4<NT),(t+2<NT),(t+2<NT));     ENDW(t+1); RESC(); ROT();
  }
  STEP(pB0,pB1,pA0,pA1,NT-1,false,false,false); RESC();
  { float sacc=pB0[0]+pB0[1]; _Pragma("unroll") for(int r=2;r<16;++r)sacc+=pB0[r]; _Pragma("unroll") for(int r=0;r<16;++r)sacc+=pB1[r]; l_reg+=sacc;
    pw0=(u32x4){PKW(pB0,0),PKW(pB0,2),PKW(pB0,4),PKW(pB0,6)};pw1=(u32x4){PKW(pB0,8),PKW(pB0,10),PKW(pB0,12),PKW(pB0,14)};pw2=(u32x4){PKW(pB1,0),PKW(pB1,2),PKW(pB1,4),PKW(pB1,6)};pw3=(u32x4){PKW(pB1,8),PKW(pB1,10),PKW(pB1,12),PKW(pB1,14)};
    SBAR(); pv(o,vb0+sl_cur,PAF(0),PAF(1),PAF(2),PAF(3)); }
  #undef PKW
  #undef PAF
  #undef VFR
  #undef PIN
  #undef MX3
  #undef GAPA
  #undef GAPB
  #undef EX
  #undef VRD
  #undef KRD
  #undef STEP
  #undef ENDW
  {auto rr=__builtin_amdgcn_permlane32_swap(__float_as_uint(l_reg),__float_as_uint(l_reg),false,false);l_reg=__uint_as_float(rr[0])+__uint_as_float(rr[1]);}
  if(hi==0)wsf[32+r32]=l_reg;asm volatile("s_waitcnt lgkmcnt(0)":::"memory");
  float rli[16];
  #pragma unroll
  for(int r=0;r<16;++r)rli[r]=__builtin_amdgcn_rcpf(wsf[32+crow(r,hi)]);
  hbf16*Ow=O+(rowbase+q0+wid*QBLK)*OP+h*HD;
  { hbf16*stg=(hbf16*)(shm+LDS_OST)+wid*2048;
    #pragma unroll
    for(int r=0;r<16;++r){const int orow=crow(r,hi);
      #pragma unroll
      for(int d0=0;d0<2;++d0)stg[orow*64+d0*32+r32]=__float2bfloat16(o[d0][r]*rli[r]);}
    asm volatile("s_waitcnt lgkmcnt(0)":::"memory");
    #pragma unroll
    for(int i=0;i<4;++i){const int row=i*8+(lane>>3),ch=lane&7; const u32x4 v=*(const u32x4*)(stg+row*64+ch*8); ATTN_STORE16(Ow+(long)row*OP+ch*8,v);} }
  asm volatile("s_waitcnt lgkmcnt(0)\n\ts_barrier":::"memory");
  #undef DMA_K
  #undef DMA_V
  #undef CMASK
  #undef START
  #undef RESC
  #undef ROT
}
constexpr int ATTN_LDS_BYTES=LDS_BYTES;
struct AttnTensors { const hbf16* Q; const hbf16* K; const hbf16* V; hbf16* O; };
template<int THRL=8> __device__ __forceinline__ void attn_phase(char*lds,const AttnTensors&T,int vcu,int G,int tid){
  for(int L=vcu;L<NB*8;L+=G){ const int b=L>>3,h=L&7;
    for(int qb=0;qb<NQB;++qb) attn_unit<THRL>(b,h,qb,T.Q,T.K,T.V,T.O,lds,tid); }
}
#undef SBAR
#undef WAIT_BAR
}


namespace mix {
constexpr int VS_STRIDE = 544, P_STRIDE = 528;
constexpr int VS_OFF = 0, P_OFF = 128 * VS_STRIDE, P_ROWS = 143, LDS_END = P_OFF + P_ROWS * P_STRIDE;
typedef short v4i16_t __attribute__((ext_vector_type(4)));
typedef short s16x4 __attribute__((ext_vector_type(4)));
DEVI s16x4 vtr(const LAS unsigned char* p) { return __builtin_bit_cast(s16x4, __builtin_amdgcn_ds_read_tr16_b64_v4i16((LAS v4i16_t*)p)); }
DEVI void mix_phase(LAS unsigned char* lds, int c0, int cstep, const bf16* VS, const bf16* U, const bf16* P, bf16* ACT, const float* g_sgu, const bf16* WSP, const float* b_sp, const bf16* WPT, int wave, int lane) {
    const int fr = lane & 15, fq = lane >> 4, sg = wave >> 1, ph = wave & 1, tid = wave * 64 + lane;
    bf16x8 wsp[4][4];
    { const bf16* wb = WSP + ((size_t)sg * 128 + 64 * ph + fr) * 128 + 8 * fq;
#pragma unroll
      for (int ks = 0; ks < 4; ++ks)
#pragma unroll
          for (int pb = 0; pb < 4; ++pb) wsp[ks][pb] = *(const bf16x8*)(wb + (size_t)16 * pb * 128 + 32 * ks); }
    const f32x4 gs = *(const f32x4*)(g_sgu + 4 * lane);
    float bias4[4];
#pragma unroll
    for (int pb = 0; pb < 4; ++pb) bias4[pb] = b_sp[sg * 128 + 64 * ph + 16 * pb + fr];
    for (int chunk = c0; chunk < M / 128; chunk += cstep) {
        const size_t row0 = (size_t)chunk * 128; const int tpos0 = (chunk & 15) * 128;
#pragma unroll 1
        for (int h8 = 0; h8 < 2; ++h8) { u32x2 w[8];
#pragma unroll
            for (int i = 0; i < 8; ++i) w[i] = *(const u32x2*)(VS + (row0 + wave * 16 + h8 * 8 + i) * SGW + 4 * lane);
#pragma unroll
            for (int i = 0; i < 8; ++i) { const float v0 = bflo(w[i].x), v1 = bfhi(w[i].x), v2 = bflo(w[i].y), v3 = bfhi(w[i].y);
                const float ss = wave_sum(v0 * v0 + v1 * v1 + v2 * v2 + v3 * v3); const float r = __builtin_amdgcn_rsqf(ss * (1.0f / SGW) + EPS);
                u32x2 o; o.x = pk2(v0 * r * gs[0], v1 * r * gs[1]); o.y = pk2(v2 * r * gs[2], v3 * r * gs[3]);
                *(LAS u32x2*)(lds + VS_OFF + (wave * 16 + h8 * 8 + i) * VS_STRIDE + 8 * lane) = o; } }
#pragma unroll 1
        for (int bt = 0; bt < 3; ++bt) { u32x4 pv[3];
#pragma unroll
            for (int it = 0; it < 3; ++it) { const int pc = tid + (bt * 3 + it) * 512, j = pc >> 5, c = pc & 31, tp = tpos0 - 8 + j;
                pv[it] = (u32x4){0u, 0u, 0u, 0u}; if (pc < P_ROWS * 32 && tp >= 0 && tp < S) pv[it] = *(const u32x4*)(P + ((long)row0 - 8 + j) * PLW + 8 * c); }
#pragma unroll
            for (int it = 0; it < 3; ++it) { const int pc = tid + (bt * 3 + it) * 512; if (pc < P_ROWS * 32) *(LAS u32x4*)(lds + P_OFF + (pc >> 5) * P_STRIDE + 16 * (pc & 31)) = pv[it]; } }
        u32x2 uw[4][4];
        { const unsigned uo = (unsigned)(((unsigned)row0 + 64 * ph + fr) * SGW + 64 * sg + 4 * fq) * 2u;
#pragma unroll
          for (int pb = 0; pb < 4; ++pb)
#pragma unroll
              for (int cb = 0; cb < 4; ++cb) uw[pb][cb] = *(const u32x2*)((const char*)U + (uo + (unsigned)(16 * pb * SGW + 16 * cb) * 2u)); }
        LDS_WAIT(); __syncthreads();
        { f32x4 acc[4][4];
#pragma unroll
          for (int a = 0; a < 4; ++a)
#pragma unroll
              for (int b = 0; b < 4; ++b) acc[a][b] = (f32x4){0.f, 0.f, 0.f, 0.f};
          const LAS unsigned char* abase = lds + VS_OFF + (8 * fq + (fr >> 2)) * VS_STRIDE + (64 * sg + 4 * (fr & 3)) * 2;
#pragma unroll
          for (int ks = 0; ks < 4; ++ks) {
              bf16x8 af[4];
#pragma unroll
              for (int cb = 0; cb < 4; ++cb) { const s16x4 lo = vtr(abase + 32 * ks * VS_STRIDE + 32 * cb), hi = vtr(abase + (32 * ks + 4) * VS_STRIDE + 32 * cb);
                  af[cb] = (bf16x8){lo[0], lo[1], lo[2], lo[3], hi[0], hi[1], hi[2], hi[3]}; }
#pragma unroll
              for (int cb = 0; cb < 4; ++cb)
#pragma unroll
                  for (int pb = 0; pb < 4; ++pb) acc[cb][pb] = __builtin_amdgcn_mfma_f32_16x16x32_bf16(af[cb], wsp[ks][pb], acc[cb][pb], 0, 0, 0);
          }
#pragma unroll
          for (int pb = 0; pb < 4; ++pb) { const int p = 64 * ph + 16 * pb + fr; const float bias = bias4[pb];
#pragma unroll
              for (int cb = 0; cb < 4; ++cb) { const int ch = 64 * sg + 16 * cb + 4 * fq; const u32x2 u2 = uw[pb][cb];
                  u32x2 o; o.x = pk2(bflo(u2.x) * (acc[cb][pb][0] + bias), bfhi(u2.x) * (acc[cb][pb][1] + bias)); o.y = pk2(bflo(u2.y) * (acc[cb][pb][2] + bias), bfhi(u2.y) * (acc[cb][pb][3] + bias));
                  *(u32x2*)((char*)ACT + (unsigned)((((unsigned)row0 + p) * 1024 + 512 + ch) * 2u)) = o; } } }
        { const int t = 16 * wave + fr, tp = tpos0 + t;
#pragma unroll 1
          for (int g = 0; g < 4; ++g) { const int wd = 2 << g, lo_off = wd >> 1, hi_off = wd - 1 - lo_off;
              bf16x8 wf[2][4];
#pragma unroll
              for (int ks = 0; ks < 2; ++ks)
#pragma unroll
                  for (int db = 0; db < 4; ++db) wf[ks][db] = *(const bf16x8*)(WPT + ((size_t)g * 64 + 16 * db + fr) * 64 + 32 * ks + 8 * fq);
              int lo = tp - lo_off; if (lo < 0) lo = 0; int hi = tp + hi_off; if (hi > S - 1) hi = S - 1; const float icnt = 1.0f / (float)(hi - lo + 1);
              f32x4 acc[4];
#pragma unroll
              for (int a = 0; a < 4; ++a) acc[a] = (f32x4){0.f, 0.f, 0.f, 0.f};
#pragma unroll
              for (int ks = 0; ks < 2; ++ks) { const LAS unsigned char* pb_ = lds + P_OFF + (64 * g + 32 * ks + 8 * fq) * 2;
                  float sum[8];
#pragma unroll
                  for (int i = 0; i < 8; ++i) sum[i] = 0.f;
#pragma unroll 1
                  for (int j = -lo_off; j <= hi_off; ++j) { const u32x4 v = *(const LAS u32x4*)(pb_ + (t + 8 + j) * P_STRIDE);
                      sum[0] += bflo(v[0]); sum[1] += bfhi(v[0]); sum[2] += bflo(v[1]); sum[3] += bfhi(v[1]); sum[4] += bflo(v[2]); sum[5] += bfhi(v[2]); sum[6] += bflo(v[3]); sum[7] += bfhi(v[3]); }
                  const u32x4 c0 = *(const LAS u32x4*)(pb_ + (t + 8) * P_STRIDE);
                  u32x4 dw; dw[0] = pk2(sum[0] * icnt - bflo(c0[0]), sum[1] * icnt - bfhi(c0[0])); dw[1] = pk2(sum[2] * icnt - bflo(c0[1]), sum[3] * icnt - bfhi(c0[1]));
                  dw[2] = pk2(sum[4] * icnt - bflo(c0[2]), sum[5] * icnt - bfhi(c0[2])); dw[3] = pk2(sum[6] * icnt - bflo(c0[3]), sum[7] * icnt - bfhi(c0[3]));
                  const bf16x8 dfr = __builtin_bit_cast(bf16x8, dw);
#pragma unroll
                  for (int db = 0; db < 4; ++db) acc[db] = __builtin_amdgcn_mfma_f32_16x16x32_bf16(wf[ks][db], dfr, acc[db], 0, 0, 0); }
#pragma unroll
              for (int db = 0; db < 4; ++db) { u32x2 o; o.x = pk2(acc[db][0], acc[db][1]); o.y = pk2(acc[db][2], acc[db][3]);
                  *(u32x2*)((char*)ACT + (unsigned)((((unsigned)row0 + t) * 1024 + 768 + 64 * g + 16 * db + 4 * fq) * 2u)) = o; } } }
        LDS_WAIT(); __syncthreads();
    }
}
}

#define XB_TMO      128
#define XB_XCNT(j)  (256  + 64 * (j))
#define XB_XSUB(j)  (1280 + 64 * (j))
#define XB_XGEN(j)  (2304 + 64 * (j))
#define XB_TOP      3328
#define XB_TOPGEN   3392
#define XCD_BAR_WORDS 3456
#define XB_SPIN_CAP (1u << 21)
DEVI unsigned xb_ld(unsigned* p)              { return __hip_atomic_load(p, __ATOMIC_RELAXED, __HIP_MEMORY_SCOPE_AGENT); }
DEVI unsigned xb_add(unsigned* p, unsigned v) { return __hip_atomic_fetch_add(p, v, __ATOMIC_RELAXED, __HIP_MEMORY_SCOPE_AGENT); }
DEVI unsigned xb_xcc_id() { return (unsigned)__builtin_amdgcn_s_getreg((3 << 11) | 20) & 0xFu; }
#define XB_SPIN(cond, bar) do { unsigned _sp = 0; while (cond) { __builtin_amdgcn_s_sleep(1); \
    if ((++_sp & 255u) == 0u) { if (xb_ld(&(bar)[XB_TMO])) break; if (_sp > XB_SPIN_CAP) { atomicAdd(&(bar)[XB_TMO], 1u); break; } } } } while (0)
struct XcdBarrier { unsigned* bar; unsigned x; volatile LAS unsigned* st; };
DEVI XcdBarrier xcd_barrier_post(unsigned* bar, volatile LAS unsigned* st) {
    XcdBarrier b; b.bar = bar; b.x = xb_xcc_id(); b.st = st;
    if (threadIdx.x == 0) (void)xb_add(&bar[XB_XCNT(b.x)], 1u);
    return b;
}
DEVI void xcd_barrier_complete(unsigned* bar, unsigned x, unsigned& nloc, unsigned& nx) {
    const unsigned G = gridDim.x * gridDim.y * gridDim.z;
    unsigned sum, cnt, mine, sp = 0u;
    for (;;) {
        sum = 0u; cnt = 0u; mine = 0u;
#pragma unroll
        for (unsigned j = 0; j < 16; ++j) { const unsigned c = xb_ld(&bar[XB_XCNT(j)]); sum += c; cnt += (c > 0u) ? 1u : 0u; mine = (j == x) ? c : mine; }
        if (sum == G) break;
        __builtin_amdgcn_s_sleep(1);
        if ((++sp & 255u) == 0u) { if (xb_ld(&bar[XB_TMO])) break; if (sp > XB_SPIN_CAP) { atomicAdd(&bar[XB_TMO], 1u); break; } }
    }
    nloc = mine > 0u ? mine : 1u; nx = cnt > 0u ? cnt : 1u;
}
DEVI void xcd_barrier(const XcdBarrier& b, int tid) {
    asm volatile("s_waitcnt vmcnt(0)" ::: "memory");
    __syncthreads();
    if (tid == 0) {
        unsigned* bar = b.bar; unsigned bx = b.x;
        asm volatile("" : "+s"(bar), "+s"(bx));
        __builtin_amdgcn_s_waitcnt(0);
        unsigned nloc = b.st[0], nx = b.st[1];
        if (nloc == 0u) { xcd_barrier_complete(bar, bx, nloc, nx); b.st[0] = nloc; b.st[1] = nx; }
        const unsigned old = xb_add(&bar[XB_XSUB(bx)], 1u);
        const unsigned gen = old / nloc;
        if (old + 1u == (gen + 1u) * nloc) {
            __builtin_amdgcn_fence(__ATOMIC_RELEASE, "agent");
            asm volatile("s_waitcnt vmcnt(0)" ::: "memory");
            const unsigned og = xb_add(&bar[XB_TOP], 1u);
            const unsigned tg = og / nx;
            if (og + 1u == (tg + 1u) * nx) xb_add(&bar[XB_TOPGEN], 1u);
            else XB_SPIN(xb_ld(&bar[XB_TOPGEN]) == tg, bar);
            __builtin_amdgcn_fence(__ATOMIC_ACQUIRE, "agent");
            xb_add(&bar[XB_XGEN(bx)], 1u);
            asm volatile("s_waitcnt vmcnt(0)" ::: "memory");
        } else {
            XB_SPIN(xb_ld(&bar[XB_XGEN(bx)]) == gen, bar);
            __builtin_amdgcn_fence(__ATOMIC_ACQUIRE, "agent");
            asm volatile("s_waitcnt vmcnt(0)" ::: "memory");
        }
    }
    __syncthreads();
}

constexpr int RING_BYTES = 131072;
constexpr int MISC_OFF = 147456, LDS_BYTES = 147456 + 512;
constexpr int CW_BAR = 4096;
static_assert((CW_BAR + XCD_BAR_WORDS) * 4 <= (int)MiB, "ctl");

struct MkArgs {
    const float* in[20]; float* out; unsigned char* ws;
    int ph_lo, ph_hi, sub, mode;
};
typedef const __attribute__((address_space(4))) MkArgs* KArgs;
#define KARGS() ({ KArgs _p = (KArgs)__builtin_amdgcn_kernarg_segment_ptr(); asm volatile("" : "+s"(_p)); _p; })
struct ConvHook {
    int at, l, gw, ngw;
    struct Item { const float* src; const float* ks; unsigned char* out; int ld, col; };
    DEVI static Item decode(int it, int lane, const float* wg, const float* wu, const float* wd, const float* gf, unsigned char* ws) {
        constexpr int I_UP = NE * 32 * 16; Item t;
        if (it < I_UP) { const int e = it >> 9, q = it & 511, nb = q >> 4, kb = q & 15, np = nb * 64 + lane, bj = (np >> 7) & 1;
            t.src = (bj ? wu : wg) + (size_t)e * D * FF + (size_t)kb * 64 * FF; t.ld = FF; t.col = (np >> 8) * 128 + (np & 127); t.ks = gf + kb * 64; t.out = ws + WS_WUP + ((size_t)e * 2048 + np) * D + kb * 64; }
        else { const int r = it - I_UP, e = r >> 8, q = r & 255, nb = q >> 4, kb = q & 15, np = nb * 64 + lane;
            t.src = wd + (size_t)e * FF * D + (size_t)kb * 64 * D; t.ld = D; t.col = np; t.ks = nullptr; t.out = ws + WS_WDN + ((size_t)e * 1024 + np) * FF + kb * 64; }
        return t;
    }
    DEVI static void load(const Item& t, float (&v)[64]) {
#pragma unroll
        for (int kk = 0; kk < 64; ++kk) v[kk] = t.src[(size_t)kk * t.ld + t.col];
    }
    DEVI static void store(const Item& t, float (&v)[64]) {
        if (t.ks) {
#pragma unroll
            for (int kk = 0; kk < 64; ++kk) v[kk] *= t.ks[kk]; }
#pragma unroll
        for (int c = 0; c < 4; ++c) { u32x4 o;
#pragma unroll
            for (int q = 0; q < 4; ++q) { f32x4 x; x[0] = v[16 * c + 4 * q] * W8SCALE; x[1] = v[16 * c + 4 * q + 1] * W8SCALE; x[2] = v[16 * c + 4 * q + 2] * W8SCALE; x[3] = v[16 * c + 4 * q + 3] * W8SCALE; o[q] = pk4_fp8(x); }
            *(u32x4*)(t.out + 16 * c) = o; }
    }
    DEVI void operator()(int ui) const {
        if (ui != at) return;
        KArgs ka = KARGS(); unsigned char* ws = ka->ws; const int lane = lane_id_v();
        const float* wg = ka->in[16] + (size_t)l * NE * D * FF; const float* wu = ka->in[17] + (size_t)l * NE * D * FF; const float* wd = ka->in[18] + (size_t)l * NE * FF * D;
        const float* gf = ka->in[14] + l * D;
        constexpr int I_ALL = NE * 32 * 16 + NE * 16 * 16;
        float va[64], vb[64];
        int it = gw; if (it >= I_ALL) return;
        Item ta = decode(it, lane, wg, wu, wd, gf, ws), tb = ta; load(ta, va);
        for (;;) {
            const bool more_b = it + ngw < I_ALL; if (more_b) { tb = decode(it + ngw, lane, wg, wu, wd, gf, ws); load(tb, vb); }
            store(ta, va); if (!more_b) break; it += ngw;
            const bool more_a = it + ngw < I_ALL; if (more_a) { ta = decode(it + ngw, lane, wg, wu, wd, gf, ws); load(ta, va); }
            store(tb, vb); if (!more_a) break; it += ngw;
        }
    }
};

constexpr int PH_PER_LAYER = 9, PH_TOTAL = 1 + DEPTH * PH_PER_LAYER;

DEVI void tr_item(const float* src, int ld, int col, const float* kscale, bf16* out0, int ldo, int k0, LAS float* scr, int lane) {
#pragma unroll 8
    for (int i = 0; i < 32; ++i) { const int kk = 2 * i + (lane >> 5); float v = src[(size_t)(k0 + kk) * ld + col]; if (kscale) v *= kscale[k0 + kk]; scr[kk * 33 + (lane & 31)] = v; }
    LDS_WAIT(); asm volatile("" ::: "memory");
    const int c = lane & 7;
#pragma unroll
    for (int j = 0; j < 4; ++j) { const int n = (lane >> 3) + 8 * j; const LAS float* s = scr + (8 * c) * 33 + n;
        u32x4 o; o.x = pk2(s[0 * 33], s[1 * 33]); o.y = pk2(s[2 * 33], s[3 * 33]); o.z = pk2(s[4 * 33], s[5 * 33]); o.w = pk2(s[6 * 33], s[7 * 33]);
        *(u32x4*)(out0 + (size_t)n * ldo + 8 * c) = o; }
    LDS_WAIT(); asm volatile("" ::: "memory");
}


#ifndef REP_G1
#define REP_G1 1
#endif
#ifndef REP_CONV
#define REP_CONV 1
#endif
#ifndef REP_ATTN
#define REP_ATTN 1
#endif
#ifndef REP_MIX
#define REP_MIX 1
#endif
#ifndef REP_G2
#define REP_G2 1
#endif
#ifndef REP_G3L0
#define REP_G3L0 1
#endif
#ifndef REP_ROUTER
#define REP_ROUTER 1
#endif
#ifndef REP_TOPK
#define REP_TOPK 1
#endif
#ifndef REP_UP
#define REP_UP 1
#endif
#ifndef REP_DOWN
#define REP_DOWN 1
#endif
DEVI void tr_item8(const float* src, int ld, int col, const float* kscale, unsigned char* out0, int ldo, int k0, LAS float* scr, int lane) {
#pragma unroll 8
    for (int i = 0; i < 32; ++i) { const int kk = 2 * i + (lane >> 5); scr[kk * 33 + (lane & 31)] = src[(size_t)(k0 + kk) * ld + col] * kscale[k0 + kk] * GSCALE; }
    LDS_WAIT(); asm volatile("" ::: "memory");
    const int c = lane & 7;
#pragma unroll
    for (int j = 0; j < 4; ++j) { const int n = (lane >> 3) + 8 * j; const LAS float* s = scr + (8 * c) * 33 + n;
        int lo = 0, hi = 0; lo = __builtin_amdgcn_cvt_pk_fp8_f32(s[0 * 33], s[1 * 33], lo, false); lo = __builtin_amdgcn_cvt_pk_fp8_f32(s[2 * 33], s[3 * 33], lo, true);
        hi = __builtin_amdgcn_cvt_pk_fp8_f32(s[4 * 33], s[5 * 33], hi, false); hi = __builtin_amdgcn_cvt_pk_fp8_f32(s[6 * 33], s[7 * 33], hi, true);
        u32x2 o; o.x = (unsigned)lo; o.y = (unsigned)hi; *(u32x2*)(out0 + (size_t)n * ldo + 8 * c) = o; }
    LDS_WAIT(); asm volatile("" ::: "memory");
}
__global__ void __launch_bounds__(NWAVES * 64, 2) mk_fwd(MkArgs args) {
    extern __shared__ __attribute__((aligned(16))) unsigned char lds_raw[];
    LAS unsigned char* lds = (LAS unsigned char*)lds_raw;
    volatile LAS unsigned* MISC = (volatile LAS unsigned*)(lds + MISC_OFF);
    const int wave = __builtin_amdgcn_readfirstlane((int)threadIdx.x >> 6);
    const int G = gridDim.x; const int vcu = (G % 8 == 0) ? ((int)blockIdx.x % 8) * (G / 8) + (int)blockIdx.x / 8 : (int)blockIdx.x;
    gu32* ctl; { KArgs ka0 = KARGS(); ctl = (gu32*)(ka0->ws + WS_CTL); }
    { const int t0 = wave * 64 + lane_id_v(); if (t0 < 128) MISC[t0] = 0u; }
    __syncthreads();
    int lo, hi; { KArgs ka0 = KARGS(); lo = ka0->ph_lo; hi = ka0->ph_hi; }
    const bool use_bar = (hi - lo) > 1;
    XcdBarrier bar; bar.bar = (unsigned*)(ctl + CW_BAR); bar.x = 0; bar.st = nullptr;
    if (use_bar) bar = xcd_barrier_post((unsigned*)(ctl + CW_BAR), MISC + 8);
#define IN(k) (lo <= (k) && (k) < hi)
#define LAUNDER_BX() int bx = (int)blockIdx.x; asm volatile("" : "+s"(bx))
#define SEAM(k) do { if (IN(k) && IN((k) + 1)) xcd_barrier(bar, wave * 64 + lane_id_v()); } while (0)
    const int NGW = G * NWAVES;
    if (IN(0)) {
            KArgs ka = KARGS(); unsigned char* ws = ka->ws;
        const int lane = lane_id_v(), tid = wave * 64 + lane, gw = vcu * NWAVES + wave;
        LAS float* scr = (LAS float*)(lds + wave * 16384);
        { const int i = blockIdx.x * 512 + tid; if (i < 64 * 16) { const int pos = i >> 4, f = i & 15; const float freq = powf(10000.0f, -(float)(2 * f) / 32.0f); const float ang = (float)pos * freq;
            ((float*)(ws + WS_ROPE))[2 * i] = cosf(ang); ((float*)(ws + WS_ROPE))[2 * i + 1] = sinf(ang); } }
        constexpr int I_W1 = 16 * 48, I_G8 = 16 * 96, I_A = 8 * 32, I_B = 4 * 32, I_C = 4 * 32, I_W3 = 16 * 32, I_L = I_W1 + I_G8 + I_A + I_B + I_C + I_W3;
        for (int it = gw; it < DEPTH * I_L; it += NGW) {
            const int l = it / I_L; int r = it % I_L;
            bf16* w1t = (bf16*)(ws + WS_W1T) + (size_t)l * INW * D; bf16* w2t = (bf16*)(ws + WS_W2T) + (size_t)l * D * D; bf16* w3t = (bf16*)(ws + WS_W3T) + (size_t)l * D * D;
            if (r < I_W1) { const int kb = r % 16, nb = r / 16, n0 = nb * 32; tr_item(ka->in[2] + (size_t)l * D * INW, INW, g1_logical(n0 + (lane & 31)), ka->in[1] + l * D, w1t + (size_t)n0 * D + kb * 64, D, kb * 64, scr, lane); continue; } r -= I_W1;
            if (r < I_G8) { const int kb = r % 16, nb = r / 16, n0 = nb * 32; tr_item8(ka->in[2] + (size_t)l * D * INW, INW, 1536 + n0 + (lane & 31), ka->in[1] + l * D, (unsigned char*)(ws + WS_W1T + (size_t)l * INW * D * 2 + WS_W1G8_OFF) + (size_t)n0 * D + kb * 64, D, kb * 64, scr, lane); continue; } r -= I_G8;
            if (r < I_A) { const int kb = r % 8, n0 = (r / 8) * 32; tr_item(ka->in[10] + (size_t)l * QW * D, D, n0 + (lane & 31), nullptr, w2t + (size_t)n0 * D + kb * 64, D, kb * 64, scr, lane); continue; } r -= I_A;
            if (r < I_B) { const int kb = r % 4, n0 = (r / 4) * 32; tr_item(ka->in[11] + (size_t)l * SGW * D, D, n0 + (lane & 31), nullptr, w2t + (size_t)n0 * D + 512 + kb * 64, D, kb * 64, scr, lane); continue; } r -= I_B;
            if (r < I_C) { const int kb = r % 4, n0 = (r / 4) * 32; tr_item(ka->in[12] + (size_t)l * PLW * D, D, n0 + (lane & 31), nullptr, w2t + (size_t)n0 * D + 768 + kb * 64, D, kb * 64, scr, lane); continue; } r -= I_C;
            { const int kb = r % 16, n0 = (r / 16) * 32; tr_item(ka->in[13] + (size_t)l * D * D, D, n0 + (lane & 31), nullptr, w3t + (size_t)n0 * D + kb * 64, D, kb * 64, scr, lane); }
        }
        { bf16* WSPo = (bf16*)(ws + WS_WSP); bf16* WPTo = (bf16*)(ws + WS_WPT);
          for (int i = (int)blockIdx.x * 512 + tid; i < DEPTH * 4 * 128 * 128; i += G * 512) WSPo[i] = (bf16)f2bf(ka->in[6][i]);
          for (int i = (int)blockIdx.x * 512 + tid; i < DEPTH * 4 * 64 * 64; i += G * 512) { const int c = i & 63, dd = (i >> 6) & 63, lg = i >> 12;
              WPTo[i] = (bf16)f2bf(ka->in[8][((size_t)lg * 64 + c) * 64 + dd] * ka->in[9][lg * 64 + dd]); } }
        { bf16* WRTo = (bf16*)(ws + WS_WRT);
          for (int i = (int)blockIdx.x * 512 + tid; i < DEPTH * NE * D; i += G * 512) { const int k = i & (D - 1), e = (i >> 10) & 15, ll = i >> 14;
              const float w = ka->in[14][ll * D + k] * ka->in[15][((size_t)ll * D + k) * NE + e]; const unsigned hi = f2bf(w); const float rem = w - __builtin_bit_cast(float, hi << 16);
              WRTo[((size_t)ll * 2 * NE + e) * D + k] = (bf16)hi; WRTo[((size_t)ll * 2 * NE + NE + e) * D + k] = (bf16)f2bf(rem); } }
        for (int m = gw; m < M; m += 2 * NGW) {
            const int m2 = m + NGW; const bool has2 = m2 < M;
            const f32x4* xr = (const f32x4*)((ka->in[0]) + (size_t)m * D) + lane; const f32x4* xr2 = (const f32x4*)((ka->in[0]) + (size_t)(has2 ? m2 : m) * D) + lane; f32x4 v[4], v2[4]; float s = 0.f, s2 = 0.f;
#pragma unroll
            for (int j = 0; j < 4; ++j) { v[j] = xr[64 * j]; v2[j] = xr2[64 * j]; }
#pragma unroll
            for (int j = 0; j < 4; ++j) { s += v[j].x * v[j].x + v[j].y * v[j].y + v[j].z * v[j].z + v[j].w * v[j].w; s2 += v2[j].x * v2[j].x + v2[j].y * v2[j].y + v2[j].z * v2[j].z + v2[j].w * v2[j].w; }
            s = wave_sum(s); s2 = wave_sum(s2);
            u32x2* o = (u32x2*)(((bf16*)(ws + WS_XB)) + (size_t)m * D) + lane; u32x2* o2 = (u32x2*)(((bf16*)(ws + WS_XB)) + (size_t)m2 * D) + lane;
#pragma unroll
            for (int j = 0; j < 4; ++j) { u32x2 w; w.x = pk2(v[j].x, v[j].y); w.y = pk2(v[j].z, v[j].w); o[64 * j] = w; if (has2) { u32x2 w2; w2.x = pk2(v2[j].x, v2[j].y); w2.y = pk2(v2[j].z, v2[j].w); o2[64 * j] = w2; } }
            { unsigned* o8 = (unsigned*)(ws + WS_XB8 + (size_t)m * D) + lane; unsigned* o82 = (unsigned*)(ws + WS_XB8 + (size_t)m2 * D) + lane;
#pragma unroll
              for (int j = 0; j < 4; ++j) { o8[64 * j] = pk4_fp8(v[j]); if (has2) o82[64 * j] = pk4_fp8(v2[j]); } }
            if (lane == 0) { ((float*)(ws + WS_R1))[m] = 1.0f / sqrtf(s * (1.0f / D) + EPS); if (has2) ((float*)(ws + WS_R1))[m2] = 1.0f / sqrtf(s2 * (1.0f / D) + EPS); }
        }
    }
    SEAM(0);

    for (int l = 0; l < DEPTH; ++l) {
        const int pb = 1 + l * PH_PER_LAYER;
#ifndef NO_G1
        for (int rr_ = 0; rr_ < REP_G1; ++rr_)
        if (IN(pb + 0)) {
            { KArgs ka = KARGS(); unsigned char* ws = ka->ws;
              LAUNDER_BX(); pg8::Gemm g{((bf16*)(ws + WS_XB)), ((const bf16*)(ws + WS_W1T) + (size_t)l * INW * D), D}; pg8::StaticOrder So; So.init(M, QW + 2 * KVW + 2 * SGW + PLW, G, bx);
              pg8::EpiG1 E{((float*)(ws + WS_R1)), ((float*)(ws + WS_ROPE)), ka->in[3] + l * 64, ka->in[4] + l * 64, ((bf16*)(ws + WS_Q)), ((bf16*)(ws + WS_K)), ((bf16*)(ws + WS_V)), ((bf16*)(ws + WS_U)), ((bf16*)(ws + WS_VS)), ((bf16*)(ws + WS_P))};
              const int n_u = (256 * 6 - bx + G - 1) / G;
              const ConvHook CH{(ka->mode & 16) ? -1 : (vcu % (n_u > 0 ? n_u : 1)), l, vcu * NWAVES + wave, NGW};
              pg8::gemm_phase<pg8::EpiG1, pg8::StaticOrder, false, ConvHook>(lds, g, So, E, nullptr, wave * 64 + lane_id_v(), ka->mode, CH); }
            { KArgs ka = KARGS(); unsigned char* ws = ka->ws;
              LAUNDER_BX();
              pg8::Gemm g{((const bf16*)(ws + WS_XB8)), ((const bf16*)(ws + WS_W1T + (size_t)l * INW * D * 2 + WS_W1G8_OFF)), D / 2}; pg8::StaticOrder So; So.init(M, GW, G, bx);
              pg8::EpiGate E{((float*)(ws + WS_R1)), (unsigned char*)(ws + WS_GATES)};
              pg8::gemm_phase<pg8::EpiGate, pg8::StaticOrder, false>(lds, g, So, E, nullptr, wave * 64 + lane_id_v(), ka->mode); }
        }
#endif
        SEAM(pb + 0);
        if (IN(pb + 1)) {
            KArgs ka = KARGS(); unsigned char* ws = ka->ws;
#ifndef NO_ATTN
            for (int rr_ = 0; rr_ < REP_ATTN; ++rr_)
            if (ka->sub & 2) {
                const int tl = wave * 64 + lane_id_v();
                const attn_body::AttnTensors AT{(const attn_body::hbf16*)((bf16*)(ws + WS_Q)), (const attn_body::hbf16*)((bf16*)(ws + WS_K)), (const attn_body::hbf16*)((bf16*)(ws + WS_V)), (attn_body::hbf16*)((bf16*)(ws + WS_ACT))};
                int vl = vcu; asm volatile("" : "+s"(vl));
                attn_body::attn_phase<8>((char*)lds_raw, AT, vl, G, tl);
            }
#endif
#ifndef NO_MIX
            for (int rr_ = 0; rr_ < REP_MIX; ++rr_)
            if (ka->sub & 4) {
                const int lane = lane_id_v(); int vl = vcu; asm volatile("" : "+s"(vl));
                const bf16* WSP = (const bf16*)(ws + WS_WSP) + (size_t)l * 4 * 128 * 128; const bf16* WPT = (const bf16*)(ws + WS_WPT) + (size_t)l * 4 * 64 * 64;
                mix::mix_phase(lds, vl, G, ((bf16*)(ws + WS_VS)), ((bf16*)(ws + WS_U)), ((bf16*)(ws + WS_P)), ((bf16*)(ws + WS_ACT)), ka->in[5] + l * SGW, WSP, ka->in[7] + l * 4 * 128, WPT, wave, lane);
            }
#endif
        }
        SEAM(pb + 1);
#ifndef NO_G2
        for (int rr_ = 0; rr_ < REP_G2; ++rr_)
        if (IN(pb + 2)) {
            KArgs ka = KARGS(); unsigned char* ws = ka->ws;
            LAUNDER_BX(); pg8::Gemm g{((bf16*)(ws + WS_ACT)), ((const bf16*)(ws + WS_W2T) + (size_t)l * D * D), D}; pg8::StaticOrder So; So.init(M, D, G, bx);
            pg8::EpiG2 E{(const unsigned char*)(ws + WS_GATES), ((bf16*)(ws + WS_MERGED))};
            pg8::gemm_phase<pg8::EpiG2, pg8::StaticOrder, false>(lds, g, So, E, nullptr, wave * 64 + lane_id_v(), ka->mode);
        }
#endif
        SEAM(pb + 2);
#ifndef NO_G3
        for (int rr_ = 0; rr_ < (l == 0 ? REP_G3L0 : 1); ++rr_)
        if (IN(pb + 3)) {
            KArgs ka = KARGS(); unsigned char* ws = ka->ws;
            LAUNDER_BX(); pg8::Gemm g{((bf16*)(ws + WS_MERGED)), ((const bf16*)(ws + WS_W3T) + (size_t)l * D * D), D}; pg8::StaticOrder So; So.init(M, D, G, bx);
            pg8::EpiG3 E{((bf16*)(ws + WS_XB)), (unsigned char*)(ws + WS_XB8)};
            pg8::gemm_phase<pg8::EpiG3, pg8::StaticOrder, false>(lds, g, So, E, nullptr, wave * 64 + lane_id_v(), ka->mode);
        }
#endif
        SEAM(pb + 3);
        for (int rr_ = 0; rr_ < REP_ROUTER; ++rr_)
        if (IN(pb + 4)) {
            KArgs ka = KARGS(); unsigned char* ws = ka->ws;
            const int lane = lane_id_v(), fr = lane & 15, fq = lane >> 4, gw = vcu * NWAVES + wave;
            const bf16* wh = (const bf16*)(ws + WS_WRT) + (size_t)l * 2 * NE * D + (size_t)fr * D + 8 * fq; const bf16* wl = wh + NE * D;
            const bf16* xbp = (const bf16*)(ws + WS_XB); float* AFFTp = (float*)(ws + WS_AFFT); float* r2p = (float*)(ws + WS_R2);
            for (int tile = gw; tile < M / 16; tile += NGW) {
                const int row0 = tile * 16; const bf16* xa = xbp + (size_t)(row0 + fr) * D + 8 * fq;
                f32x4 acc = (f32x4){0.f, 0.f, 0.f, 0.f}; float ss = 0.f;
#pragma unroll 8
                for (int ks = 0; ks < 32; ++ks) {
                    const bf16x8 a = *(const bf16x8*)(xa + 32 * ks); const bf16x8 bh = *(const bf16x8*)(wh + 32 * ks), bl = *(const bf16x8*)(wl + 32 * ks);
                    acc = __builtin_amdgcn_mfma_f32_16x16x32_bf16(a, bh, acc, 0, 0, 0); acc = __builtin_amdgcn_mfma_f32_16x16x32_bf16(a, bl, acc, 0, 0, 0);
#pragma unroll
                    for (int j = 0; j < 8; ++j) { const float v = bf2f((unsigned short)a[j]); ss += v * v; }
                }
                ss += xor16_f(ss); ss = sum32_f(ss);
                const float r = 1.0f / sqrtf(ss * (1.0f / D) + EPS);
                f32x4 aff;
#pragma unroll
                for (int rg = 0; rg < 4; ++rg) { const float rt = __builtin_bit_cast(float, __builtin_amdgcn_ds_bpermute((4 * fq + rg) * 4, __builtin_bit_cast(int, r)));
                    const float lg = acc[rg] * rt; const float mx = row16_max(lg); const float pe = expf(lg - mx); aff[rg] = pe / row16_sum(pe); }
                const int b = row0 >> 11, s0 = row0 & (S - 1);
                *(f32x4*)(AFFTp + ((size_t)b * NE + fr) * S + s0 + 4 * fq) = aff;
                if (fq == 0) r2p[row0 + fr] = r;
            }
        }
        SEAM(pb + 4);
        for (int rr_ = 0; rr_ < REP_TOPK; ++rr_)
        if (IN(pb + 5)) {
            KArgs ka = KARGS(); unsigned char* ws = ka->ws;
            const int lane = lane_id_v(), gw = vcu * NWAVES + wave;
            for (int u = gw; u < NB * NE; u += NGW) {
                const int b = u / NE, e = u % NE;
                const float* a = ((float*)(ws + WS_AFFT)) + (size_t)u * S; unsigned key[32];
#pragma unroll
                for (int j = 0; j < 32; ++j) key[j] = __builtin_bit_cast(unsigned, a[64 * j + lane]);
                float r2v[32];
#pragma unroll
                for (int j = 0; j < 32; ++j) r2v[j] = ((const float*)(ws + WS_R2))[b * S + 64 * j + lane];
                unsigned T = 0;
                for (int bit = 31; bit >= 0; --bit) { const unsigned cand = T | (1u << bit); int cnt = 0;
#pragma unroll
                    for (int j = 0; j < 32; ++j) cnt += (key[j] >= cand) ? 1 : 0;
                    cnt = wave_sum_i(cnt);
                    if (cnt >= CAP) T = cand; }
                int cgt = 0;
#pragma unroll
                for (int j = 0; j < 32; ++j) cgt += (key[j] > T) ? 1 : 0;
                cgt = wave_sum_i(cgt);
                const int need_eq = CAP - cgt; int eq_base = 0, base = 0;
                const size_t slot0 = ((size_t)e * NB + b) * CAP;
                short* inv = ((short*)(ws + WS_INV)) + (size_t)u * S;
#pragma unroll
                for (int j = 0; j < 32; ++j) {
                    const bool iseq = key[j] == T; const unsigned long long eqb = __ballot(iseq);
                    const int eqrank = eq_base + __builtin_popcountll(eqb & ((1ull << lane) - 1ull)); eq_base += __builtin_popcountll(eqb);
                    const bool sel = (key[j] > T) || (iseq && eqrank < need_eq);
                    const unsigned long long sb = __ballot(sel);
                    const int pos = base + __builtin_popcountll(sb & ((1ull << lane) - 1ull)); base += __builtin_popcountll(sb);
                    const int sp = 64 * j + lane;
                    if (sel) { ((int*)(ws + WS_IDX))[slot0 + pos] = b * S + sp; ((float*)(ws + WS_VSEL))[slot0 + pos] = __builtin_bit_cast(float, key[j]); ((float*)(ws + WS_RSEL))[slot0 + pos] = r2v[j]; }
                    inv[sp] = sel ? (short)pos : (short)-1;
                }
            }
        }
        SEAM(pb + 5);
#ifndef NO_UP
        for (int rr_ = 0; rr_ < REP_UP; ++rr_)
        if (IN(pb + 6)) {
            KArgs ka = KARGS(); unsigned char* ws = ka->ws;
            LAUNDER_BX(); pg8::Gemm g{((const bf16*)(ws + WS_XB8)), ((const bf16*)(ws + WS_WUP)), D / 2}; pg8::MoeOrder So{8, G, bx};
            pg8::EpiUp E{((float*)(ws + WS_RSEL)), (unsigned char*)(ws + WS_H)};
            pg8::gemm_phase<pg8::EpiUp, pg8::MoeOrder, true>(lds, g, So, E, ((int*)(ws + WS_IDX)), wave * 64 + lane_id_v(), ka->mode, pg8::NoHook(), (const float*)(ws + WS_RSEL));
        }
#endif
        SEAM(pb + 6);
#ifndef NO_DOWN
        for (int rr_ = 0; rr_ < REP_DOWN; ++rr_)
        if (IN(pb + 7)) {
            KArgs ka = KARGS(); unsigned char* ws = ka->ws;
            LAUNDER_BX(); pg8::Gemm g{((const bf16*)(ws + WS_H)), ((const bf16*)(ws + WS_WDN)), FF / 2}; pg8::MoeOrder So{4, G, bx};
            pg8::EpiDown E{((float*)(ws + WS_VSEL)), ((bf16*)(ws + WS_Y))};
            pg8::gemm_phase<pg8::EpiDown, pg8::MoeOrder, false>(lds, g, So, E, nullptr, wave * 64 + lane_id_v(), ka->mode, pg8::NoHook(), (const float*)(ws + WS_VSEL));
        }
#endif
        SEAM(pb + 7);
        if (IN(pb + 8)) {
            KArgs ka = KARGS(); unsigned char* ws = ka->ws;
            const int lane = lane_id_v(), gw = vcu * NWAVES + wave; const bool last_layer = (l == DEPTH - 1);
            bf16* xbp = (bf16*)(ws + WS_XB); const bf16* Yp = (const bf16*)(ws + WS_Y); const short* INVp = (const short*)(ws + WS_INV); float* r1p = (float*)(ws + WS_R1);
            f32x4 gfin[4];
#pragma unroll
            for (int j = 0; j < 4; ++j) gfin[j] = last_layer ? *((const f32x4*)ka->in[19] + lane + 64 * j) : (f32x4){1.f, 1.f, 1.f, 1.f};
            for (int m = gw; m < M; m += NGW) {
                const int b = m >> 11, sp = m & (S - 1);
                const int myc = INVp[((size_t)b * NE + (lane & 15)) * S + sp];
                u32x2* xr = (u32x2*)(xbp + (size_t)m * D) + lane; f32x4 v[4];
#pragma unroll
                for (int j = 0; j < 4; ++j) { const u32x2 w = xr[64 * j]; v[j] = (f32x4){bflo(w.x), bfhi(w.x), bflo(w.y), bfhi(w.y)}; }
                unsigned emask = (unsigned)(__ballot(myc >= 0) & 0xffffull);
                while (emask) {
                    u32x2 y[4][4]; int ne = 0;
#pragma unroll
                    for (int q = 0; q < 4; ++q) { if (emask) { const int e = __builtin_ctz(emask); emask &= emask - 1u; const int c = __builtin_amdgcn_readlane(myc, e);
                            const u32x2* yr = (const u32x2*)(Yp + (((size_t)e * NB + b) * CAP + c) * D) + lane;
#pragma unroll
                            for (int j = 0; j < 4; ++j) y[q][j] = yr[64 * j]; ne = q + 1; }
                        else {
#pragma unroll
                            for (int j = 0; j < 4; ++j) y[q][j] = (u32x2){0u, 0u}; } }
#pragma unroll
                    for (int q = 0; q < 4; ++q)
#pragma unroll
                        for (int j = 0; j < 4; ++j) { v[j].x += bflo(y[q][j].x); v[j].y += bfhi(y[q][j].x); v[j].z += bflo(y[q][j].y); v[j].w += bfhi(y[q][j].y); }
                }
                if (last_layer) {
                    float ss = 0.f;
#pragma unroll
                    for (int j = 0; j < 4; ++j) ss += v[j].x * v[j].x + v[j].y * v[j].y + v[j].z * v[j].z + v[j].w * v[j].w;
                    ss = wave_sum(ss); const float r = 1.0f / sqrtf(ss * (1.0f / D) + EPS);
                    f32x4* orow = (f32x4*)(ka->out + (size_t)m * D) + lane;
#pragma unroll
                    for (int j = 0; j < 4; ++j) orow[64 * j] = v[j] * r * gfin[j];
                } else {
                    float ss = 0.f;
                    unsigned* x8r = (unsigned*)(ws + WS_XB8 + (size_t)m * D) + lane;
#pragma unroll
                    for (int j = 0; j < 4; ++j) { u32x2 w; w.x = pk2(v[j].x, v[j].y); w.y = pk2(v[j].z, v[j].w); xr[64 * j] = w; x8r[64 * j] = pk4_fp8(v[j]);
                        const float a0 = bflo(w.x), a1 = bfhi(w.x), a2 = bflo(w.y), a3 = bfhi(w.y); ss += a0 * a0 + a1 * a1 + a2 * a2 + a3 * a3; }
                    ss = wave_sum(ss);
                    if (lane == 0) r1p[m] = 1.0f / sqrtf(ss * (1.0f / D) + EPS);
                }
            }
        }
        SEAM(pb + 8);
    }
#undef IN
#undef SEAM
}

#ifndef OPT_G1
#define OPT_G1 1
#endif
#ifndef OPT_G2
#define OPT_G2 1
#endif
#ifndef OPT_G3
#define OPT_G3 1
#endif
#ifndef OPT_UP
#define OPT_UP 1
#endif
#ifndef OPT_DOWN
#define OPT_DOWN 1
#endif
extern "C" void kernel_launch(void* const* d_in, const int* in_sizes, int n_in, void* d_out, int out_size, void* d_ws, size_t ws_size, hipStream_t stream) {
    if (n_in != 20 || ws_size < WS_END) { fprintf(stderr, "kernel_launch: unexpected n_in %d / ws_size %zu\n", n_in, ws_size); return; }
    static int grid = 0;
    if (grid == 0) {
        int dev = 0, cus = 0;
        if (hipGetDevice(&dev) != hipSuccess || hipDeviceGetAttribute(&cus, hipDeviceAttributeMultiprocessorCount, dev) != hipSuccess) { grid = -1; return; }
        if (hipFuncSetAttribute((const void*)mk_fwd, hipFuncAttributeMaxDynamicSharedMemorySize, LDS_BYTES) != hipSuccess) { fprintf(stderr, "hipFuncSetAttribute failed\n"); grid = -1; return; }
        (void)hipGetLastError();
        grid = cus;
    }
    if (grid < 0) return;
    unsigned char* ws = (unsigned char*)d_ws;
    static_assert((CW_BAR + XCD_BAR_WORDS) * 4 <= 32768, "barrier words inside the cleared block");
    (void)hipMemsetAsync(ws + WS_CTL, 0, 32768, stream);
    MkArgs a{};
    for (int i = 0; i < 20; ++i) a.in[i] = (const float*)d_in[i];
    a.out = (float*)d_out; a.ws = ws;
    auto run = [&](int lo, int hi, int sub, int mode = 0) { MkArgs b = a; b.ph_lo = lo; b.ph_hi = hi; b.sub = sub; b.mode = mode; hipLaunchKernelGGL(mk_fwd, dim3(grid), dim3(NWAVES * 64), LDS_BYTES, stream, b); };
#ifndef MK_MULTI
#define MK_MULTI 0
#endif
    if (!MK_MULTI) { run(0, PH_TOTAL, 7); return; }
#ifndef PROBE_DUP_PH
#define PROBE_DUP_PH -1
#endif
#ifndef PROBE_DUP_MODE
#define PROBE_DUP_MODE 0
#endif
#ifndef PROBE_DUP_SUB
#define PROBE_DUP_SUB 7
#endif
    if (MK_MULTI == 2) {
        run(0, 1, 0); if (PROBE_DUP_PH == -2) run(0, 1, 0);
        for (int l = 0; l < DEPTH; ++l) { const int pb = 1 + l * PH_PER_LAYER;
            for (int k = 0; k < PH_PER_LAYER; ++k) { run(pb + k, pb + k + 1, 7);
                if (k == PROBE_DUP_PH && (k != 3 || PROBE_DUP_MODE != 0) && k != 8) run(pb + k, pb + k + 1, PROBE_DUP_SUB, PROBE_DUP_MODE); } }
        return;
    }
}
```

```cpp
#include <hip/hip_runtime.h>
#include <hip/hip_bf16.h>
#include <stdint.h>
#include <stdio.h>

#define DEVI __device__ __forceinline__
typedef unsigned short bf16;
typedef short bf16x8 __attribute__((ext_vector_type(8)));
typedef float f32x4 __attribute__((ext_vector_type(4)));
typedef unsigned u32x4 __attribute__((ext_vector_type(4)));
typedef unsigned u32x2 __attribute__((ext_vector_type(2)));

constexpr int NB = 32, S = 2048, D = 1024, M = NB * S, DEPTH = 2;
constexpr int INW = 4608, QW = 512, KVW = 128, SGW = 256, PLW = 256, GW = 3072;
constexpr int NE = 16, CAP = 256, FF = 1024, NSLOT = NB * NE * CAP;
constexpr float EPS = 1e-6f;
constexpr float C2 = 0.125f * 1.4426950408889634f;

constexpr size_t MiB = 1u << 20;
constexpr size_t WS_CTL = 0;
constexpr size_t WS_ROPE = 1 * MiB;
constexpr size_t WS_R1 = WS_ROPE + 64 * 1024;
constexpr size_t WS_R2 = WS_R1 + 256 * 1024;
constexpr size_t WS_IDX = WS_R2 + 256 * 1024;
constexpr size_t WS_VSEL = WS_IDX + 512 * 1024;
constexpr size_t WS_RSEL = WS_VSEL + 512 * 1024;
constexpr size_t WS_INV = 4 * MiB;
constexpr size_t WS_AFFT = 6 * MiB;
constexpr size_t WS_WSP = 10 * MiB;
constexpr size_t WS_WPT = 10 * MiB + 512 * 1024;
constexpr size_t WS_WRT = 11 * MiB;
constexpr size_t WS_W1T = 12 * MiB;
constexpr size_t WS_W2T = 30 * MiB;
constexpr size_t WS_W3T = 34 * MiB;
constexpr size_t WS_WUP = 40 * MiB;
constexpr size_t WS_WDN = 104 * MiB;
constexpr size_t WS_XB = 136 * MiB;
constexpr size_t WS_GATES = 264 * MiB;
constexpr size_t WS_H = WS_GATES;
constexpr size_t WS_XB8 = 520 * MiB;
constexpr size_t WS_W1G8_OFF = 3 * MiB;
constexpr float HSCALE = 16.0f, W8SCALE = 64.0f;
constexpr float GSCALE = 32.0f;
constexpr size_t WS_Q = 648 * MiB;
constexpr size_t WS_K = WS_Q + 64 * MiB;
constexpr size_t WS_V = WS_K + 16 * MiB;
constexpr size_t WS_U = WS_V + 16 * MiB;
constexpr size_t WS_VS = WS_U + 32 * MiB;
constexpr size_t WS_P = WS_VS + 32 * MiB;
constexpr size_t WS_ACT = 840 * MiB;
constexpr size_t WS_MERGED = WS_Q;
constexpr size_t WS_Y = WS_Q;
constexpr size_t WS_END = 968 * MiB;
static_assert(WS_P + 32 * MiB == WS_ACT && WS_ACT + 128 * MiB == WS_END, "ws map");

DEVI unsigned f2bf(float f) { unsigned u = __builtin_bit_cast(unsigned, f); return (u + 0x7fffu + ((u >> 16) & 1u)) >> 16; }
DEVI unsigned pk2(float lo, float hi) { return f2bf(lo) | (f2bf(hi) << 16); }
DEVI float bf2f(unsigned short h) { return __builtin_bit_cast(float, (unsigned)h << 16); }
DEVI float bflo(unsigned w) { return __builtin_bit_cast(float, w << 16); }
DEVI float bfhi(unsigned w) { return __builtin_bit_cast(float, w & 0xffff0000u); }
DEVI int dpp_qx1(int v) { return __builtin_amdgcn_update_dpp(0, v, 0xB1, 0xF, 0xF, true); }
DEVI int dpp_qx2(int v) { return __builtin_amdgcn_update_dpp(0, v, 0x4E, 0xF, 0xF, true); }
DEVI int dpp_hmir(int v) { return __builtin_amdgcn_update_dpp(0, v, 0x141, 0xF, 0xF, true); }
DEVI int dpp_mir(int v) { return __builtin_amdgcn_update_dpp(0, v, 0x140, 0xF, 0xF, true); }
DEVI int swz_x16(int v) { return __builtin_amdgcn_ds_swizzle(v, 0x401F); }
DEVI float xor16_f(float v) { return __builtin_bit_cast(float, swz_x16(__builtin_bit_cast(int, v))); }
DEVI float sum32_f(float v) { unsigned a = __builtin_bit_cast(unsigned, v), b = a; asm volatile("" : "+v"(b)); auto r = __builtin_amdgcn_permlane32_swap(a, b, false, false); const unsigned r0 = r[0], r1 = r[1]; return __builtin_bit_cast(float, r0) + __builtin_bit_cast(float, r1); }
DEVI int sum32_i(int v) { unsigned a = (unsigned)v, b = a; asm volatile("" : "+v"(b)); auto r = __builtin_amdgcn_permlane32_swap(a, b, false, false); return (int)(r[0] + r[1]); }
DEVI float wave_sum(float v) {
    v += __builtin_bit_cast(float, dpp_qx1(__builtin_bit_cast(int, v))); v += __builtin_bit_cast(float, dpp_qx2(__builtin_bit_cast(int, v)));
    v += __builtin_bit_cast(float, dpp_hmir(__builtin_bit_cast(int, v))); v += __builtin_bit_cast(float, dpp_mir(__builtin_bit_cast(int, v)));
    v += xor16_f(v); return sum32_f(v);
}
DEVI int wave_sum_i(int v) {
    v += dpp_qx1(v); v += dpp_qx2(v); v += dpp_hmir(v); v += dpp_mir(v); v += swz_x16(v); return sum32_i(v);
}

__host__ __device__ __forceinline__ int g1_logical(int pos) {
    const int pn = pos >> 8, p = pos & 255, bj = p >> 7, wc = (p >> 5) & 3, r = p & 31, fq = r >> 3, low = r & 7;
    const int d = 32 * (fq >> 1) + 16 * bj + 8 * (fq & 1) + low;
    if (pn < 2) return 64 * (4 * pn + wc) + d;
    if (pn == 2) { if (wc < 2) return 512 + 64 * wc + d; return 640 + (wc - 2) * 64 + bj * 32 + r; }
    return pos;
}
__host__ __device__ __forceinline__ int g1_pos(int c) {
    if (c < 640) { const int head = c >> 6, d = c & 63, a = d >> 5, hf = (d >> 4) & 1, f8 = (d >> 3) & 1, low = d & 7;
        const int fq = 2 * a + f8, r = 8 * fq + low, pn = (c < 512) ? (head >> 2) : 2, wc = (c < 512) ? (head & 3) : (head - 8);
        return 256 * pn + 128 * hf + 32 * wc + r; }
    if (c < 768) { const int v = c - 640, wc = 2 + (v >> 6), bj = (v >> 5) & 1, r = v & 31; return 512 + 128 * bj + 32 * wc + r; }
    return c;
}

DEVI float dppf_qx1(float v) { return __builtin_bit_cast(float, dpp_qx1(__builtin_bit_cast(int, v))); }
DEVI float dppf_qx2(float v) { return __builtin_bit_cast(float, dpp_qx2(__builtin_bit_cast(int, v))); }
DEVI float dppf_hmir(float v) { return __builtin_bit_cast(float, dpp_hmir(__builtin_bit_cast(int, v))); }
DEVI float dppf_mir(float v) { return __builtin_bit_cast(float, dpp_mir(__builtin_bit_cast(int, v))); }
DEVI float row16_sum(float v) { v += dppf_qx1(v); v += dppf_qx2(v); v += dppf_hmir(v); v += dppf_mir(v); return v; }
DEVI float row16_max(float v) { v = fmaxf(v, dppf_qx1(v)); v = fmaxf(v, dppf_qx2(v)); v = fmaxf(v, dppf_hmir(v)); v = fmaxf(v, dppf_mir(v)); return v; }

DEVI unsigned pk4_fp8(const f32x4 v) { int p = 0; p = __builtin_amdgcn_cvt_pk_fp8_f32(v.x, v.y, p, false); p = __builtin_amdgcn_cvt_pk_fp8_f32(v.z, v.w, p, true); return (unsigned)p; }

#define GAS __attribute__((address_space(1)))
#define LAS __attribute__((address_space(3)))
#define LDS_WAIT() asm volatile("s_waitcnt lgkmcnt(0)" ::: "memory")
#define VM_WAIT() asm volatile("s_waitcnt vmcnt(0)" ::: "memory")
typedef GAS unsigned gu32;
#define RLX_AGENT __ATOMIC_RELAXED, __HIP_MEMORY_SCOPE_AGENT
constexpr int NWAVES = 8;
DEVI int lane_id_v() { int l; asm volatile("v_mbcnt_lo_u32_b32 %0, -1, 0\n\tv_mbcnt_hi_u32_b32 %0, -1, %0" : "=v"(l)); return l; }

namespace pg8 {
constexpr int BM = 256, BK = 64, HALF = 128, HTB = HALF * BK * 2, STAGE_BYTES = 8 * HTB, NXCD = 8, WGM = 8, GIDX_OFF = STAGE_BYTES;
__host__ __device__ __forceinline__ int lds_byte(int r, int c) { const int st = (r >> 4) * 2 + (c >> 5), rr = r & 15, cc = c & 31, ob = rr * 64 + cc * 2; return st * 1024 + (ob ^ (((ob >> 9) & 1) << 5)); }
__host__ __device__ __forceinline__ void stage_rc(int b, int& R, int& C) { const int st = b / 1024, sb = b % 1024, swz = sb ^ (((sb >> 9) & 1) << 5); R = (st >> 1) * 16 + swz / 64; C = (st & 1) * 32 + (swz % 64) / 2; }
__host__ __device__ __forceinline__ int perm32(int rho) { const int n = rho >> 4, i = rho & 15; return 8 * (i >> 2) + 4 * n + (i & 3); }
struct Unit { int pm, pn; };
struct Gemm { const bf16* A; const bf16* Bt; int K; };
struct StaticOrder {
    int nM, nN, nwg, G, c;
    __device__ void init(int M_, int N_, int G_, int c_) { nM = M_ / BM; nN = N_ / BM; nwg = nM * nN; G = G_; c = c_; }
    __device__ bool next(int i, Unit& u) const {
        const long L = (long)i * G + c; if (L >= nwg) return false;
        int wgid = (int)L; { const int q = nwg / NXCD, r = nwg % NXCD, xcd = wgid % NXCD, off = wgid / NXCD; wgid = (xcd < r ? xcd * (q + 1) : r * (q + 1) + (xcd - r) * q) + off; }
        const int nig = WGM * nN, gid = wgid / nig, fm = gid * WGM, gsz = (nM - fm) < WGM ? (nM - fm) : WGM;
        u.pm = fm + ((wgid % nig) % gsz); u.pn = (wgid % nig) / gsz; return true;
    }
};
struct MoeOrder {
    int NJ, G, c;
    __device__ bool next(int i, Unit& u) const {
        const long L = (long)i * G + c; const int per = 32 * NJ; if (L >= (long)NE * per) return false;
        const int e = (int)(L / per), w = (int)(L % per), x = w & 7, q = w >> 3, b = x * 4 + q / NJ, j = q % NJ;
        u.pm = e * 32 + b; u.pn = e * NJ + j; return true;
    }
};
DEVI unsigned cvt_pk_bf16(float lo, float hi) { unsigned r; asm volatile("v_cvt_pk_bf16_f32 %0, %1, %2" : "=v"(r) : "v"(lo), "v"(hi)); return r; }
typedef f32x4 Acc[2][2][4][2];

struct NoHook { DEVI void operator()(int) const {} };
typedef int v4i_t __attribute__((ext_vector_type(4))); typedef int v8i_t __attribute__((ext_vector_type(8)));
DEVI v8i_t cat8(const v4i_t x, const v4i_t y) { return __builtin_shufflevector(x, y, 0, 1, 2, 3, 4, 5, 6, 7); }
template <class Epi, class Sched, bool GATHER, class Hook = NoHook>
DEVI void gemm_phase(LAS unsigned char* lds, const Gemm g, const Sched& S, const Epi& E, const int* __restrict__ gidx, int tid, int mode = 0, const Hook& H = Hook(), const float* __restrict__ rs = nullptr) {
    asm volatile("" : "+v"(tid));
    const int wid = __builtin_amdgcn_readfirstlane(tid >> 6), lane = tid & 63, wr = wid >> 2, wc = wid & 3, fr = lane & 15, fq = lane >> 4;
    int K = g.K; asm volatile("" : "+s"(K));
    const int nt = K / BK;
    unsigned voffA[2], voffB[2]; int RA[2]; unsigned CA2[2];
#pragma unroll
    for (int i = 0; i < 2; ++i) { int R, C; stage_rc(tid * 16 + i * 8192, R, C); const int Rb = (R & ~31) + perm32(R & 31);
        voffA[i] = (unsigned)(R * K + C) * 2u; voffB[i] = (unsigned)(Rb * K + C) * 2u; RA[i] = R; CA2[i] = (unsigned)C * 2u; }
    const size_t kstep = (size_t)(BK * 2);
    const size_t hstep = (size_t)HALF * K * 2;
    const size_t tstep = 2 * hstep;
    const unsigned ldsw = (unsigned)wid * 1024u;
    const int aoff = lds_byte(wr * 64 + fr, fq * 8), boff = lds_byte(wc * 32 + fr, fq * 8);
#define PG8_SA(b, h) (((b) * 2 + (h)) * HTB)
#define PG8_SB(b, h) ((4 + (b) * 2 + (h)) * HTB)
#define PG8_STAGE(bufoff, gbase, voff) do { _Pragma("unroll") for (int _i = 0; _i < 2; ++_i) \
        __builtin_amdgcn_global_load_lds((const unsigned*)((const char*)(gbase) + (voff)[_i]), (LAS unsigned*)(lds + (bufoff) + ldsw + _i * 8192), 16, 0, 0); } while (0)
#define PG8_STAGEA(bufoff, kbase, h, V) do { if constexpr (GATHER) { PG8_STAGE(bufoff, kbase, (V)[h]); } else { PG8_STAGE(bufoff, (kbase) + (h) * hstep, voffA); } } while (0)
#define PG8_LDA(dst, b, h) do { if constexpr (Epi::FP8) { _Pragma("unroll") for (int m = 0; m < 4; ++m) dst##8[m] = cat8(*(const LAS v4i_t*)(lds + PG8_SA(b, h) + aoff + m * 2048), *(const LAS v4i_t*)(lds + PG8_SA(b, h) + aoff + m * 2048 + 1024)); } \
        else { _Pragma("unroll") for (int m = 0; m < 4; ++m) _Pragma("unroll") for (int k = 0; k < 2; ++k) dst[m][k] = *(const LAS bf16x8*)(lds + PG8_SA(b, h) + aoff + m * 2048 + k * 1024); } } while (0)
#define PG8_LDB(dst, b, h) do { if constexpr (Epi::FP8) { _Pragma("unroll") for (int n = 0; n < 2; ++n) dst##8[n] = cat8(*(const LAS v4i_t*)(lds + PG8_SB(b, h) + boff + n * 2048), *(const LAS v4i_t*)(lds + PG8_SB(b, h) + boff + n * 2048 + 1024)); } \
        else { _Pragma("unroll") for (int n = 0; n < 2; ++n) _Pragma("unroll") for (int k = 0; k < 2; ++k) dst[n][k] = *(const LAS bf16x8*)(lds + PG8_SB(b, h) + boff + n * 2048 + k * 1024); } } while (0)
#define PG8_MMA(ai, bj, At, Bt) do { __builtin_amdgcn_s_setprio(1); _Pragma("unroll") for (int m = 0; m < 4; ++m) _Pragma("unroll") for (int n = 0; n < 2; ++n) { \
        if constexpr (Epi::FP8) { asm volatile("v_mfma_scale_f32_16x16x128_f8f6f4 %0, %1, %2, %0, %3, %3 op_sel_hi:[0,0,0]" : "+v"(acc[ai][bj][m][n]) : "v"(Bt##8[n]), "v"(At##8[m]), "v"(one_scale)); } \
        else { _Pragma("unroll") for (int k = 0; k < 2; ++k) acc[ai][bj][m][n] = __builtin_amdgcn_mfma_f32_16x16x32_bf16(Bt[n][k], At[m][k], acc[ai][bj][m][n], 0, 0, 0); } } \
        __builtin_amdgcn_s_setprio(0); } while (0)
#define PG8_WAIT_V(n) asm volatile("s_waitcnt vmcnt(" #n ")" ::: "memory")
#define PG8_WAIT_L(n) asm volatile("s_waitcnt lgkmcnt(" #n ")" ::: "memory")
#define PG8_BAR __builtin_amdgcn_s_barrier()
#define PG8_SCHED __builtin_amdgcn_sched_barrier(0)
#define PG8_LOADV(dst, un) do { _Pragma("unroll") for (int _h = 0; _h < 2; ++_h) _Pragma("unroll") for (int _i = 0; _i < 2; ++_i) \
        dst[_h][_i] = (unsigned)gidx[(un).pm * 256 + _h * 128 + RA[_i]] * (unsigned)(K * 2) + CA2[_i]; } while (0)
#define PG8_DMAV(un) do { _Pragma("unroll") for (int _h = 0; _h < 2; ++_h) _Pragma("unroll") for (int _i = 0; _i < 2; ++_i) \
        __builtin_amdgcn_global_load_lds((const unsigned*)(gidx + (un).pm * 256 + _h * 128 + RA[_i]), (LAS unsigned*)(lds + GIDX_OFF + ((_h * 2 + _i) * 8 + wid) * 256), 4, 0, 0); } while (0)
#define PG8_READV(dst) do { _Pragma("unroll") for (int _h = 0; _h < 2; ++_h) _Pragma("unroll") for (int _i = 0; _i < 2; ++_i) \
        dst[_h][_i] = *(const LAS unsigned*)(lds + GIDX_OFF + ((_h * 2 + _i) * 8 + wid) * 256 + lane * 4) * (unsigned)(K * 2) + CA2[_i]; } while (0)
    Unit cur, nxt; int ui = 0;
    if (!S.next(0, cur)) return;
    Acc acc;
#pragma unroll
    for (int a = 0; a < 2; ++a)
#pragma unroll
        for (int b = 0; b < 2; ++b)
#pragma unroll
            for (int m = 0; m < 4; ++m)
#pragma unroll
                for (int n = 0; n < 2; ++n) acc[a][b][m][n] = (f32x4){0.f, 0.f, 0.f, 0.f};
    bf16x8 At[4][2], B0[2][2], B1[2][2];
    v8i_t At8[4], B08[2], B18[2];
    int one_scale = 0x7f7f7f7f; asm volatile("" : "+v"(one_scale));
    float rsv[8] = {0.f, 0.f, 0.f, 0.f, 0.f, 0.f, 0.f, 0.f};
    unsigned vAc[2][2] = {{0u, 0u}, {0u, 0u}};
    if constexpr (GATHER) { PG8_LOADV(vAc, cur); }
    const char* cA = GATHER ? (const char*)g.A : (const char*)g.A + (size_t)cur.pm * tstep; const char* cB = (const char*)g.Bt + (size_t)cur.pn * tstep;
    PG8_STAGE(PG8_SB(0, 0), cB, voffB); PG8_STAGE(PG8_SB(0, 1), cB + hstep, voffB); PG8_STAGEA(PG8_SA(0, 0), cA, 0, vAc); PG8_STAGEA(PG8_SA(0, 1), cA, 1, vAc);
    if (wr == 1) PG8_BAR;
    PG8_WAIT_V(2); PG8_BAR;
    PG8_STAGE(PG8_SB(1, 0), cB + kstep, voffB); PG8_STAGEA(PG8_SA(1, 0), cA + kstep, 0, vAc); PG8_STAGE(PG8_SB(1, 1), cB + hstep + kstep, voffB);
    PG8_WAIT_V(6); PG8_BAR;
    for (;;) {
        const bool has_next = S.next(ui + 1, nxt);
        if constexpr (GATHER) { if (has_next) { PG8_DMAV(nxt); } }
        const char* nA = GATHER ? (const char*)g.A : (has_next ? (const char*)g.A + (size_t)nxt.pm * tstep : cA);
        const char* nB = has_next ? (const char*)g.Bt + (size_t)nxt.pn * tstep : cB;
        for (int t = 0; t < nt; t += 2) {
            if constexpr (Epi::HAS_MID) { if ((t == Epi::MID0 || t == Epi::MID1) && !(mode & 2)) E.mid(acc, cur, t, wr, wc, fr, fq); }
            const bool last = (t == nt - 2);
            if constexpr (Epi::HAS_RS) { if (last) {
#pragma unroll
                for (int k = 0; k < 8; ++k) rsv[k] = rs[cur.pm * BM + (k >> 2) * HALF + wr * 64 + (k & 3) * 16 + fr]; } }
            const char* a1 = cA + (size_t)(t + 1) * kstep;
            const char* a2 = last ? nA : cA + (size_t)(t + 2) * kstep; const char* b2 = last ? nB : cB + (size_t)(t + 2) * kstep;
            const char* a3 = a2 + kstep; const char* b3 = b2 + kstep;
            PG8_LDB(B0, 0, 0); PG8_LDB(B1, 0, 1); PG8_SCHED; PG8_LDA(At, 0, 0); PG8_STAGEA(PG8_SA(1, 1), a1, 1, vAc);
            PG8_WAIT_V(8); PG8_WAIT_L(0); PG8_BAR; PG8_MMA(0, 0, At, B0); PG8_MMA(0, 1, At, B1); PG8_BAR; PG8_SCHED;
            if constexpr (GATHER) { if (last && has_next) { PG8_READV(vAc); } }
            PG8_LDA(At, 0, 1); PG8_STAGE(PG8_SB(0, 0), b2, voffB); PG8_STAGE(PG8_SB(0, 1), b2 + hstep, voffB); PG8_STAGEA(PG8_SA(0, 0), a2, 0, vAc);
            PG8_WAIT_V(8); PG8_WAIT_L(0); PG8_BAR; PG8_MMA(1, 0, At, B0); PG8_MMA(1, 1, At, B1); PG8_BAR; PG8_SCHED;
            PG8_LDB(B0, 1, 0); PG8_LDB(B1, 1, 1); PG8_SCHED; PG8_LDA(At, 1, 0); PG8_STAGEA(PG8_SA(0, 1), a2, 1, vAc);
            PG8_WAIT_V(8); PG8_WAIT_L(0); PG8_BAR; PG8_MMA(0, 0, At, B0); PG8_MMA(0, 1, At, B1); PG8_BAR; PG8_SCHED;
            PG8_LDA(At, 1, 1); PG8_STAGE(PG8_SB(1, 0), b3, voffB); PG8_STAGE(PG8_SB(1, 1), b3 + hstep, voffB); PG8_STAGEA(PG8_SA(1, 0), a3, 0, vAc);
            PG8_WAIT_V(8); PG8_WAIT_L(0); PG8_BAR; PG8_MMA(1, 0, At, B0); PG8_MMA(1, 1, At, B1); PG8_BAR; PG8_SCHED;
        }
        if (wr == 0) PG8_BAR;
        if constexpr (Epi::FP8) asm volatile("s_nop 15\n\ts_nop 15" ::: "memory");
        if (!(mode & 1)) E(acc, cur, wr, wc, fr, fq, rsv);
        H(ui);
        if (!has_next) break;
#pragma unroll
        for (int a = 0; a < 2; ++a)
#pragma unroll
            for (int b = 0; b < 2; ++b)
#pragma unroll
                for (int m = 0; m < 4; ++m)
#pragma unroll
                    for (int n = 0; n < 2; ++n) acc[a][b][m][n] = (f32x4){0.f, 0.f, 0.f, 0.f};
        cur = nxt; cA = nA; cB = nB; ++ui;
        if (wr == 1) PG8_BAR;
    }
    PG8_WAIT_V(0);
    PG8_BAR;
#undef PG8_SA
#undef PG8_SB
#undef PG8_STAGE
#undef PG8_STAGEA
#undef PG8_LDA
#undef PG8_LDB
#undef PG8_MMA
#undef PG8_WAIT_V
#undef PG8_WAIT_L
#undef PG8_BAR
#undef PG8_SCHED
#undef PG8_LOADV
#undef PG8_DMAV
#undef PG8_READV
}

DEVI u32x4 pack8(const f32x4 a, const f32x4 b) { u32x4 w; w.x = cvt_pk_bf16(a[0], a[1]); w.y = cvt_pk_bf16(a[2], a[3]); w.z = cvt_pk_bf16(b[0], b[1]); w.w = cvt_pk_bf16(b[2], b[3]); return w; }
DEVI float sigm(float v) { v = fmaxf(v, -30.f); return __builtin_amdgcn_rcpf(1.0f + __expf(-v)); }

struct EpiG1 {
    static constexpr bool HAS_MID = false, HAS_RS = false, FP8 = false; static constexpr int MID0 = -1, MID1 = -1;
    const float* r1; const float* rope; const float* g_q; const float* g_k;
    bf16 *Q, *Kb, *V, *U, *VS, *P;
    DEVI void mid(Acc&, const Unit&, int, int, int, int, int) const {}
    DEVI void operator()(const Acc& acc, const Unit& u, int wr, int wc, int fr, int fq, const float (&rsv)[8]) const {
        asm volatile("" : "+v"(fr), "+v"(fq));
        const int row0 = u.pm * BM + wr * 64 + fr, pn = u.pn;
        float r1v[8];
#pragma unroll
        for (int k = 0; k < 8; ++k) r1v[k] = r1[row0 + (k >> 2) * HALF + (k & 3) * 16];
        if (pn < 2 || (pn == 2 && wc < 2)) {
            const bool isq = pn < 2; const float* g = isq ? g_q : g_k; const int a = fq >> 1, f0 = 8 * (fq & 1);
            f32x4 g1[2], g2[2];
#pragma unroll
            for (int n = 0; n < 2; ++n) { g1[n] = *(const f32x4*)(g + 32 * a + f0 + 4 * n); g2[n] = *(const f32x4*)(g + 32 * a + 16 + f0 + 4 * n); }
            const float osc = isq ? C2 : 1.0f;
#pragma unroll
            for (int ai = 0; ai < 2; ++ai) {
#pragma unroll
                for (int mh = 0; mh < 2; ++mh) {
                f32x4 rp4[2][4];
#pragma unroll
                for (int m2 = 0; m2 < 2; ++m2) { const int tpos_ = (row0 + ai * HALF + (mh * 2 + m2) * 16) & (S - 1), pos_ = a ? (tpos_ & 63) : (tpos_ >> 6); const f32x4* rq = (const f32x4*)(rope + 2 * (pos_ * 16 + f0));
#pragma unroll
                    for (int q = 0; q < 4; ++q) rp4[m2][q] = rq[q]; }
#pragma unroll
                for (int m2 = 0; m2 < 2; ++m2) { const int m = mh * 2 + m2;
                    const int row = row0 + ai * HALF + m * 16; const float rs = r1v[ai * 4 + m];
                    f32x4 v[2][2]; float ss = 0.f;
#pragma unroll
                    for (int bj = 0; bj < 2; ++bj)
#pragma unroll
                        for (int n = 0; n < 2; ++n) { v[bj][n] = acc[ai][bj][m][n] * rs; ss += v[bj][n][0] * v[bj][n][0] + v[bj][n][1] * v[bj][n][1] + v[bj][n][2] * v[bj][n][2] + v[bj][n][3] * v[bj][n][3]; }
                    ss += xor16_f(ss); ss = sum32_f(ss);
                    const float rn = __builtin_amdgcn_rsqf(ss * (1.0f / 64) + EPS) * osc;
                    const f32x4* rp = rp4[m2];
                    f32x4 o1[2], o2[2];
#pragma unroll
                    for (int n = 0; n < 2; ++n) { const f32x4 cs0 = rp[2 * n], cs1 = rp[2 * n + 1];
                        const f32x4 x1 = v[0][n] * rn * g1[n], x2 = v[1][n] * rn * g2[n];
                        const f32x4 c = (f32x4){cs0[0], cs0[2], cs1[0], cs1[2]}, s = (f32x4){cs0[1], cs0[3], cs1[1], cs1[3]};
                        o1[n] = x1 * c - x2 * s; o2[n] = x2 * c + x1 * s; }
                    bf16* dst = isq ? (Q + (size_t)row * QW + 64 * (4 * pn + wc)) : (Kb + (size_t)row * KVW + 64 * wc);
                    *(u32x4*)(dst + 32 * a + f0) = pack8(o1[0], o1[1]); *(u32x4*)(dst + 32 * a + 16 + f0) = pack8(o2[0], o2[1]);
                } } }
        } else {
            bf16* base; int ld, cb;
            if (pn == 2) { base = V; ld = KVW; cb = (wc - 2) * 64 + 8 * fq; }
            else if (pn == 3) { base = U; ld = SGW; cb = 32 * wc + 8 * fq; }
            else if (pn == 4) { base = VS; ld = SGW; cb = 32 * wc + 8 * fq; }
            else { base = P; ld = PLW; cb = 32 * wc + 8 * fq; }
            const int bjs = (pn == 2) ? 32 : HALF;
#pragma unroll
            for (int ai = 0; ai < 2; ++ai)
#pragma unroll
                for (int m = 0; m < 4; ++m) {
                    const int row = row0 + ai * HALF + m * 16; const float rs = r1v[ai * 4 + m];
#pragma unroll
                    for (int bj = 0; bj < 2; ++bj) *(u32x4*)(base + (size_t)row * ld + cb + bj * bjs) = pack8(acc[ai][bj][m][0] * rs, acc[ai][bj][m][1] * rs);
                }
        }
    }
};
struct EpiGate {
    static constexpr int NSTORE = 8;
    static constexpr bool HAS_MID = false, HAS_RS = false, FP8 = true; static constexpr int MID0 = -1, MID1 = -1;
    const float* r1; unsigned char* GATES8;
    DEVI void mid(Acc&, const Unit&, int, int, int, int, int) const {}
    DEVI void operator()(const Acc& acc, const Unit& u, int wr, int wc, int fr, int fq, const float (&rsv)[8]) const {
        asm volatile("" : "+v"(fr), "+v"(fq));
        const int row0 = u.pm * BM + wr * 64 + fr, pn = u.pn;
        float r1v[8];
#pragma unroll
        for (int k = 0; k < 8; ++k) r1v[k] = r1[row0 + (k >> 2) * HALF + (k & 3) * 16];
        {
            unsigned char* gbase = GATES8 + (size_t)(pn >> 2) * 1024 + (pn & 3) * 256 + 64 * wc + 16 * fq;
#pragma unroll
            for (int ai = 0; ai < 2; ++ai)
#pragma unroll
                for (int m = 0; m < 4; ++m) {
                    const int row = row0 + ai * HALF + m * 16; const float rs = r1v[ai * 4 + m] * (-1.4426950408889634f / GSCALE); u32x4 w;
#pragma unroll
                    for (int bj = 0; bj < 2; ++bj)
#pragma unroll
                        for (int n = 0; n < 2; ++n) { unsigned pkd = 0u;
#pragma unroll
                            for (int i = 0; i < 4; ++i) { const float e = __builtin_amdgcn_exp2f(acc[ai][bj][m][n][i] * rs);
                                const float q = fmaxf(__builtin_amdgcn_rcpf(__builtin_fmaf(e, 1.0f / 255.0f, 1.0f / 255.0f)), 1.0f);
                                pkd = __builtin_amdgcn_cvt_pk_u8_f32(q, i, pkd); }
                            w[2 * bj + n] = pkd; }
                    *(u32x4*)(gbase + (size_t)row * GW) = w;
                }
        }
    }
};
struct EpiG2 {
    static constexpr bool HAS_MID = true, HAS_RS = false, FP8 = false; static constexpr int MID0 = 8, MID1 = 12;
    const unsigned char* GATES8; bf16* MERGED;
    DEVI static float ub(unsigned w, int i) { return (float)((w >> (8 * i)) & 0xffu); }
    DEVI void mid(Acc& acc, const Unit& u, int t, int wr, int wc, int fr, int fq) const {
        asm volatile("" : "+v"(fr), "+v"(fq));
        const int row0 = u.pm * BM + wr * 64 + fr; const unsigned char* gp0 = GATES8 + ((t == MID0) ? 0 : 1024) + u.pn * 256 + 64 * wc + 16 * fq;
        u32x4 ga8[8], gb8[8];
#pragma unroll
        for (int k = 0; k < 8; ++k) { const unsigned char* gp = gp0 + (size_t)(row0 + (k >> 2) * HALF + (k & 3) * 16) * GW; ga8[k] = *(const u32x4*)gp; gb8[k] = *(const u32x4*)(gp + 1024); }
        asm volatile("" : "+v"(ga8[0]), "+v"(ga8[1]), "+v"(ga8[2]), "+v"(ga8[3]), "+v"(ga8[4]), "+v"(ga8[5]), "+v"(ga8[6]), "+v"(ga8[7]),
                          "+v"(gb8[0]), "+v"(gb8[1]), "+v"(gb8[2]), "+v"(gb8[3]), "+v"(gb8[4]), "+v"(gb8[5]), "+v"(gb8[6]), "+v"(gb8[7]));
#pragma unroll
        for (int ai = 0; ai < 2; ++ai)
#pragma unroll
            for (int m = 0; m < 4; ++m) { const u32x4 ga = ga8[ai * 4 + m], gb = gb8[ai * 4 + m];
#pragma unroll
                for (int bj = 0; bj < 2; ++bj)
#pragma unroll
                    for (int n = 0; n < 2; ++n)
#pragma unroll
                        for (int i = 0; i < 4; ++i) acc[ai][bj][m][n][i] *= ub(ga[2 * bj + n], i) * __builtin_amdgcn_rcpf(ub(gb[2 * bj + n], i)); }
    }
    DEVI void operator()(const Acc& acc, const Unit& u, int wr, int wc, int fr, int fq, const float (&rsv)[8]) const {
        asm volatile("" : "+v"(fr), "+v"(fq));
        const int row0 = u.pm * BM + wr * 64 + fr, col0 = u.pn * BM + wc * 32 + 8 * fq; const unsigned char* gp0 = GATES8 + 2048 + u.pn * 256 + 64 * wc + 16 * fq;
        u32x4 gc8[8];
#pragma unroll
        for (int k = 0; k < 8; ++k) gc8[k] = *(const u32x4*)(gp0 + (size_t)(row0 + (k >> 2) * HALF + (k & 3) * 16) * GW);
#pragma unroll
        for (int ai = 0; ai < 2; ++ai)
#pragma unroll
            for (int m = 0; m < 4; ++m) { const size_t ro = (size_t)(row0 + ai * HALF + m * 16); const u32x4 gc = gc8[ai * 4 + m];
#pragma unroll
                for (int bj = 0; bj < 2; ++bj) { f32x4 v0 = acc[ai][bj][m][0], v1 = acc[ai][bj][m][1];
#pragma unroll
                    for (int i = 0; i < 4; ++i) { v0[i] *= ub(gc[2 * bj], i) * (1.0f / 255.0f); v1[i] *= ub(gc[2 * bj + 1], i) * (1.0f / 255.0f); }
                    *(u32x4*)(MERGED + ro * D + col0 + bj * HALF) = pack8(v0, v1); } }
    }
};
struct EpiG3 {
    static constexpr bool HAS_MID = false, HAS_RS = false, FP8 = false; static constexpr int MID0 = -1, MID1 = -1;
    bf16* xb; unsigned char* xb8;
    DEVI void mid(Acc&, const Unit&, int, int, int, int, int) const {}
    DEVI void operator()(const Acc& acc, const Unit& u, int wr, int wc, int fr, int fq, const float (&rsv)[8]) const {
        asm volatile("" : "+v"(fr), "+v"(fq));
        const int row0 = u.pm * BM + wr * 64 + fr, col0 = u.pn * BM + wc * 32 + 8 * fq;
        u32x4 xo16[16];
#pragma unroll
        for (int k = 0; k < 16; ++k) xo16[k] = *(const u32x4*)(xb + (size_t)(row0 + (k >> 3) * HALF + ((k >> 1) & 3) * 16) * D + col0 + (k & 1) * HALF);
#pragma unroll
        for (int ai = 0; ai < 2; ++ai)
#pragma unroll
            for (int m = 0; m < 4; ++m) { const size_t ro = (size_t)(row0 + ai * HALF + m * 16) * D + col0;
#pragma unroll
                for (int bj = 0; bj < 2; ++bj) { const size_t o = ro + bj * HALF; const u32x4 xo = xo16[ai * 8 + m * 2 + bj];
                    const f32x4 x0 = (f32x4){bflo(xo[0]), bfhi(xo[0]), bflo(xo[1]), bfhi(xo[1])} + acc[ai][bj][m][0], x1 = (f32x4){bflo(xo[2]), bfhi(xo[2]), bflo(xo[3]), bfhi(xo[3])} + acc[ai][bj][m][1];
                    *(u32x4*)(xb + o) = pack8(x0, x1); u32x2 o8; o8.x = pk4_fp8(x0); o8.y = pk4_fp8(x1); *(u32x2*)(xb8 + o) = o8; } }
    }
};
struct EpiUp {
    static constexpr bool HAS_MID = false, HAS_RS = true, FP8 = true; static constexpr int MID0 = -1, MID1 = -1;
    const float* RSEL; unsigned char* H;
    DEVI void mid(Acc&, const Unit&, int, int, int, int, int) const {}
    DEVI void operator()(const Acc& acc, const Unit& u, int wr, int wc, int fr, int fq, const float (&rsv)[8]) const {
        asm volatile("" : "+v"(fr), "+v"(fq));
        const int slot0 = u.pm * BM + wr * 64 + fr, f0 = (u.pn & 7) * 128 + 32 * wc + 8 * fq;
#pragma unroll
        for (int ai = 0; ai < 2; ++ai)
#pragma unroll
            for (int m = 0; m < 4; ++m) { const int slot = slot0 + ai * HALF + m * 16; const float rs = rsv[ai * 4 + m] * (1.0f / W8SCALE); f32x4 h[2];
#pragma unroll
                for (int n = 0; n < 2; ++n)
#pragma unroll
                    for (int i = 0; i < 4; ++i) { const float a = acc[ai][0][m][n][i] * rs, b = acc[ai][1][m][n][i] * (rs * HSCALE);
                        h[n][i] = __builtin_amdgcn_fmed3f(a * __builtin_amdgcn_rcpf(1.0f + __expf(-a)) * b, -448.f, 448.f); }
                u32x2 o; o.x = pk4_fp8(h[0]); o.y = pk4_fp8(h[1]);
                *(u32x2*)(H + (size_t)slot * FF + f0) = o; }
    }
};
struct EpiDown {
    static constexpr bool HAS_MID = false, HAS_RS = true, FP8 = true; static constexpr int MID0 = -1, MID1 = -1;
    const float* VSEL; bf16* Y;
    DEVI void mid(Acc&, const Unit&, int, int, int, int, int) const {}
    DEVI void operator()(const Acc& acc, const Unit& u, int wr, int wc, int fr, int fq, const float (&rsv)[8]) const {
        asm volatile("" : "+v"(fr), "+v"(fq));
        const int slot0 = u.pm * BM + wr * 64 + fr, col0 = (u.pn & 3) * 256 + 32 * wc + 8 * fq;
#pragma unroll
        for (int ai = 0; ai < 2; ++ai)
#pragma unroll
            for (int m = 0; m < 4; ++m) { const int slot = slot0 + ai * HALF + m * 16; const float vs = rsv[ai * 4 + m] * (1.0f / (HSCALE * W8SCALE));
#pragma unroll
                for (int bj = 0; bj < 2; ++bj) *(u32x4*)(Y + (size_t)slot * D + col0 + bj * HALF) = pack8(acc[ai][bj][m][0] * vs, acc[ai][bj][m][1] * vs); }
    }
};
}

namespace attn_body {
typedef __hip_bfloat16 hbf16;
using s16x4=__attribute__((ext_vector_type(4)))short;
using f32x16=__attribute__((ext_vector_type(16)))float;
constexpr int SEQ=S,HD=64,QP=QW,KP=KVW,OP=1024;
constexpr int NW=8,QBLK=32,QB=QBLK*NW,KVBLK=64,NQB=SEQ/QB;
__device__ __forceinline__ int crow(int r,int hi){return (r&3)+8*(r>>2)+4*hi;}
#define SBAR() __builtin_amdgcn_sched_barrier(0)
constexpr int NSLOT=3, SLOTB=8192;
constexpr int LDS_K=0, LDS_V=NSLOT*SLOTB, LDS_WS=2*NSLOT*SLOTB, LDS_OST=LDS_WS+NW*64*4, LDS_BYTES=LDS_OST+NW*4096;
constexpr float C2=0.125f*1.4426950408889634f;
__device__ __forceinline__ void glds16(const void*gsrc,unsigned lds_dst){unsigned keep;
  asm volatile("s_mov_b32 %0, m0\n\ts_mov_b32 m0, %2\n\ts_nop 0\n\tglobal_load_lds_dwordx4 %1, off\n\ts_mov_b32 m0, %0":"=&s"(keep):"v"(gsrc),"s"(lds_dst):"memory");}
__device__ __forceinline__ float max3f(float a,float b,float c){float r;asm("v_max3_f32 %0, %1, %2, %3":"=v"(r):"v"(a),"v"(b),"v"(c));return r;}
__device__ __forceinline__ float max2f(float a,float b){float r;asm("v_max_f32_e32 %0, %1, %2":"=v"(r):"v"(a),"v"(b));return r;}
__device__ __forceinline__ float fadd_s(float a,float b){float r;asm("v_add_f32_e32 %0, %1, %2":"=v"(r):"v"(a),"v"(b));return r;}
__device__ __forceinline__ float fsub_s(float a,float b){float r;asm("v_sub_f32_e32 %0, %1, %2":"=v"(r):"v"(a),"v"(b));return r;}
typedef float f32x2_t __attribute__((ext_vector_type(2))); typedef __bf16 bf16x2_t __attribute__((ext_vector_type(2)));
__device__ __forceinline__ unsigned cvtpk_s(float lo,float hi){f32x2_t v={lo,hi};bf16x2_t b=__builtin_convertvector(v,bf16x2_t);return __builtin_bit_cast(unsigned,b);}
#define WAIT_BAR(N) asm volatile("s_waitcnt vmcnt(" #N ") lgkmcnt(0)\n\ts_barrier":::"memory")

__device__ __forceinline__ void qkt(f32x16&p0,f32x16&p1,const char*Kslot,const bf16x8*qr,const f32x16&negm,int r32,int hi){
  const char*kb=Kslot+hi*1024+r32*16;
  #pragma unroll
  for(int d0=0;d0<4;++d0){
    const bf16x8 b0=*reinterpret_cast<const bf16x8*>(kb+d0*2048);
    const bf16x8 b1=*reinterpret_cast<const bf16x8*>(kb+d0*2048+512);
    if(d0==0){p0=__builtin_amdgcn_mfma_f32_32x32x16_bf16(b0,qr[0],negm,0,0,0);p1=__builtin_amdgcn_mfma_f32_32x32x16_bf16(b1,qr[0],negm,0,0,0);}
    else{p0=__builtin_amdgcn_mfma_f32_32x32x16_bf16(b0,qr[d0],p0,0,0,0);p1=__builtin_amdgcn_mfma_f32_32x32x16_bf16(b1,qr[d0],p1,0,0,0);}}
}
typedef __attribute__((address_space(3))) const char* lds_cptr;
typedef short v4i16_t __attribute__((ext_vector_type(4)));
__device__ __forceinline__ void kload8(bf16x8*kf,lds_cptr kp){
  kf[0]=*(const __attribute__((address_space(3))) bf16x8*)(kp);      kf[1]=*(const __attribute__((address_space(3))) bf16x8*)(kp+512);
  kf[2]=*(const __attribute__((address_space(3))) bf16x8*)(kp+2048); kf[3]=*(const __attribute__((address_space(3))) bf16x8*)(kp+2560);
  kf[4]=*(const __attribute__((address_space(3))) bf16x8*)(kp+4096); kf[5]=*(const __attribute__((address_space(3))) bf16x8*)(kp+4608);
  kf[6]=*(const __attribute__((address_space(3))) bf16x8*)(kp+6144); kf[7]=*(const __attribute__((address_space(3))) bf16x8*)(kp+6656);
}
__device__ __forceinline__ void kload2(bf16x8*kf,lds_cptr kp,int j){ kf[2*j]=*(const __attribute__((address_space(3))) bf16x8*)(kp+j*2048); kf[2*j+1]=*(const __attribute__((address_space(3))) bf16x8*)(kp+j*2048+512); }
__device__ __forceinline__ s16x4 vtr(lds_cptr p){ return __builtin_bit_cast(s16x4,__builtin_amdgcn_ds_read_tr16_b64_v4i16((__attribute__((address_space(3))) v4i16_t*)p)); }
__device__ __forceinline__ float rowmax(const f32x16&p0,const f32x16&p1){
  float a=max3f(p0[0],p0[1],p1[0]),b=max3f(p0[2],p0[3],p1[1]);a=max3f(a,p1[2],p1[3]);
  #pragma unroll
  for(int r=4;r<16;r+=4){a=max3f(a,p0[r],p0[r+1]);b=max3f(b,p0[r+2],p0[r+3]);a=max3f(a,p1[r],p1[r+1]);b=max3f(b,p1[r+2],p1[r+3]);}
  const float m=max2f(a,b);
  auto rr=__builtin_amdgcn_permlane32_swap(__float_as_uint(m),__float_as_uint(m),false,false);
  return max2f(__uint_as_float(rr[0]),__uint_as_float(rr[1]));
}
__device__ __forceinline__ void pv(f32x16*o,int vb,bf16x8 pa0,bf16x8 pa1,bf16x8 pa2,bf16x8 pa3){
  #pragma unroll
  for(int d0=0;d0<2;++d0){s16x4 lo[4],hi[4];
    #pragma unroll
    for(int ks=0;ks<4;++ks){
      asm volatile("ds_read_b64_tr_b16 %0,%1 offset:%c2":"=&v"(lo[ks]):"v"(vb),"i"(d0*4096+ks*1024):"memory");
      asm volatile("ds_read_b64_tr_b16 %0,%1 offset:%c2":"=&v"(hi[ks]):"v"(vb),"i"(d0*4096+ks*1024+512):"memory");}
    asm volatile("s_waitcnt lgkmcnt(0)":::"memory");SBAR();
    #define PK(k) (bf16x8){lo[k][0],lo[k][1],lo[k][2],lo[k][3],hi[k][0],hi[k][1],hi[k][2],hi[k][3]}
    o[d0]=__builtin_amdgcn_mfma_f32_32x32x16_bf16(pa0,PK(0),o[d0],0,0,0);
    o[d0]=__builtin_amdgcn_mfma_f32_32x32x16_bf16(pa1,PK(1),o[d0],0,0,0);
    o[d0]=__builtin_amdgcn_mfma_f32_32x32x16_bf16(pa2,PK(2),o[d0],0,0,0);
    o[d0]=__builtin_amdgcn_mfma_f32_32x32x16_bf16(pa3,PK(3),o[d0],0,0,0);
    #undef PK
  }
}

#ifndef ATTN_STORE16
#define ATTN_STORE16(p,v) (*(u32x4*)(p)=(v))
#endif
template<int THRL> __device__ __forceinline__ void attn_unit(int b,int h,int qb,const hbf16*Q,const hbf16*__restrict__ K,const hbf16*__restrict__ V,hbf16*O,char*shm,int tid){
  const int lane=tid&63,r32=lane&31,hi=lane>>5; const int wid=__builtin_amdgcn_readfirstlane(tid>>6);
  const long rowbase=(long)b*SEQ; const int q0=qb*QB;
  const hbf16*Qw=Q+(rowbase+q0+wid*QBLK)*QP+h*HD;
  const hbf16*Kh=K+rowbase*KP+(h>>2)*HD,*Vh=V+rowbase*KP+(h>>2)*HD;
  const unsigned lds0=(unsigned)(uintptr_t)shm;
  float*wsf=(float*)(shm+LDS_WS)+wid*64;
  const hbf16*ksrc=Kh+(long)lane*KP+wid*8;
  const hbf16*vsrc=Vh+(long)(16*(wid&3)+(lane>>2))*KP+(wid>>2)*32+(lane&3)*8;
  const unsigned kdst=lds0+LDS_K+wid*1024, vdst=lds0+LDS_V+wid*1024;
  #define DMA_K(t,slot) glds16(ksrc+(long)(t)*KVBLK*KP,(unsigned)__builtin_amdgcn_readfirstlane(kdst+(slot)))
  #define DMA_V(t,slot) glds16(vsrc+(long)(t)*KVBLK*KP,(unsigned)__builtin_amdgcn_readfirstlane(vdst+(slot)))
  const int vb0=(int)(lds0+LDS_V)+((lane>>4)&1)*32+(lane&3)*8+(4*hi+((lane&15)>>2))*64;
  const char*Kbase=shm+LDS_K; bf16x8 kf[8];
  const lds_cptr shm3=(lds_cptr)shm; const lds_cptr kp0=shm3+LDS_K+hi*1024+r32*16; const lds_cptr vp0=shm3+LDS_V+((lane>>4)&1)*32+(lane&3)*8+(4*hi+((lane&15)>>2))*64;
  constexpr int NT=SEQ/KVBLK;
  DMA_K(0,0);DMA_V(0,0);DMA_K(1,SLOTB);
  bf16x8 qr[4];
  #pragma unroll
  for(int d0=0;d0<4;++d0)qr[d0]=*reinterpret_cast<const bf16x8*>(&Qw[(long)r32*QP+d0*16+hi*8]);
  float mhat=0.f,l_reg=0.f;f32x16 o[2],negm;{float z_=0.f;asm volatile("":"+v"(z_));
  _Pragma("unroll") for(int r=0;r<16;++r){o[0][r]=z_;o[1][r]=z_;negm[r]=z_;}}asm volatile("":"+v"(negm));
  #define CMASK(P0,P1,t) do{}while(0)
  bool resc=false;
  #define START(P0,P1) do{ const float rm=rowmax(P0,P1); resc=false; \
    { const float dl=rm; mhat=fadd_s(mhat,dl); \
      _Pragma("unroll") for(int r=0;r<16;++r){P0[r]=fsub_s(P0[r],dl);P1[r]=fsub_s(P1[r],dl);} \
      _Pragma("unroll") for(int r=0;r<16;++r)negm[r]=-mhat; asm volatile("":"+v"(negm)); } \
    _Pragma("unroll") for(int r=0;r<16;++r)P0[r]=__builtin_amdgcn_exp2f(P0[r]); }while(0)
  #define RESC() do{ if(resc){ asm volatile("s_waitcnt lgkmcnt(0)":::"memory"); \
      _Pragma("unroll") for(int d_=0;d_<2;++d_) _Pragma("unroll") for(int r=0;r<16;++r)o[d_][r]*=wsf[crow(r,hi)]; } }while(0)
  f32x16 pA0,pA1,pB0,pB1;
  int sl_prev=0,sl_cur=0,sl_next=SLOTB;
  #define ROT() do{sl_prev=sl_cur;sl_cur=sl_next;sl_next=(sl_next==(NSLOT-1)*SLOTB)?0:sl_next+SLOTB;}while(0)
  DMA_K(2,2*SLOTB);
  WAIT_BAR(3);
  qkt(pA0,pA1,Kbase,qr,negm,r32,hi);asm volatile("s_nop 15\n\ts_nop 7":"+v"(pA0),"+v"(pA1));CMASK(pA0,pA1,0);
  START(pA0,pA1);
  _Pragma("unroll") for(int r=0;r<16;++r)pA1[r]=__builtin_amdgcn_exp2f(pA1[r]);
  WAIT_BAR(0);
  DMA_K(3,0);DMA_V(1,SLOTB);
  ROT();
  kload8(kf,kp0+sl_cur);
  WAIT_BAR(2);
  s16x4 vlo[8],vhi[8]; u32x4 pw0,pw1,pw2,pw3;
  #define PKW(P,B) cvtpk_s(P[B],P[B+1])
  #define PAF(k) __builtin_bit_cast(bf16x8,pw##k)
  #define VFR(i) (bf16x8){vlo[i][0],vlo[i][1],vlo[i][2],vlo[i][3],vhi[i][0],vhi[i][1],vhi[i][2],vhi[i][3]}
  #define PIN(x) asm volatile("":"+v"(x))
  #define MX3(a,b,c) __builtin_fmaxf(__builtin_fmaxf((a),(b)),(c))
  #define GAPA(MF,A0,A1,A2,A3,W0,W1,PW) do{ MF; sacc+=A0; sacc+=A1; sacc+=A2; sacc+=A3; PIN(sacc); W0; W1; PIN(PW); SBAR(); }while(0)
  #define EX(v) __builtin_amdgcn_exp2f(v)
  #define GAPB(MF,X,B) do{ MF; X[B]=EX(X[B]); X[B+1]=EX(X[B+1]); X[B+2]=EX(X[B+2]); X[B+3]=EX(X[B+3]); PIN(X); SBAR(); }while(0)
  #define VRD(i) do{ vlo[i]=vtr(vp_+(((i)>>2)*4096+((i)&3)*1024)); vhi[i]=vtr(vp_+(((i)>>2)*4096+((i)&3)*1024+512)); }while(0)
  #define KRD(G,j) do{ if(G){ kload2(kf,kp0+sl_next,j); SBAR(); } }while(0)
  #define STEP(C0,C1,P0,P1,t,GK,GV,GL) do{ SBAR(); \
    const lds_cptr vp_=vp0+sl_prev; \
    VRD(0); SBAR(); float sacc=(P0[0]+P0[1]); \
    GAPA(C0=__builtin_amdgcn_mfma_f32_32x32x16_bf16(kf[0],qr[0],negm,0,0,0), P0[2],P0[3],P0[4],P0[5],     pw0[0]=PKW(P0,0), pw0[1]=PKW(P0,2), pw0); \
    VRD(4); SBAR(); GAPA(C1=__builtin_amdgcn_mfma_f32_32x32x16_bf16(kf[1],qr[0],negm,0,0,0), P0[6],P0[7],P0[8],P0[9],     pw0[2]=PKW(P0,4), pw0[3]=PKW(P0,6), pw0); \
    VRD(1); SBAR(); GAPA(C0=__builtin_amdgcn_mfma_f32_32x32x16_bf16(kf[2],qr[1],C0,0,0,0),   P0[10],P0[11],P0[12],P0[13], pw1[0]=PKW(P0,8), pw1[1]=PKW(P0,10), pw1); \
    VRD(5); SBAR(); GAPA(C1=__builtin_amdgcn_mfma_f32_32x32x16_bf16(kf[3],qr[1],C1,0,0,0),   P0[14],P0[15],P1[0],P1[1],   pw1[2]=PKW(P0,12),pw1[3]=PKW(P0,14), pw1); \
    VRD(2); SBAR(); GAPA(C0=__builtin_amdgcn_mfma_f32_32x32x16_bf16(kf[4],qr[2],C0,0,0,0),   P1[2],P1[3],P1[4],P1[5],     pw2[0]=PKW(P1,0), pw2[1]=PKW(P1,2), pw2); \
    VRD(6); SBAR(); GAPA(C1=__builtin_amdgcn_mfma_f32_32x32x16_bf16(kf[5],qr[2],C1,0,0,0),   P1[6],P1[7],P1[8],P1[9],     pw2[2]=PKW(P1,4), pw2[3]=PKW(P1,6), pw2); \
    VRD(3); SBAR(); GAPA(C0=__builtin_amdgcn_mfma_f32_32x32x16_bf16(kf[6],qr[3],C0,0,0,0),   P1[10],P1[11],P1[12],P1[13], pw3[0]=PKW(P1,8), pw3[1]=PKW(P1,10), pw3); \
    VRD(7); SBAR(); GAPA(C1=__builtin_amdgcn_mfma_f32_32x32x16_bf16(kf[7],qr[3],C1,0,0,0),   P1[14],P1[15],0.f,0.f,       pw3[2]=PKW(P1,12),pw3[3]=PKW(P1,14), pw3); \
    l_reg+=sacc; \
    if(GK){DMA_K((t)+3,sl_cur);} if(GV){DMA_V((t)+1,sl_next);} \
    CMASK(C0,C1,t); \
    { float a=MX3(C0[0],C0[1],C1[0]),b=MX3(C0[2],C0[3],C1[1]); a=MX3(a,C1[2],C1[3]); \
      _Pragma("unroll") for(int r=4;r<16;r+=4){a=MX3(a,C0[r],C0[r+1]);b=MX3(b,C0[r+2],C0[r+3]);a=MX3(a,C1[r],C1[r+1]);b=MX3(b,C1[r+2],C1[r+3]);} \
      float rm=__builtin_fmaxf(a,b); { auto rr=__builtin_amdgcn_permlane32_swap(__float_as_uint(rm),__float_as_uint(rm),false,false); rm=__builtin_fmaxf(__uint_as_float(rr[0]),__uint_as_float(rr[1])); } \
      resc=false; \
      if(__builtin_expect(__any(rm>(float)THRL),0)){ const float dl=__builtin_fmaxf(rm,0.f); mhat+=dl; \
        _Pragma("unroll") for(int r=0;r<16;++r){C0[r]-=dl;C1[r]-=dl;} \
        _Pragma("unroll") for(int r=0;r<16;++r)negm[r]=-mhat; asm volatile("":"+v"(negm)); \
        const float f=__builtin_amdgcn_exp2f(-dl); l_reg*=f; if(hi==0)wsf[r32]=f; resc=true; } } \
    SBAR(); \
    GAPB(o[0]=__builtin_amdgcn_mfma_f32_32x32x16_bf16(PAF(0),VFR(0),o[0],0,0,0), C0,0); \
    GAPB(o[1]=__builtin_amdgcn_mfma_f32_32x32x16_bf16(PAF(0),VFR(4),o[1],0,0,0), C0,4); \
    KRD(GL,0); GAPB(o[0]=__builtin_amdgcn_mfma_f32_32x32x16_bf16(PAF(1),VFR(1),o[0],0,0,0), C0,8); \
    KRD(GL,1); GAPB(o[1]=__builtin_amdgcn_mfma_f32_32x32x16_bf16(PAF(1),VFR(5),o[1],0,0,0), C0,12); \
    KRD(GL,2); GAPB(o[0]=__builtin_amdgcn_mfma_f32_32x32x16_bf16(PAF(2),VFR(2),o[0],0,0,0), C1,0); \
    KRD(GL,3); GAPB(o[1]=__builtin_amdgcn_mfma_f32_32x32x16_bf16(PAF(2),VFR(6),o[1],0,0,0), C1,4); \
    GAPB(o[0]=__builtin_amdgcn_mfma_f32_32x32x16_bf16(PAF(3),VFR(3),o[0],0,0,0), C1,8); \
    GAPB(o[1]=__builtin_amdgcn_mfma_f32_32x32x16_bf16(PAF(3),VFR(7),o[1],0,0,0), C1,12); \
    }while(0)
  int t=1;
  for(;t+5<NT;t+=2){
    STEP(pB0,pB1,pA0,pA1,t,true,true,true);     WAIT_BAR(2); RESC(); ROT();
    STEP(pA0,pA1,pB0,pB1,t+1,true,true,true);   WAIT_BAR(2); RESC(); ROT();
  }
  #define ENDW(tt) do{ if((tt)+3<NT){WAIT_BAR(2);} else if((tt)+2<NT){WAIT_BAR(1);} else {WAIT_BAR(0);} }while(0)
  for(;t+1<NT;t+=2){
    STEP(pB0,pB1,pA0,pA1,t,(t+3<NT),(t+1<NT),(t+1<NT));       ENDW(t);   RESC(); ROT();
    STEP(pA0,pA1,pB0,pB1,t+1,(t+4<NT),(t+2<NT),(t+2<NT));     ENDW(t+1); RESC(); ROT();
  }
  STEP(pB0,pB1,pA0,pA1,NT-1,false,false,false); RESC();
  { float sacc=pB0[0]+pB0[1]; _Pragma("unroll") for(int r=2;r<16;++r)sacc+=pB0[r]; _Pragma("unroll") for(int r=0;r<16;++r)sacc+=pB1[r]; l_reg+=sacc;
    pw0=(u32x4){PKW(pB0,0),PKW(pB0,2),PKW(pB0,4),PKW(pB0,6)};pw1=(u32x4){PKW(pB0,8),PKW(pB0,10),PKW(pB0,12),PKW(pB0,14)};pw2=(u32x4){PKW(pB1,0),PKW(pB1,2),PKW(pB1,4),PKW(pB1,6)};pw3=(u32x4){PKW(pB1,8),PKW(pB1,10),PKW(pB1,12),PKW(pB1,14)};
    SBAR(); pv(o,vb0+sl_cur,PAF(0),PAF(1),PAF(2),PAF(3)); }
  #undef PKW
  #undef PAF
  #undef VFR
  #undef PIN
  #undef MX3
  #undef GAPA
  #undef GAPB
  #undef EX
  #undef VRD
  #undef KRD
  #undef STEP
  #undef ENDW
  {auto rr=__builtin_amdgcn_permlane32_swap(__float_as_uint(l_reg),__float_as_uint(l_reg),false,false);l_reg=__uint_as_float(rr[0])+__uint_as_float(rr[1]);}
  if(hi==0)wsf[32+r32]=l_reg;asm volatile("s_waitcnt lgkmcnt(0)":::"memory");
  float rli[16];
  #pragma unroll
  for(int r=0;r<16;++r)rli[r]=__builtin_amdgcn_rcpf(wsf[32+crow(r,hi)]);
  hbf16*Ow=O+(rowbase+q0+wid*QBLK)*OP+h*HD;
  { hbf16*stg=(hbf16*)(shm+LDS_OST)+wid*2048;
    #pragma unroll
    for(int r=0;r<16;++r){const int orow=crow(r,hi);
      #pragma unroll
      for(int d0=0;d0<2;++d0)stg[orow*64+d0*32+r32]=__float2bfloat16(o[d0][r]*rli[r]);}
    asm volatile("s_waitcnt lgkmcnt(0)":::"memory");
    #pragma unroll
    for(int i=0;i<4;++i){const int row=i*8+(lane>>3),ch=lane&7; const u32x4 v=*(const u32x4*)(stg+row*64+ch*8); ATTN_STORE16(Ow+(long)row*OP+ch*8,v);} }
  asm volatile("s_waitcnt lgkmcnt(0)\n\ts_barrier":::"memory");
  #undef DMA_K
  #undef DMA_V
  #undef CMASK
  #undef START
  #undef RESC
  #undef ROT
}
constexpr int ATTN_LDS_BYTES=LDS_BYTES;
struct AttnTensors { const hbf16* Q; const hbf16* K; const hbf16* V; hbf16* O; };
template<int THRL=8> __device__ __forceinline__ void attn_phase(char*lds,const AttnTensors&T,int vcu,int G,int tid){
  for(int L=vcu;L<NB*8;L+=G){ const int b=L>>3,h=L&7;
    for(int qb=0;qb<NQB;++qb) attn_unit<THRL>(b,h,qb,T.Q,T.K,T.V,T.O,lds,tid); }
}
#undef SBAR
#undef WAIT_BAR
}


namespace mix {
constexpr int VS_STRIDE = 544, P_STRIDE = 528;
constexpr int VS_OFF = 0, P_OFF = 128 * VS_STRIDE, P_ROWS = 143, LDS_END = P_OFF + P_ROWS * P_STRIDE;
typedef short v4i16_t __attribute__((ext_vector_type(4)));
typedef short s16x4 __attribute__((ext_vector_type(4)));
DEVI s16x4 vtr(const LAS unsigned char* p) { return __builtin_bit_cast(s16x4, __builtin_amdgcn_ds_read_tr16_b64_v4i16((LAS v4i16_t*)p)); }
DEVI void mix_phase(LAS unsigned char* lds, int c0, int cstep, const bf16* VS, const bf16* U, const bf16* P, bf16* ACT, const float* g_sgu, const bf16* WSP, const float* b_sp, const bf16* WPT, int wave, int lane) {
    const int fr = lane & 15, fq = lane >> 4, sg = wave >> 1, ph = wave & 1, tid = wave * 64 + lane;
    bf16x8 wsp[4][4];
    { const bf16* wb = WSP + ((size_t)sg * 128 + 64 * ph + fr) * 128 + 8 * fq;
#pragma unroll
      for (int ks = 0; ks < 4; ++ks)
#pragma unroll
          for (int pb = 0; pb < 4; ++pb) wsp[ks][pb] = *(const bf16x8*)(wb + (size_t)16 * pb * 128 + 32 * ks); }
    const f32x4 gs = *(const f32x4*)(g_sgu + 4 * lane);
    float bias4[4];
#pragma unroll
    for (int pb = 0; pb < 4; ++pb) bias4[pb] = b_sp[sg * 128 + 64 * ph + 16 * pb + fr];
    for (int chunk = c0; chunk < M / 128; chunk += cstep) {
        const size_t row0 = (size_t)chunk * 128; const int tpos0 = (chunk & 15) * 128;
#pragma unroll 1
        for (int h8 = 0; h8 < 2; ++h8) { u32x2 w[8];
#pragma unroll
            for (int i = 0; i < 8; ++i) w[i] = *(const u32x2*)(VS + (row0 + wave * 16 + h8 * 8 + i) * SGW + 4 * lane);
#pragma unroll
            for (int i = 0; i < 8; ++i) { const float v0 = bflo(w[i].x), v1 = bfhi(w[i].x), v2 = bflo(w[i].y), v3 = bfhi(w[i].y);
                const float ss = wave_sum(v0 * v0 + v1 * v1 + v2 * v2 + v3 * v3); const float r = __builtin_amdgcn_rsqf(ss * (1.0f / SGW) + EPS);
                u32x2 o; o.x = pk2(v0 * r * gs[0], v1 * r * gs[1]); o.y = pk2(v2 * r * gs[2], v3 * r * gs[3]);
                *(LAS u32x2*)(lds + VS_OFF + (wave * 16 + h8 * 8 + i) * VS_STRIDE + 8 * lane) = o; } }
#pragma unroll 1
        for (int bt = 0; bt < 3; ++bt) { u32x4 pv[3];
#pragma unroll
            for (int it = 0; it < 3; ++it) { const int pc = tid + (bt * 3 + it) * 512, j = pc >> 5, c = pc & 31, tp = tpos0 - 8 + j;
                pv[it] = (u32x4){0u, 0u, 0u, 0u}; if (pc < P_ROWS * 32 && tp >= 0 && tp < S) pv[it] = *(const u32x4*)(P + ((long)row0 - 8 + j) * PLW + 8 * c); }
#pragma unroll
            for (int it = 0; it < 3; ++it) { const int pc = tid + (bt * 3 + it) * 512; if (pc < P_ROWS * 32) *(LAS u32x4*)(lds + P_OFF + (pc >> 5) * P_STRIDE + 16 * (pc & 31)) = pv[it]; } }
        u32x2 uw[4][4];
        { const unsigned uo = (unsigned)(((unsigned)row0 + 64 * ph + fr) * SGW + 64 * sg + 4 * fq) * 2u;
#pragma unroll
          for (int pb = 0; pb < 4; ++pb)
#pragma unroll
              for (int cb = 0; cb < 4; ++cb) uw[pb][cb] = *(const u32x2*)((const char*)U + (uo + (unsigned)(16 * pb * SGW + 16 * cb) * 2u)); }
        LDS_WAIT(); __syncthreads();
        { f32x4 acc[4][4];
#pragma unroll
          for (int a = 0; a < 4; ++a)
#pragma unroll
              for (int b = 0; b < 4; ++b) acc[a][b] = (f32x4){0.f, 0.f, 0.f, 0.f};
          const LAS unsigned char* abase = lds + VS_OFF + (8 * fq + (fr >> 2)) * VS_STRIDE + (64 * sg + 4 * (fr & 3)) * 2;
#pragma unroll
          for (int ks = 0; ks < 4; ++ks) {
              bf16x8 af[4];
#pragma unroll
              for (int cb = 0; cb < 4; ++cb) { const s16x4 lo = vtr(abase + 32 * ks * VS_STRIDE + 32 * cb), hi = vtr(abase + (32 * ks + 4) * VS_STRIDE + 32 * cb);
                  af[cb] = (bf16x8){lo[0], lo[1], lo[2], lo[3], hi[0], hi[1], hi[2], hi[3]}; }
#pragma unroll
              for (int cb = 0; cb < 4; ++cb)
#pragma unroll
                  for (int pb = 0; pb < 4; ++pb) acc[cb][pb] = __builtin_amdgcn_mfma_f32_16x16x32_bf16(af[cb], wsp[ks][pb], acc[cb][pb], 0, 0, 0);
          }
#pragma unroll
          for (int pb = 0; pb < 4; ++pb) { const int p = 64 * ph + 16 * pb + fr; const float bias = bias4[pb];
#pragma unroll
              for (int cb = 0; cb < 4; ++cb) { const int ch = 64 * sg + 16 * cb + 4 * fq; const u32x2 u2 = uw[pb][cb];
                  u32x2 o; o.x = pk2(bflo(u2.x) * (acc[cb][pb][0] + bias), bfhi(u2.x) * (acc[cb][pb][1] + bias)); o.y = pk2(bflo(u2.y) * (acc[cb][pb][2] + bias), bfhi(u2.y) * (acc[cb][pb][3] + bias));
                  *(u32x2*)((char*)ACT + (unsigned)((((unsigned)row0 + p) * 1024 + 512 + ch) * 2u)) = o; } } }
        { const int t = 16 * wave + fr, tp = tpos0 + t;
#pragma unroll 1
          for (int g = 0; g < 4; ++g) { const int wd = 2 << g, lo_off = wd >> 1, hi_off = wd - 1 - lo_off;
              bf16x8 wf[2][4];
#pragma unroll
              for (int ks = 0; ks < 2; ++ks)
#pragma unroll
                  for (int db = 0; db < 4; ++db) wf[ks][db] = *(const bf16x8*)(WPT + ((size_t)g * 64 + 16 * db + fr) * 64 + 32 * ks + 8 * fq);
              int lo = tp - lo_off; if (lo < 0) lo = 0; int hi = tp + hi_off; if (hi > S - 1) hi = S - 1; const float icnt = 1.0f / (float)(hi - lo + 1);
              f32x4 acc[4];
#pragma unroll
              for (int a = 0; a < 4; ++a) acc[a] = (f32x4){0.f, 0.f, 0.f, 0.f};
#pragma unroll
              for (int ks = 0; ks < 2; ++ks) { const LAS unsigned char* pb_ = lds + P_OFF + (64 * g + 32 * ks + 8 * fq) * 2;
                  float sum[8];
#pragma unroll
                  for (int i = 0; i < 8; ++i) sum[i] = 0.f;
#pragma unroll 1
                  for (int j = -lo_off; j <= hi_off; ++j) { const u32x4 v = *(const LAS u32x4*)(pb_ + (t + 8 + j) * P_STRIDE);
                      sum[0] += bflo(v[0]); sum[1] += bfhi(v[0]); sum[2] += bflo(v[1]); sum[3] += bfhi(v[1]); sum[4] += bflo(v[2]); sum[5] += bfhi(v[2]); sum[6] += bflo(v[3]); sum[7] += bfhi(v[3]); }
                  const u32x4 c0 = *(const LAS u32x4*)(pb_ + (t + 8) * P_STRIDE);
                  u32x4 dw; dw[0] = pk2(sum[0] * icnt - bflo(c0[0]), sum[1] * icnt - bfhi(c0[0])); dw[1] = pk2(sum[2] * icnt - bflo(c0[1]), sum[3] * icnt - bfhi(c0[1]));
                  dw[2] = pk2(sum[4] * icnt - bflo(c0[2]), sum[5] * icnt - bfhi(c0[2])); dw[3] = pk2(sum[6] * icnt - bflo(c0[3]), sum[7] * icnt - bfhi(c0[3]));
                  const bf16x8 dfr = __builtin_bit_cast(bf16x8, dw);
#pragma unroll
                  for (int db = 0; db < 4; ++db) acc[db] = __builtin_amdgcn_mfma_f32_16x16x32_bf16(wf[ks][db], dfr, acc[db], 0, 0, 0); }
#pragma unroll
              for (int db = 0; db < 4; ++db) { u32x2 o; o.x = pk2(acc[db][0], acc[db][1]); o.y = pk2(acc[db][2], acc[db][3]);
                  *(u32x2*)((char*)ACT + (unsigned)((((unsigned)row0 + t) * 1024 + 768 + 64 * g + 16 * db + 4 * fq) * 2u)) = o; } } }
        LDS_WAIT(); __syncthreads();
    }
}
}

#define XB_TMO      128
#define XB_XCNT(j)  (256  + 64 * (j))
#define XB_XSUB(j)  (1280 + 64 * (j))
#define XB_XGEN(j)  (2304 + 64 * (j))
#define XB_TOP      3328
#define XB_TOPGEN   3392
#define XCD_BAR_WORDS 3456
#define XB_SPIN_CAP (1u << 21)
DEVI unsigned xb_ld(unsigned* p)              { return __hip_atomic_load(p, __ATOMIC_RELAXED, __HIP_MEMORY_SCOPE_AGENT); }
DEVI unsigned xb_add(unsigned* p, unsigned v) { return __hip_atomic_fetch_add(p, v, __ATOMIC_RELAXED, __HIP_MEMORY_SCOPE_AGENT); }
DEVI unsigned xb_xcc_id() { return (unsigned)__builtin_amdgcn_s_getreg((3 << 11) | 20) & 0xFu; }
#define XB_SPIN(cond, bar) do { unsigned _sp = 0; while (cond) { __builtin_amdgcn_s_sleep(1); \
    if ((++_sp & 255u) == 0u) { if (xb_ld(&(bar)[XB_TMO])) break; if (_sp > XB_SPIN_CAP) { atomicAdd(&(bar)[XB_TMO], 1u); break; } } } } while (0)
struct XcdBarrier { unsigned* bar; unsigned x; volatile LAS unsigned* st; };
DEVI XcdBarrier xcd_barrier_post(unsigned* bar, volatile LAS unsigned* st) {
    XcdBarrier b; b.bar = bar; b.x = xb_xcc_id(); b.st = st;
    if (threadIdx.x == 0) (void)xb_add(&bar[XB_XCNT(b.x)], 1u);
    return b;
}
DEVI void xcd_barrier_complete(unsigned* bar, unsigned x, unsigned& nloc, unsigned& nx) {
    const unsigned G = gridDim.x * gridDim.y * gridDim.z;
    unsigned sum, cnt, mine, sp = 0u;
    for (;;) {
        sum = 0u; cnt = 0u; mine = 0u;
#pragma unroll
        for (unsigned j = 0; j < 16; ++j) { const unsigned c = xb_ld(&bar[XB_XCNT(j)]); sum += c; cnt += (c > 0u) ? 1u : 0u; mine = (j == x) ? c : mine; }
        if (sum == G) break;
        __builtin_amdgcn_s_sleep(1);
        if ((++sp & 255u) == 0u) { if (xb_ld(&bar[XB_TMO])) break; if (sp > XB_SPIN_CAP) { atomicAdd(&bar[XB_TMO], 1u); break; } }
    }
    nloc = mine > 0u ? mine : 1u; nx = cnt > 0u ? cnt : 1u;
}
DEVI void xcd_barrier(const XcdBarrier& b, int tid) {
    asm volatile("s_waitcnt vmcnt(0)" ::: "memory");
    __syncthreads();
    if (tid == 0) {
        unsigned* bar = b.bar; unsigned bx = b.x;
        asm volatile("" : "+s"(bar), "+s"(bx));
        __builtin_amdgcn_s_waitcnt(0);
        unsigned nloc = b.st[0], nx = b.st[1];
        if (nloc == 0u) { xcd_barrier_complete(bar, bx, nloc, nx); b.st[0] = nloc; b.st[1] = nx; }
        const unsigned old = xb_add(&bar[XB_XSUB(bx)], 1u);
        const unsigned gen = old / nloc;
        if (old + 1u == (gen + 1u) * nloc) {
            __builtin_amdgcn_fence(__ATOMIC_RELEASE, "agent");
            asm volatile("s_waitcnt vmcnt(0)" ::: "memory");
            const unsigned og = xb_add(&bar[XB_TOP], 1u);
            const unsigned tg = og / nx;
            if (og + 1u == (tg + 1u) * nx) xb_add(&bar[XB_TOPGEN], 1u);
            else XB_SPIN(xb_ld(&bar[XB_TOPGEN]) == tg, bar);
            __builtin_amdgcn_fence(__ATOMIC_ACQUIRE, "agent");
            xb_add(&bar[XB_XGEN(bx)], 1u);
            asm volatile("s_waitcnt vmcnt(0)" ::: "memory");
        } else {
            XB_SPIN(xb_ld(&bar[XB_XGEN(bx)]) == gen, bar);
            __builtin_amdgcn_fence(__ATOMIC_ACQUIRE, "agent");
            asm volatile("s_waitcnt vmcnt(0)" ::: "memory");
        }
    }
    __syncthreads();
}

constexpr int RING_BYTES = 131072;
constexpr int MISC_OFF = 147456, LDS_BYTES = 147456 + 512;
constexpr int CW_BAR = 4096;
static_assert((CW_BAR + XCD_BAR_WORDS) * 4 <= (int)MiB, "ctl");

struct MkArgs {
    const float* in[20]; float* out; unsigned char* ws;
    int ph_lo, ph_hi, sub, mode;
};
typedef const __attribute__((address_space(4))) MkArgs* KArgs;
#define KARGS() ({ KArgs _p = (KArgs)__builtin_amdgcn_kernarg_segment_ptr(); asm volatile("" : "+s"(_p)); _p; })
struct ConvHook {
    int at, l, gw, ngw;
    struct Item { const float* src; const float* ks; unsigned char* out; int ld, col; };
    DEVI static Item decode(int it, int lane, const float* wg, const float* wu, const float* wd, const float* gf, unsigned char* ws) {
        constexpr int I_UP = NE * 32 * 16; Item t;
        if (it < I_UP) { const int e = it >> 9, q = it & 511, nb = q >> 4, kb = q & 15, np = nb * 64 + lane, bj = (np >> 7) & 1;
            t.src = (bj ? wu : wg) + (size_t)e * D * FF + (size_t)kb * 64 * FF; t.ld = FF; t.col = (np >> 8) * 128 + (np & 127); t.ks = gf + kb * 64; t.out = ws + WS_WUP + ((size_t)e * 2048 + np) * D + kb * 64; }
        else { const int r = it - I_UP, e = r >> 8, q = r & 255, nb = q >> 4, kb = q & 15, np = nb * 64 + lane;
            t.src = wd + (size_t)e * FF * D + (size_t)kb * 64 * D; t.ld = D; t.col = np; t.ks = nullptr; t.out = ws + WS_WDN + ((size_t)e * 1024 + np) * FF + kb * 64; }
        return t;
    }
    DEVI static void load(const Item& t, float (&v)[64]) {
#pragma unroll
        for (int kk = 0; kk < 64; ++kk) v[kk] = t.src[(size_t)kk * t.ld + t.col];
    }
    DEVI static void store(const Item& t, float (&v)[64]) {
        if (t.ks) {
#pragma unroll
            for (int kk = 0; kk < 64; ++kk) v[kk] *= t.ks[kk]; }
#pragma unroll
        for (int c = 0; c < 4; ++c) { u32x4 o;
#pragma unroll
            for (int q = 0; q < 4; ++q) { f32x4 x; x[0] = v[16 * c + 4 * q] * W8SCALE; x[1] = v[16 * c + 4 * q + 1] * W8SCALE; x[2] = v[16 * c + 4 * q + 2] * W8SCALE; x[3] = v[16 * c + 4 * q + 3] * W8SCALE; o[q] = pk4_fp8(x); }
            *(u32x4*)(t.out + 16 * c) = o; }
    }
    DEVI void operator()(int ui) const {
        if (ui != at) return;
        KArgs ka = KARGS(); unsigned char* ws = ka->ws; const int lane = lane_id_v();
        const float* wg = ka->in[16] + (size_t)l * NE * D * FF; const float* wu = ka->in[17] + (size_t)l * NE * D * FF; const float* wd = ka->in[18] + (size_t)l * NE * FF * D;
        const float* gf = ka->in[14] + l * D;
        constexpr int I_ALL = NE * 32 * 16 + NE * 16 * 16;
        float va[64], vb[64];
        int it = gw; if (it >= I_ALL) return;
        Item ta = decode(it, lane, wg, wu, wd, gf, ws), tb = ta; load(ta, va);
        for (;;) {
            const bool more_b = it + ngw < I_ALL; if (more_b) { tb = decode(it + ngw, lane, wg, wu, wd, gf, ws); load(tb, vb); }
            store(ta, va); if (!more_b) break; it += ngw;
            const bool more_a = it + ngw < I_ALL; if (more_a) { ta = decode(it + ngw, lane, wg, wu, wd, gf, ws); load(ta, va); }
            store(tb, vb); if (!more_a) break; it += ngw;
        }
    }
};

constexpr int PH_PER_LAYER = 9, PH_TOTAL = 1 + DEPTH * PH_PER_LAYER;

DEVI void tr_item(const float* src, int ld, int col, const float* kscale, bf16* out0, int ldo, int k0, LAS float* scr, int lane) {
#pragma unroll 8
    for (int i = 0; i < 32; ++i) { const int kk = 2 * i + (lane >> 5); float v = src[(size_t)(k0 + kk) * ld + col]; if (kscale) v *= kscale[k0 + kk]; scr[kk * 33 + (lane & 31)] = v; }
    LDS_WAIT(); asm volatile("" ::: "memory");
    const int c = lane & 7;
#pragma unroll
    for (int j = 0; j < 4; ++j) { const int n = (lane >> 3) + 8 * j; const LAS float* s = scr + (8 * c) * 33 + n;
        u32x4 o; o.x = pk2(s[0 * 33], s[1 * 33]); o.y = pk2(s[2 * 33], s[3 * 33]); o.z = pk2(s[4 * 33], s[5 * 33]); o.w = pk2(s[6 * 33], s[7 * 33]);
        *(u32x4*)(out0 + (size_t)n * ldo + 8 * c) = o; }
    LDS_WAIT(); asm volatile("" ::: "memory");
}


#ifndef REP_G1
#define REP_G1 1
#endif
#ifndef REP_CONV
#define REP_CONV 1
#endif
#ifndef REP_ATTN
#define REP_ATTN 1
#endif
#ifndef REP_MIX
#define REP_MIX 1
#endif
#ifndef REP_G2
#define REP_G2 1
#endif
#ifndef REP_G3L0
#define REP_G3L0 1
#endif
#ifndef REP_ROUTER
#define REP_ROUTER 1
#endif
#ifndef REP_TOPK
#define REP_TOPK 1
#endif
#ifndef REP_UP
#define REP_UP 1
#endif
#ifndef REP_DOWN
#define REP_DOWN 1
#endif
DEVI void tr_item8(const float* src, int ld, int col, const float* kscale, unsigned char* out0, int ldo, int k0, LAS float* scr, int lane) {
#pragma unroll 8
    for (int i = 0; i < 32; ++i) { const int kk = 2 * i + (lane >> 5); scr[kk * 33 + (lane & 31)] = src[(size_t)(k0 + kk) * ld + col] * kscale[k0 + kk] * GSCALE; }
    LDS_WAIT(); asm volatile("" ::: "memory");
    const int c = lane & 7;
#pragma unroll
    for (int j = 0; j < 4; ++j) { const int n = (lane >> 3) + 8 * j; const LAS float* s = scr + (8 * c) * 33 + n;
        int lo = 0, hi = 0; lo = __builtin_amdgcn_cvt_pk_fp8_f32(s[0 * 33], s[1 * 33], lo, false); lo = __builtin_amdgcn_cvt_pk_fp8_f32(s[2 * 33], s[3 * 33], lo, true);
        hi = __builtin_amdgcn_cvt_pk_fp8_f32(s[4 * 33], s[5 * 33], hi, false); hi = __builtin_amdgcn_cvt_pk_fp8_f32(s[6 * 33], s[7 * 33], hi, true);
        u32x2 o; o.x = (unsigned)lo; o.y = (unsigned)hi; *(u32x2*)(out0 + (size_t)n * ldo + 8 * c) = o; }
    LDS_WAIT(); asm volatile("" ::: "memory");
}
__global__ void __launch_bounds__(NWAVES * 64, 2) mk_fwd(MkArgs args) {
    extern __shared__ __attribute__((aligned(16))) unsigned char lds_raw[];
    LAS unsigned char* lds = (LAS unsigned char*)lds_raw;
    volatile LAS unsigned* MISC = (volatile LAS unsigned*)(lds + MISC_OFF);
    const int wave = __builtin_amdgcn_readfirstlane((int)threadIdx.x >> 6);
    const int G = gridDim.x; const int vcu = (G % 8 == 0) ? ((int)blockIdx.x % 8) * (G / 8) + (int)blockIdx.x / 8 : (int)blockIdx.x;
    gu32* ctl; { KArgs ka0 = KARGS(); ctl = (gu32*)(ka0->ws + WS_CTL); }
    { const int t0 = wave * 64 + lane_id_v(); if (t0 < 128) MISC[t0] = 0u; }
    __syncthreads();
    int lo, hi; { KArgs ka0 = KARGS(); lo = ka0->ph_lo; hi = ka0->ph_hi; }
    const bool use_bar = (hi - lo) > 1;
    XcdBarrier bar; bar.bar = (unsigned*)(ctl + CW_BAR); bar.x = 0; bar.st = nullptr;
    if (use_bar) bar = xcd_barrier_post((unsigned*)(ctl + CW_BAR), MISC + 8);
#define IN(k) (lo <= (k) && (k) < hi)
#define LAUNDER_BX() int bx = (int)blockIdx.x; asm volatile("" : "+s"(bx))
#define SEAM(k) do { if (IN(k) && IN((k) + 1)) xcd_barrier(bar, wave * 64 + lane_id_v()); } while (0)
    const int NGW = G * NWAVES;
    if (IN(0)) {
            KArgs ka = KARGS(); unsigned char* ws = ka->ws;
        const int lane = lane_id_v(), tid = wave * 64 + lane, gw = vcu * NWAVES + wave;
        LAS float* scr = (LAS float*)(lds + wave * 16384);
        { const int i = blockIdx.x * 512 + tid; if (i < 64 * 16) { const int pos = i >> 4, f = i & 15; const float freq = powf(10000.0f, -(float)(2 * f) / 32.0f); const float ang = (float)pos * freq;
            ((float*)(ws + WS_ROPE))[2 * i] = cosf(ang); ((float*)(ws + WS_ROPE))[2 * i + 1] = sinf(ang); } }
        constexpr int I_W1 = 16 * 48, I_G8 = 16 * 96, I_A = 8 * 32, I_B = 4 * 32, I_C = 4 * 32, I_W3 = 16 * 32, I_L = I_W1 + I_G8 + I_A + I_B + I_C + I_W3;
        for (int it = gw; it < DEPTH * I_L; it += NGW) {
            const int l = it / I_L; int r = it % I_L;
            bf16* w1t = (bf16*)(ws + WS_W1T) + (size_t)l * INW * D; bf16* w2t = (bf16*)(ws + WS_W2T) + (size_t)l * D * D; bf16* w3t = (bf16*)(ws + WS_W3T) + (size_t)l * D * D;
            if (r < I_W1) { const int kb = r % 16, nb = r / 16, n0 = nb * 32; tr_item(ka->in[2] + (size_t)l * D * INW, INW, g1_logical(n0 + (lane & 31)), ka->in[1] + l * D, w1t + (size_t)n0 * D + kb * 64, D, kb * 64, scr, lane); continue; } r -= I_W1;
            if (r < I_G8) { const int kb = r % 16, nb = r / 16, n0 = nb * 32; tr_item8(ka->in[2] + (size_t)l * D * INW, INW, 1536 + n0 + (lane & 31), ka->in[1] + l * D, (unsigned char*)(ws + WS_W1T + (size_t)l * INW * D * 2 + WS_W1G8_OFF) + (size_t)n0 * D + kb * 64, D, kb * 64, scr, lane); continue; } r -= I_G8;
            if (r < I_A) { const int kb = r % 8, n0 = (r / 8) * 32; tr_item(ka->in[10] + (size_t)l * QW * D, D, n0 + (lane & 31), nullptr, w2t + (size_t)n0 * D + kb * 64, D, kb * 64, scr, lane); continue; } r -= I_A;
            if (r < I_B) { const int kb = r % 4, n0 = (r / 4) * 32; tr_item(ka->in[11] + (size_t)l * SGW * D, D, n0 + (lane & 31), nullptr, w2t + (size_t)n0 * D + 512 + kb * 64, D, kb * 64, scr, lane); continue; } r -= I_B;
            if (r < I_C) { const int kb = r % 4, n0 = (r / 4) * 32; tr_item(ka->in[12] + (size_t)l * PLW * D, D, n0 + (lane & 31), nullptr, w2t + (size_t)n0 * D + 768 + kb * 64, D, kb * 64, scr, lane); continue; } r -= I_C;
            { const int kb = r % 16, n0 = (r / 16) * 32; tr_item(ka->in[13] + (size_t)l * D * D, D, n0 + (lane & 31), nullptr, w3t + (size_t)n0 * D + kb * 64, D, kb * 64, scr, lane); }
        }
        { bf16* WSPo = (bf16*)(ws + WS_WSP); bf16* WPTo = (bf16*)(ws + WS_WPT);
          for (int i = (int)blockIdx.x * 512 + tid; i < DEPTH * 4 * 128 * 128; i += G * 512) WSPo[i] = (bf16)f2bf(ka->in[6][i]);
          for (int i = (int)blockIdx.x * 512 + tid; i < DEPTH * 4 * 64 * 64; i += G * 512) { const int c = i & 63, dd = (i >> 6) & 63, lg = i >> 12;
              WPTo[i] = (bf16)f2bf(ka->in[8][((size_t)lg * 64 + c) * 64 + dd] * ka->in[9][lg * 64 + dd]); } }
        { bf16* WRTo = (bf16*)(ws + WS_WRT);
          for (int i = (int)blockIdx.x * 512 + tid; i < DEPTH * NE * D; i += G * 512) { const int k = i & (D - 1), e = (i >> 10) & 15, ll = i >> 14;
              const float w = ka->in[14][ll * D + k] * ka->in[15][((size_t)ll * D + k) * NE + e]; const unsigned hi = f2bf(w); const float rem = w - __builtin_bit_cast(float, hi << 16);
              WRTo[((size_t)ll * 2 * NE + e) * D + k] = (bf16)hi; WRTo[((size_t)ll * 2 * NE + NE + e) * D + k] = (bf16)f2bf(rem); } }
        for (int m = gw; m < M; m += 2 * NGW) {
            const int m2 = m + NGW; const bool has2 = m2 < M;
            const f32x4* xr = (const f32x4*)((ka->in[0]) + (size_t)m * D) + lane; const f32x4* xr2 = (const f32x4*)((ka->in[0]) + (size_t)(has2 ? m2 : m) * D) + lane; f32x4 v[4], v2[4]; float s = 0.f, s2 = 0.f;
#pragma unroll
            for (int j = 0; j < 4; ++j) { v[j] = xr[64 * j]; v2[j] = xr2[64 * j]; }
#pragma unroll
            for (int j = 0; j < 4; ++j) { s += v[j].x * v[j].x + v[j].y * v[j].y + v[j].z * v[j].z + v[j].w * v[j].w; s2 += v2[j].x * v2[j].x + v2[j].y * v2[j].y + v2[j].z * v2[j].z + v2[j].w * v2[j].w; }
            s = wave_sum(s); s2 = wave_sum(s2);
            u32x2* o = (u32x2*)(((bf16*)(ws + WS_XB)) + (size_t)m * D) + lane; u32x2* o2 = (u32x2*)(((bf16*)(ws + WS_XB)) + (size_t)m2 * D) + lane;
#pragma unroll
            for (int j = 0; j < 4; ++j) { u32x2 w; w.x = pk2(v[j].x, v[j].y); w.y = pk2(v[j].z, v[j].w); o[64 * j] = w; if (has2) { u32x2 w2; w2.x = pk2(v2[j].x, v2[j].y); w2.y = pk2(v2[j].z, v2[j].w); o2[64 * j] = w2; } }
            { unsigned* o8 = (unsigned*)(ws + WS_XB8 + (size_t)m * D) + lane; unsigned* o82 = (unsigned*)(ws + WS_XB8 + (size_t)m2 * D) + lane;
#pragma unroll
              for (int j = 0; j < 4; ++j) { o8[64 * j] = pk4_fp8(v[j]); if (has2) o82[64 * j] = pk4_fp8(v2[j]); } }
            if (lane == 0) { ((float*)(ws + WS_R1))[m] = 1.0f / sqrtf(s * (1.0f / D) + EPS); if (has2) ((float*)(ws + WS_R1))[m2] = 1.0f / sqrtf(s2 * (1.0f / D) + EPS); }
        }
    }
    SEAM(0);

    for (int l = 0; l < DEPTH; ++l) {
        const int pb = 1 + l * PH_PER_LAYER;
#ifndef NO_G1
        for (int rr_ = 0; rr_ < REP_G1; ++rr_)
        if (IN(pb + 0)) {
            { KArgs ka = KARGS(); unsigned char* ws = ka->ws;
              LAUNDER_BX(); pg8::Gemm g{((bf16*)(ws + WS_XB)), ((const bf16*)(ws + WS_W1T) + (size_t)l * INW * D), D}; pg8::StaticOrder So; So.init(M, QW + 2 * KVW + 2 * SGW + PLW, G, bx);
              pg8::EpiG1 E{((float*)(ws + WS_R1)), ((float*)(ws + WS_ROPE)), ka->in[3] + l * 64, ka->in[4] + l * 64, ((bf16*)(ws + WS_Q)), ((bf16*)(ws + WS_K)), ((bf16*)(ws + WS_V)), ((bf16*)(ws + WS_U)), ((bf16*)(ws + WS_VS)), ((bf16*)(ws + WS_P))};
              const int n_u = (256 * 6 - bx + G - 1) / G;
              const ConvHook CH{(ka->mode & 16) ? -1 : ((vcu & 7) % (n_u > 0 ? n_u : 1)), l, vcu * NWAVES + wave, NGW};
              pg8::gemm_phase<pg8::EpiG1, pg8::StaticOrder, false, ConvHook>(lds, g, So, E, nullptr, wave * 64 + lane_id_v(), ka->mode, CH); }
            { KArgs ka = KARGS(); unsigned char* ws = ka->ws;
              LAUNDER_BX();
              pg8::Gemm g{((const bf16*)(ws + WS_XB8)), ((const bf16*)(ws + WS_W1T + (size_t)l * INW * D * 2 + WS_W1G8_OFF)), D / 2}; pg8::StaticOrder So; So.init(M, GW, G, bx);
              pg8::EpiGate E{((float*)(ws + WS_R1)), (unsigned char*)(ws + WS_GATES)};
              pg8::gemm_phase<pg8::EpiGate, pg8::StaticOrder, false>(lds, g, So, E, nullptr, wave * 64 + lane_id_v(), ka->mode); }
        }
#endif
        SEAM(pb + 0);
        if (IN(pb + 1)) {
            KArgs ka = KARGS(); unsigned char* ws = ka->ws;
#ifndef NO_ATTN
            for (int rr_ = 0; rr_ < REP_ATTN; ++rr_)
            if (ka->sub & 2) {
                const int tl = wave * 64 + lane_id_v();
                const attn_body::AttnTensors AT{(const attn_body::hbf16*)((bf16*)(ws + WS_Q)), (const attn_body::hbf16*)((bf16*)(ws + WS_K)), (const attn_body::hbf16*)((bf16*)(ws + WS_V)), (attn_body::hbf16*)((bf16*)(ws + WS_ACT))};
                int vl = vcu; asm volatile("" : "+s"(vl));
                attn_body::attn_phase<8>((char*)lds_raw, AT, vl, G, tl);
            }
#endif
#ifndef NO_MIX
            for (int rr_ = 0; rr_ < REP_MIX; ++rr_)
            if (ka->sub & 4) {
                const int lane = lane_id_v(); int vl = vcu; asm volatile("" : "+s"(vl));
                const bf16* WSP = (const bf16*)(ws + WS_WSP) + (size_t)l * 4 * 128 * 128; const bf16* WPT = (const bf16*)(ws + WS_WPT) + (size_t)l * 4 * 64 * 64;
                mix::mix_phase(lds, vl, G, ((bf16*)(ws + WS_VS)), ((bf16*)(ws + WS_U)), ((bf16*)(ws + WS_P)), ((bf16*)(ws + WS_ACT)), ka->in[5] + l * SGW, WSP, ka->in[7] + l * 4 * 128, WPT, wave, lane);
            }
#endif
        }
        SEAM(pb + 1);
#ifndef NO_G2
        for (int rr_ = 0; rr_ < REP_G2; ++rr_)
        if (IN(pb + 2)) {
            KArgs ka = KARGS(); unsigned char* ws = ka->ws;
            LAUNDER_BX(); pg8::Gemm g{((bf16*)(ws + WS_ACT)), ((const bf16*)(ws + WS_W2T) + (size_t)l * D * D), D}; pg8::StaticOrder So; So.init(M, D, G, bx);
            pg8::EpiG2 E{(const unsigned char*)(ws + WS_GATES), ((bf16*)(ws + WS_MERGED))};
            pg8::gemm_phase<pg8::EpiG2, pg8::StaticOrder, false>(lds, g, So, E, nullptr, wave * 64 + lane_id_v(), ka->mode);
        }
#endif
        SEAM(pb + 2);
#ifndef NO_G3
        for (int rr_ = 0; rr_ < (l == 0 ? REP_G3L0 : 1); ++rr_)
        if (IN(pb + 3)) {
            KArgs ka = KARGS(); unsigned char* ws = ka->ws;
            LAUNDER_BX(); pg8::Gemm g{((bf16*)(ws + WS_MERGED)), ((const bf16*)(ws + WS_W3T) + (size_t)l * D * D), D}; pg8::StaticOrder So; So.init(M, D, G, bx);
            pg8::EpiG3 E{((bf16*)(ws + WS_XB)), (unsigned char*)(ws + WS_XB8)};
            pg8::gemm_phase<pg8::EpiG3, pg8::StaticOrder, false>(lds, g, So, E, nullptr, wave * 64 + lane_id_v(), ka->mode);
        }
#endif
        SEAM(pb + 3);
        for (int rr_ = 0; rr_ < REP_ROUTER; ++rr_)
        if (IN(pb + 4)) {
            KArgs ka = KARGS(); unsigned char* ws = ka->ws;
            const int lane = lane_id_v(), fr = lane & 15, fq = lane >> 4, gw = vcu * NWAVES + wave;
            const bf16* wh = (const bf16*)(ws + WS_WRT) + (size_t)l * 2 * NE * D + (size_t)fr * D + 8 * fq; const bf16* wl = wh + NE * D;
            const bf16* xbp = (const bf16*)(ws + WS_XB); float* AFFTp = (float*)(ws + WS_AFFT); float* r2p = (float*)(ws + WS_R2);
            for (int tile = gw; tile < M / 16; tile += NGW) {
                const int row0 = tile * 16; const bf16* xa = xbp + (size_t)(row0 + fr) * D + 8 * fq;
                f32x4 acc = (f32x4){0.f, 0.f, 0.f, 0.f}; float ss = 0.f;
#pragma unroll 8
                for (int ks = 0; ks < 32; ++ks) {
                    const bf16x8 a = *(const bf16x8*)(xa + 32 * ks); const bf16x8 bh = *(const bf16x8*)(wh + 32 * ks), bl = *(const bf16x8*)(wl + 32 * ks);
                    acc = __builtin_amdgcn_mfma_f32_16x16x32_bf16(a, bh, acc, 0, 0, 0); acc = __builtin_amdgcn_mfma_f32_16x16x32_bf16(a, bl, acc, 0, 0, 0);
#pragma unroll
                    for (int j = 0; j < 8; ++j) { const float v = bf2f((unsigned short)a[j]); ss += v * v; }
                }
                ss += xor16_f(ss); ss = sum32_f(ss);
                const float r = 1.0f / sqrtf(ss * (1.0f / D) + EPS);
                f32x4 aff;
#pragma unroll
                for (int rg = 0; rg < 4; ++rg) { const float rt = __builtin_bit_cast(float, __builtin_amdgcn_ds_bpermute((4 * fq + rg) * 4, __builtin_bit_cast(int, r)));
                    const float lg = acc[rg] * rt; const float mx = row16_max(lg); const float pe = expf(lg - mx); aff[rg] = pe / row16_sum(pe); }
                const int b = row0 >> 11, s0 = row0 & (S - 1);
                *(f32x4*)(AFFTp + ((size_t)b * NE + fr) * S + s0 + 4 * fq) = aff;
                if (fq == 0) r2p[row0 + fr] = r;
            }
        }
        SEAM(pb + 4);
        for (int rr_ = 0; rr_ < REP_TOPK; ++rr_)
        if (IN(pb + 5)) {
            KArgs ka = KARGS(); unsigned char* ws = ka->ws;
            const int lane = lane_id_v(), gw = vcu * NWAVES + wave;
            for (int u = gw; u < NB * NE; u += NGW) {
                const int b = u / NE, e = u % NE;
                const float* a = ((float*)(ws + WS_AFFT)) + (size_t)u * S; unsigned key[32];
#pragma unroll
                for (int j = 0; j < 32; ++j) key[j] = __builtin_bit_cast(unsigned, a[64 * j + lane]);
                float r2v[32];
#pragma unroll
                for (int j = 0; j < 32; ++j) r2v[j] = ((const float*)(ws + WS_R2))[b * S + 64 * j + lane];
                unsigned T = 0;
                for (int bit = 31; bit >= 0; --bit) { const unsigned cand = T | (1u << bit); int cnt = 0;
#pragma unroll
                    for (int j = 0; j < 32; ++j) cnt += (key[j] >= cand) ? 1 : 0;
                    cnt = wave_sum_i(cnt);
                    if (cnt >= CAP) T = cand; }
                int cgt = 0;
#pragma unroll
                for (int j = 0; j < 32; ++j) cgt += (key[j] > T) ? 1 : 0;
                cgt = wave_sum_i(cgt);
                const int need_eq = CAP - cgt; int eq_base = 0, base = 0;
                const size_t slot0 = ((size_t)e * NB + b) * CAP;
                short* inv = ((short*)(ws + WS_INV)) + (size_t)u * S;
#pragma unroll
                for (int j = 0; j < 32; ++j) {
                    const bool iseq = key[j] == T; const unsigned long long eqb = __ballot(iseq);
                    const int eqrank = eq_base + __builtin_popcountll(eqb & ((1ull << lane) - 1ull)); eq_base += __builtin_popcountll(eqb);
                    const bool sel = (key[j] > T) || (iseq && eqrank < need_eq);
                    const unsigned long long sb = __ballot(sel);
                    const int pos = base + __builtin_popcountll(sb & ((1ull << lane) - 1ull)); base += __builtin_popcountll(sb);
                    const int sp = 64 * j + lane;
                    if (sel) { ((int*)(ws + WS_IDX))[slot0 + pos] = b * S + sp; ((float*)(ws + WS_VSEL))[slot0 + pos] = __builtin_bit_cast(float, key[j]); ((float*)(ws + WS_RSEL))[slot0 + pos] = r2v[j]; }
                    inv[sp] = sel ? (short)pos : (short)-1;
                }
            }
        }
        SEAM(pb + 5);
#ifndef NO_UP
        for (int rr_ = 0; rr_ < REP_UP; ++rr_)
        if (IN(pb + 6)) {
            KArgs ka = KARGS(); unsigned char* ws = ka->ws;
            LAUNDER_BX(); pg8::Gemm g{((const bf16*)(ws + WS_XB8)), ((const bf16*)(ws + WS_WUP)), D / 2}; pg8::MoeOrder So{8, G, bx};
            pg8::EpiUp E{((float*)(ws + WS_RSEL)), (unsigned char*)(ws + WS_H)};
            pg8::gemm_phase<pg8::EpiUp, pg8::MoeOrder, true>(lds, g, So, E, ((int*)(ws + WS_IDX)), wave * 64 + lane_id_v(), ka->mode, pg8::NoHook(), (const float*)(ws + WS_RSEL));
        }
#endif
        SEAM(pb + 6);
#ifndef NO_DOWN
        for (int rr_ = 0; rr_ < REP_DOWN; ++rr_)
        if (IN(pb + 7)) {
            KArgs ka = KARGS(); unsigned char* ws = ka->ws;
            LAUNDER_BX(); pg8::Gemm g{((const bf16*)(ws + WS_H)), ((const bf16*)(ws + WS_WDN)), FF / 2}; pg8::MoeOrder So{4, G, bx};
            pg8::EpiDown E{((float*)(ws + WS_VSEL)), ((bf16*)(ws + WS_Y))};
            pg8::gemm_phase<pg8::EpiDown, pg8::MoeOrder, false>(lds, g, So, E, nullptr, wave * 64 + lane_id_v(), ka->mode, pg8::NoHook(), (const float*)(ws + WS_VSEL));
        }
#endif
        SEAM(pb + 7);
        if (IN(pb + 8)) {
            KArgs ka = KARGS(); unsigned char* ws = ka->ws;
            const int lane = lane_id_v(), gw = vcu * NWAVES + wave; const bool last_layer = (l == DEPTH - 1);
            bf16* xbp = (bf16*)(ws + WS_XB); const bf16* Yp = (const bf16*)(ws + WS_Y); const short* INVp = (const short*)(ws + WS_INV); float* r1p = (float*)(ws + WS_R1);
            f32x4 gfin[4];
#pragma unroll
            for (int j = 0; j < 4; ++j) gfin[j] = last_layer ? *((const f32x4*)ka->in[19] + lane + 64 * j) : (f32x4){1.f, 1.f, 1.f, 1.f};
            for (int m = gw; m < M; m += NGW) {
                const int b = m >> 11, sp = m & (S - 1);
                const int myc = INVp[((size_t)b * NE + (lane & 15)) * S + sp];
                u32x2* xr = (u32x2*)(xbp + (size_t)m * D) + lane; f32x4 v[4];
#pragma unroll
                for (int j = 0; j < 4; ++j) { const u32x2 w = xr[64 * j]; v[j] = (f32x4){bflo(w.x), bfhi(w.x), bflo(w.y), bfhi(w.y)}; }
                unsigned emask = (unsigned)(__ballot(myc >= 0) & 0xffffull);
                while (emask) {
                    u32x2 y[4][4]; int ne = 0;
#pragma unroll
                    for (int q = 0; q < 4; ++q) { if (emask) { const int e = __builtin_ctz(emask); emask &= emask - 1u; const int c = __builtin_amdgcn_readlane(myc, e);
                            const u32x2* yr = (const u32x2*)(Yp + (((size_t)e * NB + b) * CAP + c) * D) + lane;
#pragma unroll
                            for (int j = 0; j < 4; ++j) y[q][j] = yr[64 * j]; ne = q + 1; }
                        else {
#pragma unroll
                            for (int j = 0; j < 4; ++j) y[q][j] = (u32x2){0u, 0u}; } }
#pragma unroll
                    for (int q = 0; q < 4; ++q)
#pragma unroll
                        for (int j = 0; j < 4; ++j) { v[j].x += bflo(y[q][j].x); v[j].y += bfhi(y[q][j].x); v[j].z += bflo(y[q][j].y); v[j].w += bfhi(y[q][j].y); }
                }
                if (last_layer) {
                    float ss = 0.f;
#pragma unroll
                    for (int j = 0; j < 4; ++j) ss += v[j].x * v[j].x + v[j].y * v[j].y + v[j].z * v[j].z + v[j].w * v[j].w;
                    ss = wave_sum(ss); const float r = 1.0f / sqrtf(ss * (1.0f / D) + EPS);
                    f32x4* orow = (f32x4*)(ka->out + (size_t)m * D) + lane;
#pragma unroll
                    for (int j = 0; j < 4; ++j) orow[64 * j] = v[j] * r * gfin[j];
                } else {
                    float ss = 0.f;
                    unsigned* x8r = (unsigned*)(ws + WS_XB8 + (size_t)m * D) + lane;
#pragma unroll
                    for (int j = 0; j < 4; ++j) { u32x2 w; w.x = pk2(v[j].x, v[j].y); w.y = pk2(v[j].z, v[j].w); xr[64 * j] = w; x8r[64 * j] = pk4_fp8(v[j]);
                        const float a0 = bflo(w.x), a1 = bfhi(w.x), a2 = bflo(w.y), a3 = bfhi(w.y); ss += a0 * a0 + a1 * a1 + a2 * a2 + a3 * a3; }
                    ss = wave_sum(ss);
                    if (lane == 0) r1p[m] = 1.0f / sqrtf(ss * (1.0f / D) + EPS);
                }
            }
        }
        SEAM(pb + 8);
    }
#undef IN
#undef SEAM
}

#ifndef OPT_G1
#define OPT_G1 1
#endif
#ifndef OPT_G2
#define OPT_G2 1
#endif
#ifndef OPT_G3
#define OPT_G3 1
#endif
#ifndef OPT_UP
#define OPT_UP 1
#endif
#ifndef OPT_DOWN
#define OPT_DOWN 1
#endif
extern "C" void kernel_launch(void* const* d_in, const int* in_sizes, int n_in, void* d_out, int out_size, void* d_ws, size_t ws_size, hipStream_t stream) {
    if (n_in != 20 || ws_size < WS_END) { fprintf(stderr, "kernel_launch: unexpected n_in %d / ws_size %zu\n", n_in, ws_size); return; }
    static int grid = 0;
    if (grid == 0) {
        int dev = 0, cus = 0;
        if (hipGetDevice(&dev) != hipSuccess || hipDeviceGetAttribute(&cus, hipDeviceAttributeMultiprocessorCount, dev) != hipSuccess) { grid = -1; return; }
        if (hipFuncSetAttribute((const void*)mk_fwd, hipFuncAttributeMaxDynamicSharedMemorySize, LDS_BYTES) != hipSuccess) { fprintf(stderr, "hipFuncSetAttribute failed\n"); grid = -1; return; }
        (void)hipGetLastError();
        grid = cus;
    }
    if (grid < 0) return;
    unsigned char* ws = (unsigned char*)d_ws;
    static_assert((CW_BAR + XCD_BAR_WORDS) * 4 <= 32768, "barrier words inside the cleared block");
    (void)hipMemsetAsync(ws + WS_CTL, 0, 32768, stream);
    MkArgs a{};
    for (int i = 0; i < 20; ++i) a.in[i] = (const float*)d_in[i];
    a.out = (float*)d_out; a.ws = ws;
    auto run = [&](int lo, int hi, int sub, int mode = 0) { MkArgs b = a; b.ph_lo = lo; b.ph_hi = hi; b.sub = sub; b.mode = mode; hipLaunchKernelGGL(mk_fwd, dim3(grid), dim3(NWAVES * 64), LDS_BYTES, stream, b); };
#ifndef MK_MULTI
#define MK_MULTI 0
#endif
    if (!MK_MULTI) { run(0, PH_TOTAL, 7); return; }
#ifndef PROBE_DUP_PH
#define PROBE_DUP_PH -1
#endif
#ifndef PROBE_DUP_MODE
#define PROBE_DUP_MODE 0
#endif
#ifndef PROBE_DUP_SUB
#define PROBE_DUP_SUB 7
#endif
    if (MK_MULTI == 2) {
        run(0, 1, 0); if (PROBE_DUP_PH == -2) run(0, 1, 0);
        for (int l = 0; l < DEPTH; ++l) { const int pb = 1 + l * PH_PER_LAYER;
            for (int k = 0; k < PH_PER_LAYER; ++k) { run(pb + k, pb + k + 1, 7);
                if (k == PROBE_DUP_PH && (k != 3 || PROBE_DUP_MODE != 0) && k != 8) run(pb + k, pb + k + 1, PROBE_DUP_SUB, PROBE_DUP_MODE); } }
        return;
    }
}
```

```cpp
#include <hip/hip_runtime.h>
#include <hip/hip_bf16.h>
#include <stdint.h>
#include <stdio.h>

#define DEVI __device__ __forceinline__
typedef unsigned short bf16;
typedef short bf16x8 __attribute__((ext_vector_type(8)));
typedef float f32x4 __attribute__((ext_vector_type(4)));
typedef unsigned u32x4 __attribute__((ext_vector_type(4)));
typedef unsigned u32x2 __attribute__((ext_vector_type(2)));

constexpr int NB = 32, S = 2048, D = 1024, M = NB * S, DEPTH = 2;
constexpr int INW = 4608, QW = 512, KVW = 128, SGW = 256, PLW = 256, GW = 3072;
constexpr int NE = 16, CAP = 256, FF = 1024, NSLOT = NB * NE * CAP;
constexpr float EPS = 1e-6f;
constexpr float C2 = 0.125f * 1.4426950408889634f;

constexpr size_t MiB = 1u << 20;
constexpr size_t WS_CTL = 0;
constexpr size_t WS_ROPE = 1 * MiB;
constexpr size_t WS_R1 = WS_ROPE + 64 * 1024;
constexpr size_t WS_R2 = WS_R1 + 256 * 1024;
constexpr size_t WS_IDX = WS_R2 + 256 * 1024;
constexpr size_t WS_VSEL = WS_IDX + 512 * 1024;
constexpr size_t WS_RSEL = WS_VSEL + 512 * 1024;
constexpr size_t WS_INV = 4 * MiB;
constexpr size_t WS_AFFT = 6 * MiB;
constexpr size_t WS_WSP = 10 * MiB;
constexpr size_t WS_WPT = 10 * MiB + 512 * 1024;
constexpr size_t WS_WRT = 11 * MiB;
constexpr size_t WS_W1T = 12 * MiB;
constexpr size_t WS_W2T = 30 * MiB;
constexpr size_t WS_W3T = 34 * MiB;
constexpr size_t WS_WUP = 40 * MiB;
constexpr size_t WS_WDN = 104 * MiB;
constexpr size_t WS_XB = 136 * MiB;
constexpr size_t WS_GATES = 264 * MiB;
constexpr size_t WS_H = WS_GATES;
constexpr size_t WS_XB8 = 520 * MiB;
constexpr size_t WS_W1G8_OFF = 3 * MiB;
constexpr float HSCALE = 16.0f, W8SCALE = 64.0f;
constexpr float GSCALE = 32.0f;
constexpr size_t WS_Q = 648 * MiB;
constexpr size_t WS_K = WS_Q + 64 * MiB;
constexpr size_t WS_V = WS_K + 16 * MiB;
constexpr size_t WS_U = WS_V + 16 * MiB;
constexpr size_t WS_VS = WS_U + 32 * MiB;
constexpr size_t WS_P = WS_VS + 32 * MiB;
constexpr size_t WS_ACT = 840 * MiB;
constexpr size_t WS_MERGED = WS_Q;
constexpr size_t WS_Y = WS_Q;
constexpr size_t WS_END = 968 * MiB;
static_assert(WS_P + 32 * MiB == WS_ACT && WS_ACT + 128 * MiB == WS_END, "ws map");

DEVI unsigned f2bf(float f) { unsigned u = __builtin_bit_cast(unsigned, f); return (u + 0x7fffu + ((u >> 16) & 1u)) >> 16; }
DEVI unsigned pk2(float lo, float hi) { return f2bf(lo) | (f2bf(hi) << 16); }
DEVI float bf2f(unsigned short h) { return __builtin_bit_cast(float, (unsigned)h << 16); }
DEVI float bflo(unsigned w) { return __builtin_bit_cast(float, w << 16); }
DEVI float bfhi(unsigned w) { return __builtin_bit_cast(float, w & 0xffff0000u); }
DEVI int dpp_qx1(int v) { return __builtin_amdgcn_update_dpp(0, v, 0xB1, 0xF, 0xF, true); }
DEVI int dpp_qx2(int v) { return __builtin_amdgcn_update_dpp(0, v, 0x4E, 0xF, 0xF, true); }
DEVI int dpp_hmir(int v) { return __builtin_amdgcn_update_dpp(0, v, 0x141, 0xF, 0xF, true); }
DEVI int dpp_mir(int v) { return __builtin_amdgcn_update_dpp(0, v, 0x140, 0xF, 0xF, true); }
DEVI int swz_x16(int v) { return __builtin_amdgcn_ds_swizzle(v, 0x401F); }
DEVI float xor16_f(float v) { return __builtin_bit_cast(float, swz_x16(__builtin_bit_cast(int, v))); }
DEVI float sum32_f(float v) { unsigned a = __builtin_bit_cast(unsigned, v), b = a; asm volatile("" : "+v"(b)); auto r = __builtin_amdgcn_permlane32_swap(a, b, false, false); const unsigned r0 = r[0], r1 = r[1]; return __builtin_bit_cast(float, r0) + __builtin_bit_cast(float, r1); }
DEVI int sum32_i(int v) { unsigned a = (unsigned)v, b = a; asm volatile("" : "+v"(b)); auto r = __builtin_amdgcn_permlane32_swap(a, b, false, false); return (int)(r[0] + r[1]); }
DEVI float wave_sum(float v) {
    v += __builtin_bit_cast(float, dpp_qx1(__builtin_bit_cast(int, v))); v += __builtin_bit_cast(float, dpp_qx2(__builtin_bit_cast(int, v)));
    v += __builtin_bit_cast(float, dpp_hmir(__builtin_bit_cast(int, v))); v += __builtin_bit_cast(float, dpp_mir(__builtin_bit_cast(int, v)));
    v += xor16_f(v); return sum32_f(v);
}
DEVI int wave_sum_i(int v) {
    v += dpp_qx1(v); v += dpp_qx2(v); v += dpp_hmir(v); v += dpp_mir(v); v += swz_x16(v); return sum32_i(v);
}

__host__ __device__ __forceinline__ int g1_logical(int pos) {
    const int pn = pos >> 8, p = pos & 255, bj = p >> 7, wc = (p >> 5) & 3, r = p & 31, fq = r >> 3, low = r & 7;
    const int d = 32 * (fq >> 1) + 16 * bj + 8 * (fq & 1) + low;
    if (pn < 2) return 64 * (4 * pn + wc) + d;
    if (pn == 2) { if (wc < 2) return 512 + 64 * wc + d; return 640 + (wc - 2) * 64 + bj * 32 + r; }
    return pos;
}
__host__ __device__ __forceinline__ int g1_pos(int c) {
    if (c < 640) { const int head = c >> 6, d = c & 63, a = d >> 5, hf = (d >> 4) & 1, f8 = (d >> 3) & 1, low = d & 7;
        const int fq = 2 * a + f8, r = 8 * fq + low, pn = (c < 512) ? (head >> 2) : 2, wc = (c < 512) ? (head & 3) : (head - 8);
        return 256 * pn + 128 * hf + 32 * wc + r; }
    if (c < 768) { const int v = c - 640, wc = 2 + (v >> 6), bj = (v >> 5) & 1, r = v & 31; return 512 + 128 * bj + 32 * wc + r; }
    return c;
}

DEVI float dppf_qx1(float v) { return __builtin_bit_cast(float, dpp_qx1(__builtin_bit_cast(int, v))); }
DEVI float dppf_qx2(float v) { return __builtin_bit_cast(float, dpp_qx2(__builtin_bit_cast(int, v))); }
DEVI float dppf_hmir(float v) { return __builtin_bit_cast(float, dpp_hmir(__builtin_bit_cast(int, v))); }
DEVI float dppf_mir(float v) { return __builtin_bit_cast(float, dpp_mir(__builtin_bit_cast(int, v))); }
DEVI float row16_sum(float v) { v += dppf_qx1(v); v += dppf_qx2(v); v += dppf_hmir(v); v += dppf_mir(v); return v; }
DEVI float row16_max(float v) { v = fmaxf(v, dppf_qx1(v)); v = fmaxf(v, dppf_qx2(v)); v = fmaxf(v, dppf_hmir(v)); v = fmaxf(v, dppf_mir(v)); return v; }

DEVI float wave_max(float v) { v = row16_max(v); v = fmaxf(v, xor16_f(v)); unsigned x = __builtin_bit_cast(unsigned, v), y = x; asm volatile("" : "+v"(y)); auto r = __builtin_amdgcn_permlane32_swap(x, y, false, false); const unsigned r0 = r[0], r1 = r[1]; return fmaxf(__builtin_bit_cast(float, r0), __builtin_bit_cast(float, r1)); }
DEVI unsigned pk4_fp8(const f32x4 v) { int p = 0; p = __builtin_amdgcn_cvt_pk_fp8_f32(v.x, v.y, p, false); p = __builtin_amdgcn_cvt_pk_fp8_f32(v.z, v.w, p, true); return (unsigned)p; }

#define GAS __attribute__((address_space(1)))
#define LAS __attribute__((address_space(3)))
#define LDS_WAIT() asm volatile("s_waitcnt lgkmcnt(0)" ::: "memory")
#define VM_WAIT() asm volatile("s_waitcnt vmcnt(0)" ::: "memory")
typedef GAS unsigned gu32;
#define RLX_AGENT __ATOMIC_RELAXED, __HIP_MEMORY_SCOPE_AGENT
constexpr int NWAVES = 8;
DEVI int lane_id_v() { int l; asm volatile("v_mbcnt_lo_u32_b32 %0, -1, 0\n\tv_mbcnt_hi_u32_b32 %0, -1, %0" : "=v"(l)); return l; }

namespace pg8 {
constexpr int BM = 256, BK = 64, HALF = 128, HTB = HALF * BK * 2, STAGE_BYTES = 8 * HTB, NXCD = 8, WGM = 8, GIDX_OFF = STAGE_BYTES;
__host__ __device__ __forceinline__ int lds_byte(int r, int c) { const int st = (r >> 4) * 2 + (c >> 5), rr = r & 15, cc = c & 31, ob = rr * 64 + cc * 2; return st * 1024 + (ob ^ (((ob >> 9) & 1) << 5)); }
__host__ __device__ __forceinline__ void stage_rc(int b, int& R, int& C) { const int st = b / 1024, sb = b % 1024, swz = sb ^ (((sb >> 9) & 1) << 5); R = (st >> 1) * 16 + swz / 64; C = (st & 1) * 32 + (swz % 64) / 2; }
__host__ __device__ __forceinline__ int perm32(int rho) { const int n = rho >> 4, i = rho & 15; return 8 * (i >> 2) + 4 * n + (i & 3); }
struct Unit { int pm, pn; };
struct Gemm { const bf16* A; const bf16* Bt; int K; };
struct StaticOrder {
    int nM, nN, nwg, G, c;
    __device__ void init(int M_, int N_, int G_, int c_) { nM = M_ / BM; nN = N_ / BM; nwg = nM * nN; G = G_; c = c_; }
    __device__ bool next(int i, Unit& u) const {
        const long L = (long)i * G + c; if (L >= nwg) return false;
        int wgid = (int)L; { const int q = nwg / NXCD, r = nwg % NXCD, xcd = wgid % NXCD, off = wgid / NXCD; wgid = (xcd < r ? xcd * (q + 1) : r * (q + 1) + (xcd - r) * q) + off; }
        const int nig = WGM * nN, gid = wgid / nig, fm = gid * WGM, gsz = (nM - fm) < WGM ? (nM - fm) : WGM;
        u.pm = fm + ((wgid % nig) % gsz); u.pn = (wgid % nig) / gsz; return true;
    }
};
struct MoeOrder {
    int NJ, G, c;
    __device__ bool next(int i, Unit& u) const {
        const long L = (long)i * G + c; const int per = 32 * NJ; if (L >= (long)NE * per) return false;
        const int e = (int)(L / per), w = (int)(L % per), x = w & 7, q = w >> 3, b = x * 4 + q / NJ, j = q % NJ;
        u.pm = e * 32 + b; u.pn = e * NJ + j; return true;
    }
};
DEVI unsigned cvt_pk_bf16(float lo, float hi) { unsigned r; asm volatile("v_cvt_pk_bf16_f32 %0, %1, %2" : "=v"(r) : "v"(lo), "v"(hi)); return r; }
typedef f32x4 Acc[2][2][4][2];

struct NoHook { DEVI void operator()(int) const {} };
typedef int v4i_t __attribute__((ext_vector_type(4))); typedef int v8i_t __attribute__((ext_vector_type(8)));
DEVI v8i_t cat8(const v4i_t x, const v4i_t y) { return __builtin_shufflevector(x, y, 0, 1, 2, 3, 4, 5, 6, 7); }
template <class Epi, class Sched, bool GATHER, class Hook = NoHook>
DEVI void gemm_phase(LAS unsigned char* lds, const Gemm g, const Sched& S, const Epi& E, const int* __restrict__ gidx, int tid, int mode = 0, const Hook& H = Hook(), const float* __restrict__ rs = nullptr) {
    asm volatile("" : "+v"(tid));
    const int wid = __builtin_amdgcn_readfirstlane(tid >> 6), lane = tid & 63, wr = wid >> 2, wc = wid & 3, fr = lane & 15, fq = lane >> 4;
    int K = g.K; asm volatile("" : "+s"(K));
    const int nt = K / BK;
    unsigned voffA[2], voffB[2]; int RA[2]; unsigned CA2[2];
#pragma unroll
    for (int i = 0; i < 2; ++i) { int R, C; stage_rc(tid * 16 + i * 8192, R, C); const int Rb = (R & ~31) + perm32(R & 31);
        voffA[i] = (unsigned)(R * K + C) * 2u; voffB[i] = (unsigned)(Rb * K + C) * 2u; RA[i] = R; CA2[i] = (unsigned)C * 2u; }
    const size_t kstep = (size_t)(BK * 2);
    const size_t hstep = (size_t)HALF * K * 2;
    const size_t tstep = 2 * hstep;
    const unsigned ldsw = (unsigned)wid * 1024u;
    const int aoff = lds_byte(wr * 64 + fr, fq * 8), boff = lds_byte(wc * 32 + fr, fq * 8);
#define PG8_SA(b, h) (((b) * 2 + (h)) * HTB)
#define PG8_SB(b, h) ((4 + (b) * 2 + (h)) * HTB)
#define PG8_STAGE(bufoff, gbase, voff) do { _Pragma("unroll") for (int _i = 0; _i < 2; ++_i) \
        __builtin_amdgcn_global_load_lds((const unsigned*)((const char*)(gbase) + (voff)[_i]), (LAS unsigned*)(lds + (bufoff) + ldsw + _i * 8192), 16, 0, 0); } while (0)
#define PG8_STAGEA(bufoff, kbase, h, V) do { if constexpr (GATHER) { PG8_STAGE(bufoff, kbase, (V)[h]); } else { PG8_STAGE(bufoff, (kbase) + (h) * hstep, voffA); } } while (0)
#define PG8_LDA(dst, b, h) do { if constexpr (Epi::FP8) { _Pragma("unroll") for (int m = 0; m < 4; ++m) dst##8[m] = cat8(*(const LAS v4i_t*)(lds + PG8_SA(b, h) + aoff + m * 2048), *(const LAS v4i_t*)(lds + PG8_SA(b, h) + aoff + m * 2048 + 1024)); } \
        else { _Pragma("unroll") for (int m = 0; m < 4; ++m) _Pragma("unroll") for (int k = 0; k < 2; ++k) dst[m][k] = *(const LAS bf16x8*)(lds + PG8_SA(b, h) + aoff + m * 2048 + k * 1024); } } while (0)
#define PG8_LDB(dst, b, h) do { if constexpr (Epi::FP8) { _Pragma("unroll") for (int n = 0; n < 2; ++n) dst##8[n] = cat8(*(const LAS v4i_t*)(lds + PG8_SB(b, h) + boff + n * 2048), *(const LAS v4i_t*)(lds + PG8_SB(b, h) + boff + n * 2048 + 1024)); } \
        else { _Pragma("unroll") for (int n = 0; n < 2; ++n) _Pragma("unroll") for (int k = 0; k < 2; ++k) dst[n][k] = *(const LAS bf16x8*)(lds + PG8_SB(b, h) + boff + n * 2048 + k * 1024); } } while (0)
#define PG8_MMA(ai, bj, At, Bt) do { __builtin_amdgcn_s_setprio(1); _Pragma("unroll") for (int m = 0; m < 4; ++m) _Pragma("unroll") for (int n = 0; n < 2; ++n) { \
        if constexpr (Epi::FP8) { asm volatile("v_mfma_scale_f32_16x16x128_f8f6f4 %0, %1, %2, %0, %3, %3 op_sel_hi:[0,0,0]" : "+v"(acc[ai][bj][m][n]) : "v"(Bt##8[n]), "v"(At##8[m]), "v"(one_scale)); } \
        else { _Pragma("unroll") for (int k = 0; k < 2; ++k) acc[ai][bj][m][n] = __builtin_amdgcn_mfma_f32_16x16x32_bf16(Bt[n][k], At[m][k], acc[ai][bj][m][n], 0, 0, 0); } } \
        __builtin_amdgcn_s_setprio(0); } while (0)
#define PG8_WAIT_V(n) asm volatile("s_waitcnt vmcnt(" #n ")" ::: "memory")
#define PG8_WAIT_L(n) asm volatile("s_waitcnt lgkmcnt(" #n ")" ::: "memory")
#define PG8_BAR __builtin_amdgcn_s_barrier()
#define PG8_SCHED __builtin_amdgcn_sched_barrier(0)
#define PG8_LOADV(dst, un) do { _Pragma("unroll") for (int _h = 0; _h < 2; ++_h) _Pragma("unroll") for (int _i = 0; _i < 2; ++_i) \
        dst[_h][_i] = (unsigned)gidx[(un).pm * 256 + _h * 128 + RA[_i]] * (unsigned)(K * 2) + CA2[_i]; } while (0)
#define PG8_DMAV(un) do { _Pragma("unroll") for (int _h = 0; _h < 2; ++_h) _Pragma("unroll") for (int _i = 0; _i < 2; ++_i) \
        __builtin_amdgcn_global_load_lds((const unsigned*)(gidx + (un).pm * 256 + _h * 128 + RA[_i]), (LAS unsigned*)(lds + GIDX_OFF + ((_h * 2 + _i) * 8 + wid) * 256), 4, 0, 0); } while (0)
#define PG8_READV(dst) do { _Pragma("unroll") for (int _h = 0; _h < 2; ++_h) _Pragma("unroll") for (int _i = 0; _i < 2; ++_i) \
        dst[_h][_i] = *(const LAS unsigned*)(lds + GIDX_OFF + ((_h * 2 + _i) * 8 + wid) * 256 + lane * 4) * (unsigned)(K * 2) + CA2[_i]; } while (0)
    Unit cur, nxt; int ui = 0;
    if (!S.next(0, cur)) return;
    Acc acc;
#pragma unroll
    for (int a = 0; a < 2; ++a)
#pragma unroll
        for (int b = 0; b < 2; ++b)
#pragma unroll
            for (int m = 0; m < 4; ++m)
#pragma unroll
                for (int n = 0; n < 2; ++n) acc[a][b][m][n] = (f32x4){0.f, 0.f, 0.f, 0.f};
    bf16x8 At[4][2], B0[2][2], B1[2][2];
    v8i_t At8[4], B08[2], B18[2];
    int one_scale = 0x7f7f7f7f; asm volatile("" : "+v"(one_scale));
    float rsv[8] = {0.f, 0.f, 0.f, 0.f, 0.f, 0.f, 0.f, 0.f};
    unsigned vAc[2][2] = {{0u, 0u}, {0u, 0u}};
    if constexpr (GATHER) { PG8_LOADV(vAc, cur); }
    const char* cA = GATHER ? (const char*)g.A : (const char*)g.A + (size_t)cur.pm * tstep; const char* cB = (const char*)g.Bt + (size_t)cur.pn * tstep;
    PG8_STAGE(PG8_SB(0, 0), cB, voffB); PG8_STAGE(PG8_SB(0, 1), cB + hstep, voffB); PG8_STAGEA(PG8_SA(0, 0), cA, 0, vAc); PG8_STAGEA(PG8_SA(0, 1), cA, 1, vAc);
    if (wr == 1) PG8_BAR;
    PG8_WAIT_V(2); PG8_BAR;
    PG8_STAGE(PG8_SB(1, 0), cB + kstep, voffB); PG8_STAGEA(PG8_SA(1, 0), cA + kstep, 0, vAc); PG8_STAGE(PG8_SB(1, 1), cB + hstep + kstep, voffB);
    PG8_WAIT_V(6); PG8_BAR;
    for (;;) {
        const bool has_next = S.next(ui + 1, nxt);
        if constexpr (GATHER) { if (has_next) { PG8_DMAV(nxt); } }
        const char* nA = GATHER ? (const char*)g.A : (has_next ? (const char*)g.A + (size_t)nxt.pm * tstep : cA);
        const char* nB = has_next ? (const char*)g.Bt + (size_t)nxt.pn * tstep : cB;
        for (int t = 0; t < nt; t += 2) {
            if constexpr (Epi::HAS_MID) { if ((t == Epi::MID0 || t == Epi::MID1) && !(mode & 2)) E.mid(acc, cur, t, wr, wc, fr, fq); }
            const bool last = (t == nt - 2);
            if constexpr (Epi::HAS_RS) { if (last) {
#pragma unroll
                for (int k = 0; k < 8; ++k) rsv[k] = rs[cur.pm * BM + (k >> 2) * HALF + wr * 64 + (k & 3) * 16 + fr]; } }
            const char* a1 = cA + (size_t)(t + 1) * kstep;
            const char* a2 = last ? nA : cA + (size_t)(t + 2) * kstep; const char* b2 = last ? nB : cB + (size_t)(t + 2) * kstep;
            const char* a3 = a2 + kstep; const char* b3 = b2 + kstep;
            PG8_LDB(B0, 0, 0); PG8_LDB(B1, 0, 1); PG8_SCHED; PG8_LDA(At, 0, 0); PG8_STAGEA(PG8_SA(1, 1), a1, 1, vAc);
            PG8_WAIT_V(8); PG8_WAIT_L(0); PG8_BAR; PG8_MMA(0, 0, At, B0); PG8_MMA(0, 1, At, B1); PG8_BAR; PG8_SCHED;
            if constexpr (GATHER) { if (last && has_next) { PG8_READV(vAc); } }
            PG8_LDA(At, 0, 1); PG8_STAGE(PG8_SB(0, 0), b2, voffB); PG8_STAGE(PG8_SB(0, 1), b2 + hstep, voffB); PG8_STAGEA(PG8_SA(0, 0), a2, 0, vAc);
            PG8_WAIT_V(8); PG8_WAIT_L(0); PG8_BAR; PG8_MMA(1, 0, At, B0); PG8_MMA(1, 1, At, B1); PG8_BAR; PG8_SCHED;
            PG8_LDB(B0, 1, 0); PG8_LDB(B1, 1, 1); PG8_SCHED; PG8_LDA(At, 1, 0); PG8_STAGEA(PG8_SA(0, 1), a2, 1, vAc);
            PG8_WAIT_V(8); PG8_WAIT_L(0); PG8_BAR; PG8_MMA(0, 0, At, B0); PG8_MMA(0, 1, At, B1); PG8_BAR; PG8_SCHED;
            PG8_LDA(At, 1, 1); PG8_STAGE(PG8_SB(1, 0), b3, voffB); PG8_STAGE(PG8_SB(1, 1), b3 + hstep, voffB); PG8_STAGEA(PG8_SA(1, 0), a3, 0, vAc);
            PG8_WAIT_V(8); PG8_WAIT_L(0); PG8_BAR; PG8_MMA(1, 0, At, B0); PG8_MMA(1, 1, At, B1); PG8_BAR; PG8_SCHED;
        }
        if (wr == 0) PG8_BAR;
        if constexpr (Epi::FP8) asm volatile("s_nop 15\n\ts_nop 15" ::: "memory");
        if (!(mode & 1)) E(acc, cur, wr, wc, fr, fq, rsv);
        H(ui);
        if (!has_next) break;
#pragma unroll
        for (int a = 0; a < 2; ++a)
#pragma unroll
            for (int b = 0; b < 2; ++b)
#pragma unroll
                for (int m = 0; m < 4; ++m)
#pragma unroll
                    for (int n = 0; n < 2; ++n) acc[a][b][m][n] = (f32x4){0.f, 0.f, 0.f, 0.f};
        cur = nxt; cA = nA; cB = nB; ++ui;
        if (wr == 1) PG8_BAR;
    }
    PG8_WAIT_V(0);
    PG8_BAR;
#undef PG8_SA
#undef PG8_SB
#undef PG8_STAGE
#undef PG8_STAGEA
#undef PG8_LDA
#undef PG8_LDB
#undef PG8_MMA
#undef PG8_WAIT_V
#undef PG8_WAIT_L
#undef PG8_BAR
#undef PG8_SCHED
#undef PG8_LOADV
#undef PG8_DMAV
#undef PG8_READV
}

DEVI u32x4 pack8(const f32x4 a, const f32x4 b) { u32x4 w; w.x = cvt_pk_bf16(a[0], a[1]); w.y = cvt_pk_bf16(a[2], a[3]); w.z = cvt_pk_bf16(b[0], b[1]); w.w = cvt_pk_bf16(b[2], b[3]); return w; }
DEVI float sigm(float v) { v = fmaxf(v, -30.f); return __builtin_amdgcn_rcpf(1.0f + __expf(-v)); }

struct EpiG1 {
    static constexpr bool HAS_MID = false, HAS_RS = false, FP8 = false; static constexpr int MID0 = -1, MID1 = -1;
    const float* r1; const float* g_q; const float* g_k; unsigned char* ws; int pn_off; float ascale; bool use_rsv;
    DEVI void mid(Acc&, const Unit&, int, int, int, int, int) const {}
    DEVI void operator()(const Acc& acc, const Unit& u, int wr, int wc, int fr, int fq, const float (&rsv)[8]) const {
        asm volatile("" : "+v"(fr), "+v"(fq));
        const int row0 = u.pm * BM + wr * 64 + fr, pn = u.pn + pn_off;
        float r1v[8];
#pragma unroll
        for (int k = 0; k < 8; ++k) r1v[k] = (use_rsv ? rsv[k] : r1[row0 + (k >> 2) * HALF + (k & 3) * 16]) * ascale;
        if (pn < 2 || (pn == 2 && wc < 2)) {
            const bool isq = pn < 2; const int a = fq >> 1, f0 = 8 * (fq & 1);
            f32x4 g1[2], g2[2];
#pragma unroll
            for (int n = 0; n < 2; ++n) { const f32x4 q1 = *(const f32x4*)(g_q + 32 * a + f0 + 4 * n), q2 = *(const f32x4*)(g_q + 32 * a + 16 + f0 + 4 * n), k1 = *(const f32x4*)(g_k + 32 * a + f0 + 4 * n), k2 = *(const f32x4*)(g_k + 32 * a + 16 + f0 + 4 * n);
                g1[n] = isq ? q1 : k1; g2[n] = isq ? q2 : k2; }
            const float osc = isq ? C2 : 1.0f;
            float fq8[8];
#pragma unroll
            for (int j = 0; j < 8; ++j) fq8[j] = __builtin_amdgcn_exp2f((float)(f0 + j) * (-2.0f / 32.0f * 13.287712379549449f)) * 0.15915494309189535f;
#pragma unroll
            for (int ai = 0; ai < 2; ++ai)
#pragma unroll
                for (int m = 0; m < 4; ++m) {
                    const int row = row0 + ai * HALF + m * 16; const int tpos_ = row & (S - 1), pos_ = a ? (tpos_ & 63) : (tpos_ >> 6); const float pf = (float)pos_;
                    const float rs = r1v[ai * 4 + m];
                    f32x4 v[2][2]; float ss = 0.f;
#pragma unroll
                    for (int bj = 0; bj < 2; ++bj)
#pragma unroll
                        for (int n = 0; n < 2; ++n) { v[bj][n] = acc[ai][bj][m][n] * rs; ss += v[bj][n][0] * v[bj][n][0] + v[bj][n][1] * v[bj][n][1] + v[bj][n][2] * v[bj][n][2] + v[bj][n][3] * v[bj][n][3]; }
                    ss += xor16_f(ss); ss = sum32_f(ss);
                    const float rn = __builtin_amdgcn_rsqf(ss * (1.0f / 64) + EPS) * osc;
                    f32x4 o1[2], o2[2];
#pragma unroll
                    for (int n = 0; n < 2; ++n) { f32x4 c, sn;
#pragma unroll
                        for (int i = 0; i < 4; ++i) { const float rev = pf * fq8[4 * n + i]; c[i] = __builtin_amdgcn_cosf(rev); sn[i] = __builtin_amdgcn_sinf(rev); }
                        const f32x4 x1 = v[0][n] * rn * g1[n], x2 = v[1][n] * rn * g2[n];
                        o1[n] = x1 * c - x2 * sn; o2[n] = x2 * c + x1 * sn; }
                    bf16* dst = isq ? ((bf16*)(ws + WS_Q) + (size_t)row * QW + 64 * (4 * pn + wc)) : ((bf16*)(ws + WS_K) + (size_t)row * KVW + 64 * wc);
                    *(u32x4*)(dst + 32 * a + f0) = pack8(o1[0], o1[1]); *(u32x4*)(dst + 32 * a + 16 + f0) = pack8(o2[0], o2[1]);
                }
        } else {
            bf16* base; int ld, cb;
            if (pn == 2) { base = (bf16*)(ws + WS_V); ld = KVW; cb = (wc - 2) * 64 + 8 * fq; }
            else if (pn == 3) { base = (bf16*)(ws + WS_U); ld = SGW; cb = 32 * wc + 8 * fq; }
            else if (pn == 4) { base = (bf16*)(ws + WS_VS); ld = SGW; cb = 32 * wc + 8 * fq; }
            else { base = (bf16*)(ws + WS_P); ld = PLW; cb = 32 * wc + 8 * fq; }
            const int bjs = (pn == 2) ? 32 : HALF;
#pragma unroll
            for (int ai = 0; ai < 2; ++ai)
#pragma unroll
                for (int m = 0; m < 4; ++m) {
                    const int row = row0 + ai * HALF + m * 16; const float rs = r1v[ai * 4 + m];
#pragma unroll
                    for (int bj = 0; bj < 2; ++bj) *(u32x4*)(base + (size_t)row * ld + cb + bj * bjs) = pack8(acc[ai][bj][m][0] * rs, acc[ai][bj][m][1] * rs);
                }
        }
    }
};
struct EpiGate {
    static constexpr int NSTORE = 8;
    static constexpr bool HAS_MID = false, HAS_RS = false, FP8 = true; static constexpr int MID0 = -1, MID1 = -1;
    const float* r1; unsigned char* GATES8;
    DEVI void mid(Acc&, const Unit&, int, int, int, int, int) const {}
    DEVI void operator()(const Acc& acc, const Unit& u, int wr, int wc, int fr, int fq, const float (&rsv)[8]) const {
        asm volatile("" : "+v"(fr), "+v"(fq));
        const int row0 = u.pm * BM + wr * 64 + fr, pn = u.pn;
        float r1v[8];
#pragma unroll
        for (int k = 0; k < 8; ++k) r1v[k] = rsv[k];
        {
            unsigned char* gbase = GATES8 + (size_t)(pn >> 2) * 1024 + (pn & 3) * 256 + 64 * wc + 16 * fq;
#pragma unroll
            for (int ai = 0; ai < 2; ++ai)
#pragma unroll
                for (int m = 0; m < 4; ++m) {
                    const int row = row0 + ai * HALF + m * 16; const float rs = r1v[ai * 4 + m] * (-1.4426950408889634f / GSCALE); u32x4 w;
#pragma unroll
                    for (int bj = 0; bj < 2; ++bj)
#pragma unroll
                        for (int n = 0; n < 2; ++n) { unsigned pkd = 0u;
#pragma unroll
                            for (int i = 0; i < 4; ++i) { const float e = __builtin_amdgcn_exp2f(acc[ai][bj][m][n][i] * rs);
                                const float q = fmaxf(__builtin_amdgcn_rcpf(__builtin_fmaf(e, 1.0f / 255.0f, 1.0f / 255.0f)), 1.0f);
                                pkd = __builtin_amdgcn_cvt_pk_u8_f32(q, i, pkd); }
                            w[2 * bj + n] = pkd; }
                    *(u32x4*)(gbase + (size_t)row * GW) = w;
                }
        }
    }
};
struct EpiGQ {
    static constexpr bool HAS_MID = false, HAS_RS = true, FP8 = true; static constexpr int MID0 = -1, MID1 = -1;
    EpiGate g; EpiG1 q;
    DEVI void mid(Acc&, const Unit&, int, int, int, int, int) const {}
    DEVI void operator()(const Acc& acc, const Unit& u, int wr, int wc, int fr, int fq, const float (&rsv)[8]) const {
        if (u.pn < 12) g(acc, u, wr, wc, fr, fq, rsv); else q(acc, u, wr, wc, fr, fq, rsv);
    }
};
struct EpiG2 {
    static constexpr bool HAS_MID = true, HAS_RS = false, FP8 = false; static constexpr int MID0 = 8, MID1 = 12;
    const unsigned char* GATES8; bf16* MERGED;
    DEVI static float ub(unsigned w, int i) { return (float)((w >> (8 * i)) & 0xffu); }
    DEVI void mid(Acc& acc, const Unit& u, int t, int wr, int wc, int fr, int fq) const {
        asm volatile("" : "+v"(fr), "+v"(fq));
        const int row0 = u.pm * BM + wr * 64 + fr; const unsigned char* gp0 = GATES8 + ((t == MID0) ? 0 : 1024) + u.pn * 256 + 64 * wc + 16 * fq;
        u32x4 ga8[8], gb8[8];
#pragma unroll
        for (int k = 0; k < 8; ++k) { const unsigned char* gp = gp0 + (size_t)(row0 + (k >> 2) * HALF + (k & 3) * 16) * GW; ga8[k] = *(const u32x4*)gp; gb8[k] = *(const u32x4*)(gp + 1024); }
        asm volatile("" : "+v"(ga8[0]), "+v"(ga8[1]), "+v"(ga8[2]), "+v"(ga8[3]), "+v"(ga8[4]), "+v"(ga8[5]), "+v"(ga8[6]), "+v"(ga8[7]),
                          "+v"(gb8[0]), "+v"(gb8[1]), "+v"(gb8[2]), "+v"(gb8[3]), "+v"(gb8[4]), "+v"(gb8[5]), "+v"(gb8[6]), "+v"(gb8[7]));
#pragma unroll
        for (int ai = 0; ai < 2; ++ai)
#pragma unroll
            for (int m = 0; m < 4; ++m) { const u32x4 ga = ga8[ai * 4 + m], gb = gb8[ai * 4 + m];
#pragma unroll
                for (int bj = 0; bj < 2; ++bj)
#pragma unroll
                    for (int n = 0; n < 2; ++n)
#pragma unroll
                        for (int i = 0; i < 4; ++i) acc[ai][bj][m][n][i] *= ub(ga[2 * bj + n], i) * __builtin_amdgcn_rcpf(ub(gb[2 * bj + n], i)); }
    }
    DEVI void operator()(const Acc& acc, const Unit& u, int wr, int wc, int fr, int fq, const float (&rsv)[8]) const {
        asm volatile("" : "+v"(fr), "+v"(fq));
        const int row0 = u.pm * BM + wr * 64 + fr, col0 = u.pn * BM + wc * 32 + 8 * fq; const unsigned char* gp0 = GATES8 + 2048 + u.pn * 256 + 64 * wc + 16 * fq;
        u32x4 gc8[8];
#pragma unroll
        for (int k = 0; k < 8; ++k) gc8[k] = *(const u32x4*)(gp0 + (size_t)(row0 + (k >> 2) * HALF + (k & 3) * 16) * GW);
#pragma unroll
        for (int ai = 0; ai < 2; ++ai)
#pragma unroll
            for (int m = 0; m < 4; ++m) { const size_t ro = (size_t)(row0 + ai * HALF + m * 16); const u32x4 gc = gc8[ai * 4 + m];
#pragma unroll
                for (int bj = 0; bj < 2; ++bj) { f32x4 v0 = acc[ai][bj][m][0], v1 = acc[ai][bj][m][1];
#pragma unroll
                    for (int i = 0; i < 4; ++i) { v0[i] *= ub(gc[2 * bj], i) * (1.0f / 255.0f); v1[i] *= ub(gc[2 * bj + 1], i) * (1.0f / 255.0f); }
                    *(u32x4*)(MERGED + ro * D + col0 + bj * HALF) = pack8(v0, v1); } }
    }
};
struct EpiG3 {
    static constexpr bool HAS_MID = false, HAS_RS = false, FP8 = false; static constexpr int MID0 = -1, MID1 = -1;
    bf16* xb; unsigned char* xb8;
    DEVI void mid(Acc&, const Unit&, int, int, int, int, int) const {}
    DEVI void operator()(const Acc& acc, const Unit& u, int wr, int wc, int fr, int fq, const float (&rsv)[8]) const {
        asm volatile("" : "+v"(fr), "+v"(fq));
        const int row0 = u.pm * BM + wr * 64 + fr, col0 = u.pn * BM + wc * 32 + 8 * fq;
        u32x4 xo16[16];
#pragma unroll
        for (int k = 0; k < 16; ++k) xo16[k] = *(const u32x4*)(xb + (size_t)(row0 + (k >> 3) * HALF + ((k >> 1) & 3) * 16) * D + col0 + (k & 1) * HALF);
#pragma unroll
        for (int ai = 0; ai < 2; ++ai)
#pragma unroll
            for (int m = 0; m < 4; ++m) { const size_t ro = (size_t)(row0 + ai * HALF + m * 16) * D + col0;
#pragma unroll
                for (int bj = 0; bj < 2; ++bj) { const size_t o = ro + bj * HALF; const u32x4 xo = xo16[ai * 8 + m * 2 + bj];
                    const f32x4 x0 = (f32x4){bflo(xo[0]), bfhi(xo[0]), bflo(xo[1]), bfhi(xo[1])} + acc[ai][bj][m][0], x1 = (f32x4){bflo(xo[2]), bfhi(xo[2]), bflo(xo[3]), bfhi(xo[3])} + acc[ai][bj][m][1];
                    *(u32x4*)(xb + o) = pack8(x0, x1); u32x2 o8; o8.x = pk4_fp8(x0); o8.y = pk4_fp8(x1); *(u32x2*)(xb8 + o) = o8; } }
    }
};
struct EpiUp {
    static constexpr bool HAS_MID = false, HAS_RS = true, FP8 = true; static constexpr int MID0 = -1, MID1 = -1;
    const float* RSEL; unsigned char* H;
    DEVI void mid(Acc&, const Unit&, int, int, int, int, int) const {}
    DEVI void operator()(const Acc& acc, const Unit& u, int wr, int wc, int fr, int fq, const float (&rsv)[8]) const {
        asm volatile("" : "+v"(fr), "+v"(fq));
        const int slot0 = u.pm * BM + wr * 64 + fr, f0 = (u.pn & 7) * 128 + 32 * wc + 8 * fq;
#pragma unroll
        for (int ai = 0; ai < 2; ++ai)
#pragma unroll
            for (int m = 0; m < 4; ++m) { const int slot = slot0 + ai * HALF + m * 16; const float rs = rsv[ai * 4 + m] * (1.0f / W8SCALE); f32x4 h[2];
#pragma unroll
                for (int n = 0; n < 2; ++n)
#pragma unroll
                    for (int i = 0; i < 4; ++i) { const float a = acc[ai][0][m][n][i] * rs, b = acc[ai][1][m][n][i] * (rs * HSCALE);
                        h[n][i] = __builtin_amdgcn_fmed3f(a * __builtin_amdgcn_rcpf(1.0f + __expf(-a)) * b, -448.f, 448.f); }
                u32x2 o; o.x = pk4_fp8(h[0]); o.y = pk4_fp8(h[1]);
                *(u32x2*)(H + (size_t)slot * FF + f0) = o; }
    }
};
struct EpiDown {
    static constexpr bool HAS_MID = false, HAS_RS = true, FP8 = true; static constexpr int MID0 = -1, MID1 = -1;
    const float* VSEL; bf16* Y;
    DEVI void mid(Acc&, const Unit&, int, int, int, int, int) const {}
    DEVI void operator()(const Acc& acc, const Unit& u, int wr, int wc, int fr, int fq, const float (&rsv)[8]) const {
        asm volatile("" : "+v"(fr), "+v"(fq));
        const int slot0 = u.pm * BM + wr * 64 + fr, col0 = (u.pn & 3) * 256 + 32 * wc + 8 * fq;
#pragma unroll
        for (int ai = 0; ai < 2; ++ai)
#pragma unroll
            for (int m = 0; m < 4; ++m) { const int slot = slot0 + ai * HALF + m * 16; const float vs = rsv[ai * 4 + m] * (1.0f / (HSCALE * W8SCALE));
#pragma unroll
                for (int bj = 0; bj < 2; ++bj) *(u32x4*)(Y + (size_t)slot * D + col0 + bj * HALF) = pack8(acc[ai][bj][m][0] * vs, acc[ai][bj][m][1] * vs); }
    }
};
}

namespace attn_body {
typedef __hip_bfloat16 hbf16;
using s16x4=__attribute__((ext_vector_type(4)))short;
using f32x16=__attribute__((ext_vector_type(16)))float;
constexpr int SEQ=S,HD=64,QP=QW,KP=KVW,OP=1024;
constexpr int NW=8,QBLK=32,QB=QBLK*NW,KVBLK=64,NQB=SEQ/QB;
__device__ __forceinline__ int crow(int r,int hi){return (r&3)+8*(r>>2)+4*hi;}
#define SBAR() __builtin_amdgcn_sched_barrier(0)
constexpr int NSLOT=3, SLOTB=8192;
constexpr int LDS_K=0, LDS_V=NSLOT*SLOTB, LDS_WS=2*NSLOT*SLOTB, LDS_OST=LDS_WS+NW*64*4, LDS_BYTES=LDS_OST+NW*4096;
constexpr float C2=0.125f*1.4426950408889634f;
__device__ __forceinline__ void glds16(const void*gsrc,unsigned lds_dst){unsigned keep;
  asm volatile("s_mov_b32 %0, m0\n\ts_mov_b32 m0, %2\n\ts_nop 0\n\tglobal_load_lds_dwordx4 %1, off\n\ts_mov_b32 m0, %0":"=&s"(keep):"v"(gsrc),"s"(lds_dst):"memory");}
__device__ __forceinline__ float max3f(float a,float b,float c){float r;asm("v_max3_f32 %0, %1, %2, %3":"=v"(r):"v"(a),"v"(b),"v"(c));return r;}
__device__ __forceinline__ float max2f(float a,float b){float r;asm("v_max_f32_e32 %0, %1, %2":"=v"(r):"v"(a),"v"(b));return r;}
__device__ __forceinline__ float fadd_s(float a,float b){float r;asm("v_add_f32_e32 %0, %1, %2":"=v"(r):"v"(a),"v"(b));return r;}
__device__ __forceinline__ float fsub_s(float a,float b){float r;asm("v_sub_f32_e32 %0, %1, %2":"=v"(r):"v"(a),"v"(b));return r;}
typedef float f32x2_t __attribute__((ext_vector_type(2))); typedef __bf16 bf16x2_t __attribute__((ext_vector_type(2)));
__device__ __forceinline__ unsigned cvtpk_s(float lo,float hi){f32x2_t v={lo,hi};bf16x2_t b=__builtin_convertvector(v,bf16x2_t);return __builtin_bit_cast(unsigned,b);}
#define WAIT_BAR(N) asm volatile("s_waitcnt vmcnt(" #N ") lgkmcnt(0)\n\ts_barrier":::"memory")

__device__ __forceinline__ void qkt(f32x16&p0,f32x16&p1,const char*Kslot,const bf16x8*qr,const f32x16&negm,int r32,int hi){
  const char*kb=Kslot+hi*1024+r32*16;
  #pragma unroll
  for(int d0=0;d0<4;++d0){
    const bf16x8 b0=*reinterpret_cast<const bf16x8*>(kb+d0*2048);
    const bf16x8 b1=*reinterpret_cast<const bf16x8*>(kb+d0*2048+512);
    if(d0==0){p0=__builtin_amdgcn_mfma_f32_32x32x16_bf16(b0,qr[0],negm,0,0,0);p1=__builtin_amdgcn_mfma_f32_32x32x16_bf16(b1,qr[0],negm,0,0,0);}
    else{p0=__builtin_amdgcn_mfma_f32_32x32x16_bf16(b0,qr[d0],p0,0,0,0);p1=__builtin_amdgcn_mfma_f32_32x32x16_bf16(b1,qr[d0],p1,0,0,0);}}
}
typedef __attribute__((address_space(3))) const char* lds_cptr;
typedef short v4i16_t __attribute__((ext_vector_type(4)));
__device__ __forceinline__ void kload8(bf16x8*kf,lds_cptr kp){
  kf[0]=*(const __attribute__((address_space(3))) bf16x8*)(kp);      kf[1]=*(const __attribute__((address_space(3))) bf16x8*)(kp+512);
  kf[2]=*(const __attribute__((address_space(3))) bf16x8*)(kp+2048); kf[3]=*(const __attribute__((address_space(3))) bf16x8*)(kp+2560);
  kf[4]=*(const __attribute__((address_space(3))) bf16x8*)(kp+4096); kf[5]=*(const __attribute__((address_space(3))) bf16x8*)(kp+4608);
  kf[6]=*(const __attribute__((address_space(3))) bf16x8*)(kp+6144); kf[7]=*(const __attribute__((address_space(3))) bf16x8*)(kp+6656);
}
__device__ __forceinline__ void kload2(bf16x8*kf,lds_cptr kp,int j){ kf[2*j]=*(const __attribute__((address_space(3))) bf16x8*)(kp+j*2048); kf[2*j+1]=*(const __attribute__((address_space(3))) bf16x8*)(kp+j*2048+512); }
__device__ __forceinline__ s16x4 vtr(lds_cptr p){ return __builtin_bit_cast(s16x4,__builtin_amdgcn_ds_read_tr16_b64_v4i16((__attribute__((address_space(3))) v4i16_t*)p)); }
__device__ __forceinline__ float rowmax(const f32x16&p0,const f32x16&p1){
  float a=max3f(p0[0],p0[1],p1[0]),b=max3f(p0[2],p0[3],p1[1]);a=max3f(a,p1[2],p1[3]);
  #pragma unroll
  for(int r=4;r<16;r+=4){a=max3f(a,p0[r],p0[r+1]);b=max3f(b,p0[r+2],p0[r+3]);a=max3f(a,p1[r],p1[r+1]);b=max3f(b,p1[r+2],p1[r+3]);}
  const float m=max2f(a,b);
  auto rr=__builtin_amdgcn_permlane32_swap(__float_as_uint(m),__float_as_uint(m),false,false);
  return max2f(__uint_as_float(rr[0]),__uint_as_float(rr[1]));
}
__device__ __forceinline__ void pv(f32x16*o,int vb,bf16x8 pa0,bf16x8 pa1,bf16x8 pa2,bf16x8 pa3){
  #pragma unroll
  for(int d0=0;d0<2;++d0){s16x4 lo[4],hi[4];
    #pragma unroll
    for(int ks=0;ks<4;++ks){
      asm volatile("ds_read_b64_tr_b16 %0,%1 offset:%c2":"=&v"(lo[ks]):"v"(vb),"i"(d0*4096+ks*1024):"memory");
      asm volatile("ds_read_b64_tr_b16 %0,%1 offset:%c2":"=&v"(hi[ks]):"v"(vb),"i"(d0*4096+ks*1024+512):"memory");}
    asm volatile("s_waitcnt lgkmcnt(0)":::"memory");SBAR();
    #define PK(k) (bf16x8){lo[k][0],lo[k][1],lo[k][2],lo[k][3],hi[k][0],hi[k][1],hi[k][2],hi[k][3]}
    o[d0]=__builtin_amdgcn_mfma_f32_32x32x16_bf16(pa0,PK(0),o[d0],0,0,0);
    o[d0]=__builtin_amdgcn_mfma_f32_32x32x16_bf16(pa1,PK(1),o[d0],0,0,0);
    o[d0]=__builtin_amdgcn_mfma_f32_32x32x16_bf16(pa2,PK(2),o[d0],0,0,0);
    o[d0]=__builtin_amdgcn_mfma_f32_32x32x16_bf16(pa3,PK(3),o[d0],0,0,0);
    #undef PK
  }
}

#ifndef ATTN_STORE16
#define ATTN_STORE16(p,v) (*(u32x4*)(p)=(v))
#endif
template<int THRL,bool FAST> __device__ __forceinline__ void attn_unit(int b,int h,int qb,const hbf16*Q,const hbf16*__restrict__ K,const hbf16*__restrict__ V,hbf16*O,char*shm,int tid,bool first,bool has_next,bf16x8 (&qr)[4]){
  const int lane=tid&63,r32=lane&31,hi=lane>>5; const int wid=__builtin_amdgcn_readfirstlane(tid>>6);
  const long rowbase=(long)b*SEQ; const int q0=qb*QB;
  const hbf16*Qw=Q+(rowbase+q0+wid*QBLK)*QP+h*HD;
  const hbf16*Kh=K+rowbase*KP+(h>>2)*HD,*Vh=V+rowbase*KP+(h>>2)*HD;
  const unsigned lds0=(unsigned)(uintptr_t)shm;
  float*wsf=(float*)(shm+LDS_WS)+wid*64;
  const hbf16*ksrc=Kh+(long)lane*KP+wid*8;
  const hbf16*vsrc=Vh+(long)(16*(wid&3)+(lane>>2))*KP+(wid>>2)*32+(lane&3)*8;
  const unsigned kdst=lds0+LDS_K+wid*1024, vdst=lds0+LDS_V+wid*1024;
  #define DMA_K(t,slot) glds16(ksrc+(long)(t)*KVBLK*KP,(unsigned)__builtin_amdgcn_readfirstlane(kdst+(slot)))
  #define DMA_V(t,slot) glds16(vsrc+(long)(t)*KVBLK*KP,(unsigned)__builtin_amdgcn_readfirstlane(vdst+(slot)))
  const int vb0=(int)(lds0+LDS_V)+((lane>>4)&1)*32+(lane&3)*8+(4*hi+((lane&15)>>2))*64;
  const char*Kbase=shm+LDS_K; bf16x8 kf[8];
  const lds_cptr shm3=(lds_cptr)shm; const lds_cptr kp0=shm3+LDS_K+hi*1024+r32*16; const lds_cptr vp0=shm3+LDS_V+((lane>>4)&1)*32+(lane&3)*8+(4*hi+((lane&15)>>2))*64;
  constexpr int NT=SEQ/KVBLK;
  if(first){ DMA_K(0,0);DMA_V(0,0);DMA_K(1,SLOTB);
  _Pragma("unroll") for(int d0=0;d0<4;++d0)qr[d0]=*reinterpret_cast<const bf16x8*>(&Qw[(long)r32*QP+d0*16+hi*8]); }
  float mhat=0.f,l_reg=0.f;f32x16 o[2],negm;{float z_=0.f;asm volatile("":"+v"(z_));
  _Pragma("unroll") for(int r=0;r<16;++r){o[0][r]=z_;o[1][r]=z_;negm[r]=z_;}}asm volatile("":"+v"(negm));
  #define CMASK(P0,P1,t) do{}while(0)
  bool resc=false;
  #define START(P0,P1) do{ resc=false; \
    if constexpr(!FAST){ const float rm=rowmax(P0,P1); const float dl=rm; mhat=fadd_s(mhat,dl); \
      _Pragma("unroll") for(int r=0;r<16;++r){P0[r]=fsub_s(P0[r],dl);P1[r]=fsub_s(P1[r],dl);} \
      _Pragma("unroll") for(int r=0;r<16;++r)negm[r]=-mhat; asm volatile("":"+v"(negm)); } \
    _Pragma("unroll") for(int r=0;r<16;++r)P0[r]=__builtin_amdgcn_exp2f(P0[r]); }while(0)
  #define RESC() do{ if(!FAST&&resc){ asm volatile("s_waitcnt lgkmcnt(0)":::"memory"); \
      _Pragma("unroll") for(int d_=0;d_<2;++d_) _Pragma("unroll") for(int r=0;r<16;++r)o[d_][r]*=wsf[crow(r,hi)]; } }while(0)
  f32x16 pA0,pA1,pB0,pB1;
  int sl_prev=0,sl_cur=0,sl_next=SLOTB;
  #define ROT() do{sl_prev=sl_cur;sl_cur=sl_next;sl_next=(sl_next==(NSLOT-1)*SLOTB)?0:sl_next+SLOTB;}while(0)
  if(first){ DMA_K(2,2*SLOTB);
    WAIT_BAR(3); }
  else { WAIT_BAR(4); }
  qkt(pA0,pA1,Kbase,qr,negm,r32,hi);asm volatile("s_nop 15\n\ts_nop 7":"+v"(pA0),"+v"(pA1));CMASK(pA0,pA1,0);
  START(pA0,pA1);
  _Pragma("unroll") for(int r=0;r<16;++r)pA1[r]=__builtin_amdgcn_exp2f(pA1[r]);
  WAIT_BAR(0);
  DMA_K(3,0);DMA_V(1,SLOTB);
  ROT();
  kload8(kf,kp0+sl_cur);
  WAIT_BAR(2);
  s16x4 vlo[8],vhi[8]; u32x4 pw0,pw1,pw2,pw3;
  #define PKW(P,B) cvtpk_s(P[B],P[B+1])
  #define PAF(k) __builtin_bit_cast(bf16x8,pw##k)
  #define VFR(i) (bf16x8){vlo[i][0],vlo[i][1],vlo[i][2],vlo[i][3],vhi[i][0],vhi[i][1],vhi[i][2],vhi[i][3]}
  #define PIN(x) asm volatile("":"+v"(x))
  #define MX3(a,b,c) __builtin_fmaxf(__builtin_fmaxf((a),(b)),(c))
  #define GAPA(MF,A0,A1,A2,A3,W0,W1,PW) do{ MF; sacc+=A0; sacc+=A1; sacc+=A2; sacc+=A3; PIN(sacc); W0; W1; PIN(PW); SBAR(); }while(0)
  #define EX(v) __builtin_amdgcn_exp2f(v)
  #define GAPB(MF,X,B) do{ MF; X[B]=EX(X[B]); X[B+1]=EX(X[B+1]); X[B+2]=EX(X[B+2]); X[B+3]=EX(X[B+3]); PIN(X); SBAR(); }while(0)
  #define VRD(i) do{ vlo[i]=vtr(vp_+(((i)>>2)*4096+((i)&3)*1024)); vhi[i]=vtr(vp_+(((i)>>2)*4096+((i)&3)*1024+512)); }while(0)
  #define KRD(G,j) do{ if(G){ kload2(kf,kp0+sl_next,j); SBAR(); } }while(0)
  #define STEP(C0,C1,P0,P1,t,GK,GV,GL) do{ SBAR(); \
    const lds_cptr vp_=vp0+sl_prev; \
    VRD(0); SBAR(); float sacc=(P0[0]+P0[1]); \
    GAPA(C0=__builtin_amdgcn_mfma_f32_32x32x16_bf16(kf[0],qr[0],negm,0,0,0), P0[2],P0[3],P0[4],P0[5],     pw0[0]=PKW(P0,0), pw0[1]=PKW(P0,2), pw0); \
    VRD(4); SBAR(); GAPA(C1=__builtin_amdgcn_mfma_f32_32x32x16_bf16(kf[1],qr[0],negm,0,0,0), P0[6],P0[7],P0[8],P0[9],     pw0[2]=PKW(P0,4), pw0[3]=PKW(P0,6), pw0); \
    VRD(1); SBAR(); GAPA(C0=__builtin_amdgcn_mfma_f32_32x32x16_bf16(kf[2],qr[1],C0,0,0,0),   P0[10],P0[11],P0[12],P0[13], pw1[0]=PKW(P0,8), pw1[1]=PKW(P0,10), pw1); \
    VRD(5); SBAR(); GAPA(C1=__builtin_amdgcn_mfma_f32_32x32x16_bf16(kf[3],qr[1],C1,0,0,0),   P0[14],P0[15],P1[0],P1[1],   pw1[2]=PKW(P0,12),pw1[3]=PKW(P0,14), pw1); \
    VRD(2); SBAR(); GAPA(C0=__builtin_amdgcn_mfma_f32_32x32x16_bf16(kf[4],qr[2],C0,0,0,0),   P1[2],P1[3],P1[4],P1[5],     pw2[0]=PKW(P1,0), pw2[1]=PKW(P1,2), pw2); \
    VRD(6); SBAR(); GAPA(C1=__builtin_amdgcn_mfma_f32_32x32x16_bf16(kf[5],qr[2],C1,0,0,0),   P1[6],P1[7],P1[8],P1[9],     pw2[2]=PKW(P1,4), pw2[3]=PKW(P1,6), pw2); \
    VRD(3); SBAR(); GAPA(C0=__builtin_amdgcn_mfma_f32_32x32x16_bf16(kf[6],qr[3],C0,0,0,0),   P1[10],P1[11],P1[12],P1[13], pw3[0]=PKW(P1,8), pw3[1]=PKW(P1,10), pw3); \
    VRD(7); SBAR(); GAPA(C1=__builtin_amdgcn_mfma_f32_32x32x16_bf16(kf[7],qr[3],C1,0,0,0),   P1[14],P1[15],0.f,0.f,       pw3[2]=PKW(P1,12),pw3[3]=PKW(P1,14), pw3); \
    l_reg+=sacc; \
    if(GK){DMA_K((t)+3,sl_cur);} if(GV){DMA_V((t)+1,sl_next);} \
    CMASK(C0,C1,t); \
    if constexpr(!FAST){ float a=MX3(C0[0],C0[1],C1[0]),b=MX3(C0[2],C0[3],C1[1]); a=MX3(a,C1[2],C1[3]); \
      _Pragma("unroll") for(int r=4;r<16;r+=4){a=MX3(a,C0[r],C0[r+1]);b=MX3(b,C0[r+2],C0[r+3]);a=MX3(a,C1[r],C1[r+1]);b=MX3(b,C1[r+2],C1[r+3]);} \
      float rm=__builtin_fmaxf(a,b); { auto rr=__builtin_amdgcn_permlane32_swap(__float_as_uint(rm),__float_as_uint(rm),false,false); rm=__builtin_fmaxf(__uint_as_float(rr[0]),__uint_as_float(rr[1])); } \
      resc=false; \
      if(__builtin_expect(__any(rm>(float)THRL),0)){ const float dl=__builtin_fmaxf(rm,0.f); mhat+=dl; \
        _Pragma("unroll") for(int r=0;r<16;++r){C0[r]-=dl;C1[r]-=dl;} \
        _Pragma("unroll") for(int r=0;r<16;++r)negm[r]=-mhat; asm volatile("":"+v"(negm)); \
        const float f=__builtin_amdgcn_exp2f(-dl); l_reg*=f; if(hi==0)wsf[r32]=f; resc=true; } } \
    SBAR(); \
    GAPB(o[0]=__builtin_amdgcn_mfma_f32_32x32x16_bf16(PAF(0),VFR(0),o[0],0,0,0), C0,0); \
    GAPB(o[1]=__builtin_amdgcn_mfma_f32_32x32x16_bf16(PAF(0),VFR(4),o[1],0,0,0), C0,4); \
    KRD(GL,0); GAPB(o[0]=__builtin_amdgcn_mfma_f32_32x32x16_bf16(PAF(1),VFR(1),o[0],0,0,0), C0,8); \
    KRD(GL,1); GAPB(o[1]=__builtin_amdgcn_mfma_f32_32x32x16_bf16(PAF(1),VFR(5),o[1],0,0,0), C0,12); \
    KRD(GL,2); GAPB(o[0]=__builtin_amdgcn_mfma_f32_32x32x16_bf16(PAF(2),VFR(2),o[0],0,0,0), C1,0); \
    KRD(GL,3); GAPB(o[1]=__builtin_amdgcn_mfma_f32_32x32x16_bf16(PAF(2),VFR(6),o[1],0,0,0), C1,4); \
    GAPB(o[0]=__builtin_amdgcn_mfma_f32_32x32x16_bf16(PAF(3),VFR(3),o[0],0,0,0), C1,8); \
    GAPB(o[1]=__builtin_amdgcn_mfma_f32_32x32x16_bf16(PAF(3),VFR(7),o[1],0,0,0), C1,12); \
    }while(0)
  int t=1;
  for(;t+5<NT;t+=2){
    STEP(pB0,pB1,pA0,pA1,t,true,true,true);     WAIT_BAR(2); RESC(); ROT();
    STEP(pA0,pA1,pB0,pB1,t+1,true,true,true);   WAIT_BAR(2); RESC(); ROT();
  }
  #define ENDW(tt) do{ if((tt)+3<NT){WAIT_BAR(2);} else if((tt)+2<NT){WAIT_BAR(1);} else {WAIT_BAR(0);} }while(0)
  for(;t+1<NT;t+=2){
    STEP(pB0,pB1,pA0,pA1,t,(t+3<NT),(t+1<NT),(t+1<NT));       ENDW(t);   RESC(); ROT();
    STEP(pA0,pA1,pB0,pB1,t+1,(t+4<NT),(t+2<NT),(t+2<NT));     ENDW(t+1); RESC(); ROT();
  }
  STEP(pB0,pB1,pA0,pA1,NT-1,false,false,false); RESC();
  { float sacc=pB0[0]+pB0[1]; _Pragma("unroll") for(int r=2;r<16;++r)sacc+=pB0[r]; _Pragma("unroll") for(int r=0;r<16;++r)sacc+=pB1[r]; l_reg+=sacc;
    pw0=(u32x4){PKW(pB0,0),PKW(pB0,2),PKW(pB0,4),PKW(pB0,6)};pw1=(u32x4){PKW(pB0,8),PKW(pB0,10),PKW(pB0,12),PKW(pB0,14)};pw2=(u32x4){PKW(pB1,0),PKW(pB1,2),PKW(pB1,4),PKW(pB1,6)};pw3=(u32x4){PKW(pB1,8),PKW(pB1,10),PKW(pB1,12),PKW(pB1,14)};
    SBAR(); pv(o,vb0+sl_cur,PAF(0),PAF(1),PAF(2),PAF(3)); }
  #undef PKW
  #undef PAF
  #undef VFR
  #undef PIN
  #undef MX3
  #undef GAPA
  #undef GAPB
  #undef EX
  #undef VRD
  #undef KRD
  #undef STEP
  #undef ENDW
  if(has_next){ asm volatile("s_waitcnt lgkmcnt(0)\n\ts_barrier":::"memory");
    DMA_K(0,0);DMA_V(0,0);DMA_K(1,SLOTB);DMA_K(2,2*SLOTB);
    _Pragma("unroll") for(int d0=0;d0<4;++d0)qr[d0]=*reinterpret_cast<const bf16x8*>(&Qw[(long)(QB+r32)*QP+d0*16+hi*8]); }
  {auto rr=__builtin_amdgcn_permlane32_swap(__float_as_uint(l_reg),__float_as_uint(l_reg),false,false);l_reg=__uint_as_float(rr[0])+__uint_as_float(rr[1]);}
  if(hi==0)wsf[32+r32]=l_reg;asm volatile("s_waitcnt lgkmcnt(0)":::"memory");
  float rli[16];
  #pragma unroll
  for(int r=0;r<16;++r)rli[r]=__builtin_amdgcn_rcpf(wsf[32+crow(r,hi)]);
  hbf16*Ow=O+(rowbase+q0+wid*QBLK)*OP+h*HD;
  { hbf16*stg=(hbf16*)(shm+LDS_OST)+wid*2048;
    #pragma unroll
    for(int r=0;r<16;++r){const int orow=crow(r,hi);
      #pragma unroll
      for(int d0=0;d0<2;++d0)stg[orow*64+d0*32+r32]=__float2bfloat16(o[d0][r]*rli[r]);}
    asm volatile("s_waitcnt lgkmcnt(0)":::"memory");
    #pragma unroll
    for(int i=0;i<4;++i){const int row=i*8+(lane>>3),ch=lane&7; const u32x4 v=*(const u32x4*)(stg+row*64+ch*8); ATTN_STORE16(Ow+(long)row*OP+ch*8,v);} }
  if(!has_next){ asm volatile("s_waitcnt lgkmcnt(0)\n\ts_barrier":::"memory"); }
  #undef DMA_K
  #undef DMA_V
  #undef CMASK
  #undef START
  #undef RESC
  #undef ROT
}
constexpr int ATTN_LDS_BYTES=LDS_BYTES;
struct AttnTensors { const hbf16* Q; const hbf16* K; const hbf16* V; hbf16* O; };
template<int THRL=8> __device__ __forceinline__ void attn_phase(char*lds,const AttnTensors&T,int vcu,int G,int tid,bool fast){
  bf16x8 qr[4];
  if(fast){ for(int L=vcu;L<NB*8;L+=G){ const int b=L>>3,h=L&7; for(int qb=0;qb<NQB;++qb) attn_unit<THRL,true>(b,h,qb,T.Q,T.K,T.V,T.O,lds,tid,qb==0,qb+1<NQB,qr); } }
  else    { for(int L=vcu;L<NB*8;L+=G){ const int b=L>>3,h=L&7; for(int qb=0;qb<NQB;++qb) attn_unit<THRL,false>(b,h,qb,T.Q,T.K,T.V,T.O,lds,tid,qb==0,qb+1<NQB,qr); } }
}
#undef SBAR
#undef WAIT_BAR
}


namespace mix {
constexpr int VS_STRIDE = 544, P_STRIDE = 528;
constexpr int VS_OFF = 0, P_OFF = 128 * VS_STRIDE, P_ROWS = 143, LDS_END = P_OFF + P_ROWS * P_STRIDE;
typedef short v4i16_t __attribute__((ext_vector_type(4)));
typedef short s16x4 __attribute__((ext_vector_type(4)));
DEVI s16x4 vtr(const LAS unsigned char* p) { return __builtin_bit_cast(s16x4, __builtin_amdgcn_ds_read_tr16_b64_v4i16((LAS v4i16_t*)p)); }
DEVI void mix_phase(LAS unsigned char* lds, int c0, int cstep, const bf16* VS, const bf16* U, const bf16* P, bf16* ACT, const float* g_sgu, const bf16* WSP, const float* b_sp, const bf16* WPT, int wave, int lane) {
    const int fr = lane & 15, fq = lane >> 4, sg = wave >> 1, ph = wave & 1, tid = wave * 64 + lane;
    bf16x8 wsp[4][4];
    { const bf16* wb = WSP + ((size_t)sg * 128 + 64 * ph + fr) * 128 + 8 * fq;
#pragma unroll
      for (int ks = 0; ks < 4; ++ks)
#pragma unroll
          for (int pb = 0; pb < 4; ++pb) wsp[ks][pb] = *(const bf16x8*)(wb + (size_t)16 * pb * 128 + 32 * ks); }
    const f32x4 gs = *(const f32x4*)(g_sgu + 4 * lane);
    float bias4[4];
#pragma unroll
    for (int pb = 0; pb < 4; ++pb) bias4[pb] = b_sp[sg * 128 + 64 * ph + 16 * pb + fr];
    for (int chunk = c0; chunk < M / 128; chunk += cstep) {
        const size_t row0 = (size_t)chunk * 128; const int tpos0 = (chunk & 15) * 128;
#pragma unroll 1
        for (int h8 = 0; h8 < 2; ++h8) { u32x2 w[8];
#pragma unroll
            for (int i = 0; i < 8; ++i) w[i] = *(const u32x2*)(VS + (row0 + wave * 16 + h8 * 8 + i) * SGW + 4 * lane);
#pragma unroll
            for (int i = 0; i < 8; ++i) { const float v0 = bflo(w[i].x), v1 = bfhi(w[i].x), v2 = bflo(w[i].y), v3 = bfhi(w[i].y);
                const float ss = wave_sum(v0 * v0 + v1 * v1 + v2 * v2 + v3 * v3); const float r = __builtin_amdgcn_rsqf(ss * (1.0f / SGW) + EPS);
                u32x2 o; o.x = pk2(v0 * r * gs[0], v1 * r * gs[1]); o.y = pk2(v2 * r * gs[2], v3 * r * gs[3]);
                *(LAS u32x2*)(lds + VS_OFF + (wave * 16 + h8 * 8 + i) * VS_STRIDE + 8 * lane) = o; } }
#pragma unroll 1
        for (int bt = 0; bt < 3; ++bt) { u32x4 pv[3];
#pragma unroll
            for (int it = 0; it < 3; ++it) { const int pc = tid + (bt * 3 + it) * 512, j = pc >> 5, c = pc & 31, tp = tpos0 - 8 + j;
                pv[it] = (u32x4){0u, 0u, 0u, 0u}; if (pc < P_ROWS * 32 && tp >= 0 && tp < S) pv[it] = *(const u32x4*)(P + ((long)row0 - 8 + j) * PLW + 8 * c); }
#pragma unroll
            for (int it = 0; it < 3; ++it) { const int pc = tid + (bt * 3 + it) * 512; if (pc < P_ROWS * 32) *(LAS u32x4*)(lds + P_OFF + (pc >> 5) * P_STRIDE + 16 * (pc & 31)) = pv[it]; } }
        u32x2 uw[4][4];
        { const unsigned uo = (unsigned)(((unsigned)row0 + 64 * ph + fr) * SGW + 64 * sg + 4 * fq) * 2u;
#pragma unroll
          for (int pb = 0; pb < 4; ++pb)
#pragma unroll
              for (int cb = 0; cb < 4; ++cb) uw[pb][cb] = *(const u32x2*)((const char*)U + (uo + (unsigned)(16 * pb * SGW + 16 * cb) * 2u)); }
        LDS_WAIT(); __syncthreads();
        { f32x4 acc[4][4];
#pragma unroll
          for (int a = 0; a < 4; ++a)
#pragma unroll
              for (int b = 0; b < 4; ++b) acc[a][b] = (f32x4){0.f, 0.f, 0.f, 0.f};
          const LAS unsigned char* abase = lds + VS_OFF + (8 * fq + (fr >> 2)) * VS_STRIDE + (64 * sg + 4 * (fr & 3)) * 2;
#pragma unroll
          for (int ks = 0; ks < 4; ++ks) {
              bf16x8 af[4];
#pragma unroll
              for (int cb = 0; cb < 4; ++cb) { const s16x4 lo = vtr(abase + 32 * ks * VS_STRIDE + 32 * cb), hi = vtr(abase + (32 * ks + 4) * VS_STRIDE + 32 * cb);
                  af[cb] = (bf16x8){lo[0], lo[1], lo[2], lo[3], hi[0], hi[1], hi[2], hi[3]}; }
#pragma unroll
              for (int cb = 0; cb < 4; ++cb)
#pragma unroll
                  for (int pb = 0; pb < 4; ++pb) acc[cb][pb] = __builtin_amdgcn_mfma_f32_16x16x32_bf16(af[cb], wsp[ks][pb], acc[cb][pb], 0, 0, 0);
          }
#pragma unroll
          for (int pb = 0; pb < 4; ++pb) { const int p = 64 * ph + 16 * pb + fr; const float bias = bias4[pb];
#pragma unroll
              for (int cb = 0; cb < 4; ++cb) { const int ch = 64 * sg + 16 * cb + 4 * fq; const u32x2 u2 = uw[pb][cb];
                  u32x2 o; o.x = pk2(bflo(u2.x) * (acc[cb][pb][0] + bias), bfhi(u2.x) * (acc[cb][pb][1] + bias)); o.y = pk2(bflo(u2.y) * (acc[cb][pb][2] + bias), bfhi(u2.y) * (acc[cb][pb][3] + bias));
                  *(u32x2*)((char*)ACT + (unsigned)((((unsigned)row0 + p) * 1024 + 512 + ch) * 2u)) = o; } } }
        { const int t = 16 * wave + fr, tp = tpos0 + t;
#pragma unroll 1
          for (int g = 0; g < 4; ++g) { const int wd = 2 << g, lo_off = wd >> 1, hi_off = wd - 1 - lo_off;
              bf16x8 wf[2][4];
#pragma unroll
              for (int ks = 0; ks < 2; ++ks)
#pragma unroll
                  for (int db = 0; db < 4; ++db) wf[ks][db] = *(const bf16x8*)(WPT + ((size_t)g * 64 + 16 * db + fr) * 64 + 32 * ks + 8 * fq);
              int lo = tp - lo_off; if (lo < 0) lo = 0; int hi = tp + hi_off; if (hi > S - 1) hi = S - 1; const float icnt = 1.0f / (float)(hi - lo + 1);
              f32x4 acc[4];
#pragma unroll
              for (int a = 0; a < 4; ++a) acc[a] = (f32x4){0.f, 0.f, 0.f, 0.f};
#pragma unroll
              for (int ks = 0; ks < 2; ++ks) { const LAS unsigned char* pb_ = lds + P_OFF + (64 * g + 32 * ks + 8 * fq) * 2;
                  float sum[8];
#pragma unroll
                  for (int i = 0; i < 8; ++i) sum[i] = 0.f;
#pragma unroll 1
                  for (int j = -lo_off; j <= hi_off; ++j) { const u32x4 v = *(const LAS u32x4*)(pb_ + (t + 8 + j) * P_STRIDE);
                      sum[0] += bflo(v[0]); sum[1] += bfhi(v[0]); sum[2] += bflo(v[1]); sum[3] += bfhi(v[1]); sum[4] += bflo(v[2]); sum[5] += bfhi(v[2]); sum[6] += bflo(v[3]); sum[7] += bfhi(v[3]); }
                  const u32x4 c0 = *(const LAS u32x4*)(pb_ + (t + 8) * P_STRIDE);
                  u32x4 dw; dw[0] = pk2(sum[0] * icnt - bflo(c0[0]), sum[1] * icnt - bfhi(c0[0])); dw[1] = pk2(sum[2] * icnt - bflo(c0[1]), sum[3] * icnt - bfhi(c0[1]));
                  dw[2] = pk2(sum[4] * icnt - bflo(c0[2]), sum[5] * icnt - bfhi(c0[2])); dw[3] = pk2(sum[6] * icnt - bflo(c0[3]), sum[7] * icnt - bfhi(c0[3]));
                  const bf16x8 dfr = __builtin_bit_cast(bf16x8, dw);
#pragma unroll
                  for (int db = 0; db < 4; ++db) acc[db] = __builtin_amdgcn_mfma_f32_16x16x32_bf16(wf[ks][db], dfr, acc[db], 0, 0, 0); }
#pragma unroll
              for (int db = 0; db < 4; ++db) { u32x2 o; o.x = pk2(acc[db][0], acc[db][1]); o.y = pk2(acc[db][2], acc[db][3]);
                  *(u32x2*)((char*)ACT + (unsigned)((((unsigned)row0 + t) * 1024 + 768 + 64 * g + 16 * db + 4 * fq) * 2u)) = o; } } }
        LDS_WAIT(); __syncthreads();
    }
}
}

#define XB_TMO      128
#define XB_XCNT(j)  (256  + 64 * (j))
#define XB_XSUB(j)  (1280 + 64 * (j))
#define XB_XGEN(j)  (2304 + 64 * (j))
#define XB_TOP      3328
#define XB_TOPGEN   3392
#define XCD_BAR_WORDS 3456
#define XB_SPIN_CAP (1u << 21)
DEVI unsigned xb_ld(unsigned* p)              { return __hip_atomic_load(p, __ATOMIC_RELAXED, __HIP_MEMORY_SCOPE_AGENT); }
DEVI unsigned xb_add(unsigned* p, unsigned v) { return __hip_atomic_fetch_add(p, v, __ATOMIC_RELAXED, __HIP_MEMORY_SCOPE_AGENT); }
DEVI unsigned xb_xcc_id() { return (unsigned)__builtin_amdgcn_s_getreg((3 << 11) | 20) & 0xFu; }
#define XB_SPIN(cond, bar) do { unsigned _sp = 0; while (cond) { __builtin_amdgcn_s_sleep(1); \
    if ((++_sp & 255u) == 0u) { if (xb_ld(&(bar)[XB_TMO])) break; if (_sp > XB_SPIN_CAP) { atomicAdd(&(bar)[XB_TMO], 1u); break; } } } } while (0)
struct XcdBarrier { unsigned* bar; unsigned x; volatile LAS unsigned* st; };
DEVI XcdBarrier xcd_barrier_post(unsigned* bar, volatile LAS unsigned* st) {
    XcdBarrier b; b.bar = bar; b.x = xb_xcc_id(); b.st = st;
    if (threadIdx.x == 0) (void)xb_add(&bar[XB_XCNT(b.x)], 1u);
    return b;
}
DEVI void xcd_barrier_complete(unsigned* bar, unsigned x, unsigned& nloc, unsigned& nx) {
    const unsigned G = gridDim.x * gridDim.y * gridDim.z;
    unsigned sum, cnt, mine, sp = 0u;
    for (;;) {
        sum = 0u; cnt = 0u; mine = 0u;
#pragma unroll
        for (unsigned j = 0; j < 16; ++j) { const unsigned c = xb_ld(&bar[XB_XCNT(j)]); sum += c; cnt += (c > 0u) ? 1u : 0u; mine = (j == x) ? c : mine; }
        if (sum == G) break;
        __builtin_amdgcn_s_sleep(1);
        if ((++sp & 255u) == 0u) { if (xb_ld(&bar[XB_TMO])) break; if (sp > XB_SPIN_CAP) { atomicAdd(&bar[XB_TMO], 1u); break; } }
    }
    nloc = mine > 0u ? mine : 1u; nx = cnt > 0u ? cnt : 1u;
}
DEVI void xcd_barrier(const XcdBarrier& b, int tid) {
    asm volatile("s_waitcnt vmcnt(0)" ::: "memory");
    __syncthreads();
    if (tid == 0) {
        unsigned* bar = b.bar; unsigned bx = b.x;
        asm volatile("" : "+s"(bar), "+s"(bx));
        __builtin_amdgcn_s_waitcnt(0);
        unsigned nloc = b.st[0], nx = b.st[1];
        if (nloc == 0u) { xcd_barrier_complete(bar, bx, nloc, nx); b.st[0] = nloc; b.st[1] = nx; }
        const unsigned old = xb_add(&bar[XB_XSUB(bx)], 1u);
        const unsigned gen = old / nloc;
        if (old + 1u == (gen + 1u) * nloc) {
            __builtin_amdgcn_fence(__ATOMIC_RELEASE, "agent");
            asm volatile("s_waitcnt vmcnt(0)" ::: "memory");
            const unsigned og = xb_add(&bar[XB_TOP], 1u);
            const unsigned tg = og / nx;
            if (og + 1u == (tg + 1u) * nx) xb_add(&bar[XB_TOPGEN], 1u);
            else XB_SPIN(xb_ld(&bar[XB_TOPGEN]) == tg, bar);
            __builtin_amdgcn_fence(__ATOMIC_ACQUIRE, "agent");
            xb_add(&bar[XB_XGEN(bx)], 1u);
            asm volatile("s_waitcnt vmcnt(0)" ::: "memory");
        } else {
            XB_SPIN(xb_ld(&bar[XB_XGEN(bx)]) == gen, bar);
            __builtin_amdgcn_fence(__ATOMIC_ACQUIRE, "agent");
            asm volatile("s_waitcnt vmcnt(0)" ::: "memory");
        }
    }
    __syncthreads();
}

constexpr int RING_BYTES = 131072;
constexpr int MISC_OFF = 147456, LDS_BYTES = 147456 + 512;
constexpr int CW_BAR = 4096;
static_assert((CW_BAR + XCD_BAR_WORDS) * 4 <= (int)MiB, "ctl");

struct MkArgs {
    const float* in[20]; float* out; unsigned char* ws;
    int ph_lo, ph_hi, sub, mode;
};
typedef const __attribute__((address_space(4))) MkArgs* KArgs;
#define KARGS() ({ KArgs _p = (KArgs)__builtin_amdgcn_kernarg_segment_ptr(); asm volatile("" : "+s"(_p)); _p; })
struct ConvHook {
    int at, l, gw, ngw;
    struct Item { const float* src; const float* ks; unsigned char* out; int ld, col; };
    DEVI static Item decode(int it, int lane, const float* wg, const float* wu, const float* wd, const float* gf, unsigned char* ws) {
        constexpr int I_UP = NE * 32 * 16; Item t;
        if (it < I_UP) { const int e = it >> 9, q = it & 511, nb = q >> 4, kb = q & 15, np = nb * 64 + lane, bj = (np >> 7) & 1;
            t.src = (bj ? wu : wg) + (size_t)e * D * FF + (size_t)kb * 64 * FF; t.ld = FF; t.col = (np >> 8) * 128 + (np & 127); t.ks = gf + kb * 64; t.out = ws + WS_WUP + ((size_t)e * 2048 + np) * D + kb * 64; }
        else { const int r = it - I_UP, e = r >> 8, q = r & 255, nb = q >> 4, kb = q & 15, np = nb * 64 + lane;
            t.src = wd + (size_t)e * FF * D + (size_t)kb * 64 * D; t.ld = D; t.col = np; t.ks = nullptr; t.out = ws + WS_WDN + ((size_t)e * 1024 + np) * FF + kb * 64; }
        return t;
    }
    DEVI static void load(const Item& t, float (&v)[64]) {
#pragma unroll
        for (int kk = 0; kk < 64; ++kk) v[kk] = t.src[(size_t)kk * t.ld + t.col];
    }
    DEVI static void store(const Item& t, float (&v)[64]) {
        if (t.ks) {
#pragma unroll
            for (int kk = 0; kk < 64; ++kk) v[kk] *= t.ks[kk]; }
#pragma unroll
        for (int c = 0; c < 4; ++c) { u32x4 o;
#pragma unroll
            for (int q = 0; q < 4; ++q) { f32x4 x; x[0] = v[16 * c + 4 * q] * W8SCALE; x[1] = v[16 * c + 4 * q + 1] * W8SCALE; x[2] = v[16 * c + 4 * q + 2] * W8SCALE; x[3] = v[16 * c + 4 * q + 3] * W8SCALE; o[q] = pk4_fp8(x); }
            *(u32x4*)(t.out + 16 * c) = o; }
    }
    DEVI void operator()(int ui) const {
        if (ui != at) return;
        KArgs ka = KARGS(); unsigned char* ws = ka->ws; const int lane = lane_id_v();
        const float* wg = ka->in[16] + (size_t)l * NE * D * FF; const float* wu = ka->in[17] + (size_t)l * NE * D * FF; const float* wd = ka->in[18] + (size_t)l * NE * FF * D;
        const float* gf = ka->in[14] + l * D;
        constexpr int I_ALL = NE * 32 * 16 + NE * 16 * 16;
        float va[64], vb[64];
        int it = gw; if (it >= I_ALL) return;
        Item ta = decode(it, lane, wg, wu, wd, gf, ws), tb = ta; load(ta, va);
        for (;;) {
            const bool more_b = it + ngw < I_ALL; if (more_b) { tb = decode(it + ngw, lane, wg, wu, wd, gf, ws); load(tb, vb); }
            store(ta, va); if (!more_b) break; it += ngw;
            const bool more_a = it + ngw < I_ALL; if (more_a) { ta = decode(it + ngw, lane, wg, wu, wd, gf, ws); load(ta, va); }
            store(tb, vb); if (!more_a) break; it += ngw;
        }
    }
};

constexpr int PH_PER_LAYER = 9, PH_TOTAL = 1 + DEPTH * PH_PER_LAYER;

DEVI void tr_item(const float* src, int ld, int col, const float* kscale, bf16* out0, int ldo, int k0, LAS float* scr, int lane) {
#pragma unroll 8
    for (int i = 0; i < 32; ++i) { const int kk = 2 * i + (lane >> 5); float v = src[(size_t)(k0 + kk) * ld + col]; if (kscale) v *= kscale[k0 + kk]; scr[kk * 33 + (lane & 31)] = v; }
    LDS_WAIT(); asm volatile("" ::: "memory");
    const int c = lane & 7;
#pragma unroll
    for (int j = 0; j < 4; ++j) { const int n = (lane >> 3) + 8 * j; const LAS float* s = scr + (8 * c) * 33 + n;
        u32x4 o; o.x = pk2(s[0 * 33], s[1 * 33]); o.y = pk2(s[2 * 33], s[3 * 33]); o.z = pk2(s[4 * 33], s[5 * 33]); o.w = pk2(s[6 * 33], s[7 * 33]);
        *(u32x4*)(out0 + (size_t)n * ldo + 8 * c) = o; }
    LDS_WAIT(); asm volatile("" ::: "memory");
}


#ifndef REP_G1
#define REP_G1 1
#endif
#ifndef REP_CONV
#define REP_CONV 1
#endif
#ifndef REP_ATTN
#define REP_ATTN 1
#endif
#ifndef REP_MIX
#define REP_MIX 1
#endif
#ifndef REP_G2
#define REP_G2 1
#endif
#ifndef REP_G3L0
#define REP_G3L0 1
#endif
#ifndef REP_ROUTER
#define REP_ROUTER 1
#endif
#ifndef REP_TOPK
#define REP_TOPK 1
#endif
#ifndef REP_UP
#define REP_UP 1
#endif
#ifndef REP_DOWN
#define REP_DOWN 1
#endif
DEVI void tr_item8(const float* src, int ld, int col, const float* kscale, unsigned char* out0, int ldo, int k0, LAS float* scr, int lane) {
#pragma unroll 8
    for (int i = 0; i < 32; ++i) { const int kk = 2 * i + (lane >> 5); scr[kk * 33 + (lane & 31)] = src[(size_t)(k0 + kk) * ld + col] * kscale[k0 + kk] * GSCALE; }
    LDS_WAIT(); asm volatile("" ::: "memory");
    const int c = lane & 7;
#pragma unroll
    for (int j = 0; j < 4; ++j) { const int n = (lane >> 3) + 8 * j; const LAS float* s = scr + (8 * c) * 33 + n;
        int lo = 0, hi = 0; lo = __builtin_amdgcn_cvt_pk_fp8_f32(s[0 * 33], s[1 * 33], lo, false); lo = __builtin_amdgcn_cvt_pk_fp8_f32(s[2 * 33], s[3 * 33], lo, true);
        hi = __builtin_amdgcn_cvt_pk_fp8_f32(s[4 * 33], s[5 * 33], hi, false); hi = __builtin_amdgcn_cvt_pk_fp8_f32(s[6 * 33], s[7 * 33], hi, true);
        u32x2 o; o.x = (unsigned)lo; o.y = (unsigned)hi; *(u32x2*)(out0 + (size_t)n * ldo + 8 * c) = o; }
    LDS_WAIT(); asm volatile("" ::: "memory");
}
__global__ void __launch_bounds__(NWAVES * 64, 2) mk_fwd(MkArgs args) {
    extern __shared__ __attribute__((aligned(16))) unsigned char lds_raw[];
    LAS unsigned char* lds = (LAS unsigned char*)lds_raw;
    volatile LAS unsigned* MISC = (volatile LAS unsigned*)(lds + MISC_OFF);
    const int wave = __builtin_amdgcn_readfirstlane((int)threadIdx.x >> 6);
    const int G = gridDim.x; const int vcu = (G % 8 == 0) ? ((int)blockIdx.x % 8) * (G / 8) + (int)blockIdx.x / 8 : (int)blockIdx.x;
    gu32* ctl; { KArgs ka0 = KARGS(); ctl = (gu32*)(ka0->ws + WS_CTL); }
    { const int t0 = wave * 64 + lane_id_v(); if (t0 < 128) MISC[t0] = 0u; }
    __syncthreads();
    int lo, hi; { KArgs ka0 = KARGS(); lo = ka0->ph_lo; hi = ka0->ph_hi; }
    const bool use_bar = (hi - lo) > 1;
    XcdBarrier bar; bar.bar = (unsigned*)(ctl + CW_BAR); bar.x = 0; bar.st = nullptr;
    if (use_bar) bar = xcd_barrier_post((unsigned*)(ctl + CW_BAR), MISC + 8);
#define IN(k) (lo <= (k) && (k) < hi)
#define LAUNDER_BX() int bx = (int)blockIdx.x; asm volatile("" : "+s"(bx))
#define SEAM(k) do { if (IN(k) && IN((k) + 1)) xcd_barrier(bar, wave * 64 + lane_id_v()); } while (0)
    const int NGW = G * NWAVES;
    if (IN(0)) {
            KArgs ka = KARGS(); unsigned char* ws = ka->ws;
        const int lane = lane_id_v(), tid = wave * 64 + lane, gw = vcu * NWAVES + wave;
        LAS float* scr = (LAS float*)(lds + wave * 16384);
        { const int i = blockIdx.x * 512 + tid; if (i < 64 * 16) { const int pos = i >> 4, f = i & 15; const float freq = powf(10000.0f, -(float)(2 * f) / 32.0f); const float ang = (float)pos * freq;
            ((float*)(ws + WS_ROPE))[2 * i] = cosf(ang); ((float*)(ws + WS_ROPE))[2 * i + 1] = sinf(ang); } }
        constexpr int I_W1 = 16 * 24, I_G8 = 16 * 120, I_A = 8 * 32, I_B = 4 * 32, I_C = 4 * 32, I_W3 = 16 * 32, I_L = I_W1 + I_G8 + I_A + I_B + I_C + I_W3;
        for (int it = gw; it < DEPTH * I_L; it += NGW) {
            const int l = it / I_L; int r = it % I_L;
            bf16* w1t = (bf16*)(ws + WS_W1T) + (size_t)l * INW * D; bf16* w2t = (bf16*)(ws + WS_W2T) + (size_t)l * D * D; bf16* w3t = (bf16*)(ws + WS_W3T) + (size_t)l * D * D;
            if (r < I_W1) { const int kb = r % 16, nb = 24 + r / 16, n0 = nb * 32; tr_item(ka->in[2] + (size_t)l * D * INW, INW, g1_logical(n0 + (lane & 31)), ka->in[1] + l * D, w1t + (size_t)n0 * D + kb * 64, D, kb * 64, scr, lane); continue; } r -= I_W1;
            if (r < I_G8) { const int kb = r % 16, nb = r / 16, n0 = nb * 32; tr_item8(ka->in[2] + (size_t)l * D * INW, INW, (nb < 96) ? 1536 + n0 + (lane & 31) : g1_logical(n0 - 3072 + (lane & 31)), ka->in[1] + l * D, (unsigned char*)(ws + WS_W1T + (size_t)l * INW * D * 2 + WS_W1G8_OFF) + (size_t)n0 * D + kb * 64, D, kb * 64, scr, lane); continue; } r -= I_G8;
            if (r < I_A) { const int kb = r % 8, n0 = (r / 8) * 32; tr_item(ka->in[10] + (size_t)l * QW * D, D, n0 + (lane & 31), nullptr, w2t + (size_t)n0 * D + kb * 64, D, kb * 64, scr, lane); continue; } r -= I_A;
            if (r < I_B) { const int kb = r % 4, n0 = (r / 4) * 32; tr_item(ka->in[11] + (size_t)l * SGW * D, D, n0 + (lane & 31), nullptr, w2t + (size_t)n0 * D + 512 + kb * 64, D, kb * 64, scr, lane); continue; } r -= I_B;
            if (r < I_C) { const int kb = r % 4, n0 = (r / 4) * 32; tr_item(ka->in[12] + (size_t)l * PLW * D, D, n0 + (lane & 31), nullptr, w2t + (size_t)n0 * D + 768 + kb * 64, D, kb * 64, scr, lane); continue; } r -= I_C;
            { const int kb = r % 16, n0 = (r / 16) * 32; tr_item(ka->in[13] + (size_t)l * D * D, D, n0 + (lane & 31), nullptr, w3t + (size_t)n0 * D + kb * 64, D, kb * 64, scr, lane); }
        }
        { bf16* WSPo = (bf16*)(ws + WS_WSP); bf16* WPTo = (bf16*)(ws + WS_WPT);
          for (int i = (int)blockIdx.x * 512 + tid; i < DEPTH * 4 * 128 * 128; i += G * 512) WSPo[i] = (bf16)f2bf(ka->in[6][i]);
          for (int i = (int)blockIdx.x * 512 + tid; i < DEPTH * 4 * 64 * 64; i += G * 512) { const int c = i & 63, dd = (i >> 6) & 63, lg = i >> 12;
              WPTo[i] = (bf16)f2bf(ka->in[8][((size_t)lg * 64 + c) * 64 + dd] * ka->in[9][lg * 64 + dd]); } }
        { bf16* WRTo = (bf16*)(ws + WS_WRT);
          for (int i = (int)blockIdx.x * 512 + tid; i < DEPTH * NE * D; i += G * 512) { const int k = i & (D - 1), e = (i >> 10) & 15, ll = i >> 14;
              const float w = ka->in[14][ll * D + k] * ka->in[15][((size_t)ll * D + k) * NE + e]; const unsigned hi = f2bf(w); const float rem = w - __builtin_bit_cast(float, hi << 16);
              WRTo[((size_t)ll * 2 * NE + e) * D + k] = (bf16)hi; WRTo[((size_t)ll * 2 * NE + NE + e) * D + k] = (bf16)f2bf(rem); } }
        {
            int m = gw;
            if (m < M) {
                const float* xin = ka->in[0];
                f32x4 v[4], v2[4];
                { const int m2 = m + NGW; const f32x4* xr = (const f32x4*)(xin + (size_t)m * D) + lane; const f32x4* xr2 = (const f32x4*)(xin + (size_t)(m2 < M ? m2 : m) * D) + lane;
#pragma unroll
                  for (int j = 0; j < 4; ++j) { v[j] = xr[64 * j]; v2[j] = xr2[64 * j]; } }
                for (;;) {
                    const int m2 = m + NGW; const bool has2 = m2 < M;
                    const int mn = m + 2 * NGW, mn2 = mn + NGW; const bool more = mn < M;
                    f32x4 nv[4], nv2[4];
                    { const f32x4* xr = (const f32x4*)(xin + (size_t)(more ? mn : m) * D) + lane; const f32x4* xr2 = (const f32x4*)(xin + (size_t)(mn2 < M ? mn2 : m) * D) + lane;
#pragma unroll
                      for (int j = 0; j < 4; ++j) { nv[j] = xr[64 * j]; nv2[j] = xr2[64 * j]; } }
                    float s = 0.f, s2 = 0.f;
#pragma unroll
                    for (int j = 0; j < 4; ++j) { s += v[j].x * v[j].x + v[j].y * v[j].y + v[j].z * v[j].z + v[j].w * v[j].w; s2 += v2[j].x * v2[j].x + v2[j].y * v2[j].y + v2[j].z * v2[j].z + v2[j].w * v2[j].w; }
                    s = wave_sum(s); s2 = wave_sum(s2);
                    u32x2* o = (u32x2*)(((bf16*)(ws + WS_XB)) + (size_t)m * D) + lane; u32x2* o2 = (u32x2*)(((bf16*)(ws + WS_XB)) + (size_t)m2 * D) + lane;
#pragma unroll
                    for (int j = 0; j < 4; ++j) { u32x2 w; w.x = pk2(v[j].x, v[j].y); w.y = pk2(v[j].z, v[j].w); o[64 * j] = w; if (has2) { u32x2 w2; w2.x = pk2(v2[j].x, v2[j].y); w2.y = pk2(v2[j].z, v2[j].w); o2[64 * j] = w2; } }
                    { unsigned* o8 = (unsigned*)(ws + WS_XB8 + (size_t)m * D) + lane; unsigned* o82 = (unsigned*)(ws + WS_XB8 + (size_t)m2 * D) + lane;
#pragma unroll
                      for (int j = 0; j < 4; ++j) { o8[64 * j] = pk4_fp8(v[j]); if (has2) o82[64 * j] = pk4_fp8(v2[j]); } }
                    if (lane == 0) { ((float*)(ws + WS_R1))[m] = 1.0f / sqrtf(s * (1.0f / D) + EPS); if (has2) ((float*)(ws + WS_R1))[m2] = 1.0f / sqrtf(s2 * (1.0f / D) + EPS); }
                    if (!more) break;
                    m = mn;
#pragma unroll
                    for (int j = 0; j < 4; ++j) { v[j] = nv[j]; v2[j] = nv2[j]; }
                }
            }
        }
    }
    SEAM(0);

    for (int l = 0; l < DEPTH; ++l) {
        const int pb = 1 + l * PH_PER_LAYER;
#ifndef NO_G1
        for (int rr_ = 0; rr_ < REP_G1; ++rr_)
        if (IN(pb + 0)) {
            { KArgs ka = KARGS(); unsigned char* ws = ka->ws;
              LAUNDER_BX(); pg8::Gemm g{((bf16*)(ws + WS_XB)), ((const bf16*)(ws + WS_W1T) + (size_t)l * INW * D + (size_t)768 * D), D}; pg8::StaticOrder So; So.init(M, 2 * SGW + PLW, G, bx);
              pg8::EpiG1 E{((float*)(ws + WS_R1)), ka->in[3] + l * 64, ka->in[4] + l * 64, ws, 3, 1.0f, false};
              const int n_u = (256 * 3 - bx + G - 1) / G;
              const ConvHook CH{(ka->mode & 16) ? -1 : ((vcu & 7) % (n_u > 0 ? n_u : 1)), l, vcu * NWAVES + wave, NGW};
              pg8::gemm_phase<pg8::EpiG1, pg8::StaticOrder, false, ConvHook>(lds, g, So, E, nullptr, wave * 64 + lane_id_v(), ka->mode, CH); }
            { KArgs ka = KARGS(); unsigned char* ws = ka->ws;
              LAUNDER_BX();
              pg8::Gemm g{((const bf16*)(ws + WS_XB8)), ((const bf16*)(ws + WS_W1T + (size_t)l * INW * D * 2 + WS_W1G8_OFF)), D / 2}; pg8::StaticOrder So; So.init(M, GW + 768, G, bx);
              pg8::EpiGQ E{pg8::EpiGate{((float*)(ws + WS_R1)), (unsigned char*)(ws + WS_GATES)},
                  pg8::EpiG1{((float*)(ws + WS_R1)), ka->in[3] + l * 64, ka->in[4] + l * 64, ws, -12, 1.0f / GSCALE, true}};
              pg8::gemm_phase<pg8::EpiGQ, pg8::StaticOrder, false>(lds, g, So, E, nullptr, wave * 64 + lane_id_v(), ka->mode, pg8::NoHook(), (const float*)(ws + WS_R1)); }
        }
#endif
        SEAM(pb + 0);
        if (IN(pb + 1)) {
            KArgs ka = KARGS(); unsigned char* ws = ka->ws;
#ifndef NO_ATTN
            for (int rr_ = 0; rr_ < REP_ATTN; ++rr_)
            if (ka->sub & 2) {
                const int tl = wave * 64 + lane_id_v();
                const attn_body::AttnTensors AT{(const attn_body::hbf16*)((bf16*)(ws + WS_Q)), (const attn_body::hbf16*)((bf16*)(ws + WS_K)), (const attn_body::hbf16*)((bf16*)(ws + WS_V)), (attn_body::hbf16*)((bf16*)(ws + WS_ACT))};
                int vl = vcu; asm volatile("" : "+s"(vl));
                const float gqm = wave_max(fabsf(ka->in[3][l * 64 + (tl & 63)])), gkm = wave_max(fabsf(ka->in[4][l * 64 + (tl & 63)]));
                const bool fast = (64.0f * attn_body::C2 * 1.02f) * gqm * gkm < 40.0f;
                attn_body::attn_phase<8>((char*)lds_raw, AT, vl, G, tl, __builtin_amdgcn_readfirstlane((int)fast) != 0);
            }
#endif
#ifndef NO_MIX
            for (int rr_ = 0; rr_ < REP_MIX; ++rr_)
            if (ka->sub & 4) {
                const int lane = lane_id_v(); int vl = vcu; asm volatile("" : "+s"(vl));
                const bf16* WSP = (const bf16*)(ws + WS_WSP) + (size_t)l * 4 * 128 * 128; const bf16* WPT = (const bf16*)(ws + WS_WPT) + (size_t)l * 4 * 64 * 64;
                mix::mix_phase(lds, vl, G, ((bf16*)(ws + WS_VS)), ((bf16*)(ws + WS_U)), ((bf16*)(ws + WS_P)), ((bf16*)(ws + WS_ACT)), ka->in[5] + l * SGW, WSP, ka->in[7] + l * 4 * 128, WPT, wave, lane);
            }
#endif
        }
        SEAM(pb + 1);
#ifndef NO_G2
        for (int rr_ = 0; rr_ < REP_G2; ++rr_)
        if (IN(pb + 2)) {
            KArgs ka = KARGS(); unsigned char* ws = ka->ws;
            LAUNDER_BX(); pg8::Gemm g{((bf16*)(ws + WS_ACT)), ((const bf16*)(ws + WS_W2T) + (size_t)l * D * D), D}; pg8::StaticOrder So; So.init(M, D, G, bx);
            pg8::EpiG2 E{(const unsigned char*)(ws + WS_GATES), ((bf16*)(ws + WS_MERGED))};
            pg8::gemm_phase<pg8::EpiG2, pg8::StaticOrder, false>(lds, g, So, E, nullptr, wave * 64 + lane_id_v(), ka->mode);
        }
#endif
        SEAM(pb + 2);
#ifndef NO_G3
        for (int rr_ = 0; rr_ < (l == 0 ? REP_G3L0 : 1); ++rr_)
        if (IN(pb + 3)) {
            KArgs ka = KARGS(); unsigned char* ws = ka->ws;
            LAUNDER_BX(); pg8::Gemm g{((bf16*)(ws + WS_MERGED)), ((const bf16*)(ws + WS_W3T) + (size_t)l * D * D), D}; pg8::StaticOrder So; So.init(M, D, G, bx);
            pg8::EpiG3 E{((bf16*)(ws + WS_XB)), (unsigned char*)(ws + WS_XB8)};
            pg8::gemm_phase<pg8::EpiG3, pg8::StaticOrder, false>(lds, g, So, E, nullptr, wave * 64 + lane_id_v(), ka->mode);
        }
#endif
        SEAM(pb + 3);
        for (int rr_ = 0; rr_ < REP_ROUTER; ++rr_)
        if (IN(pb + 4)) {
            KArgs ka = KARGS(); unsigned char* ws = ka->ws;
            const int lane = lane_id_v(), fr = lane & 15, fq = lane >> 4, gw = vcu * NWAVES + wave;
            { const bf16* wrt = (const bf16*)(ws + WS_WRT) + (size_t)l * 2 * NE * D; const int tid_ = wave * 64 + lane;
#pragma unroll
              for (int it = 0; it < 8; ++it) { const int c = tid_ + 512 * it, hl = c >> 11, ks = (c >> 6) & 31, ln = c & 63;
                  *(LAS u32x4*)(lds + c * 16) = *(const u32x4*)(wrt + (size_t)hl * NE * D + (size_t)(ln & 15) * D + 32 * ks + 8 * (ln >> 4)); }
              LDS_WAIT(); __syncthreads(); }
            const LAS unsigned char* whl = lds + lane * 16;
            const bf16* xbp = (const bf16*)(ws + WS_XB); float* AFFTp = (float*)(ws + WS_AFFT); float* r2p = (float*)(ws + WS_R2);
            int tile = gw;
            if (tile < M / 16) {
                bf16x8 a[32];
                { const bf16* xa = xbp + (size_t)(tile * 16 + fr) * D + 8 * fq;
#pragma unroll
                  for (int ks = 0; ks < 32; ++ks) a[ks] = *(const bf16x8*)(xa + 32 * ks); }
                for (;;) {
                    const int row0 = tile * 16;
                    f32x4 acc = (f32x4){0.f, 0.f, 0.f, 0.f}; float ss = 0.f;
#pragma unroll
                    for (int ks = 0; ks < 32; ++ks) {
                        const bf16x8 bh = *(const LAS bf16x8*)(whl + ks * 1024), bl = *(const LAS bf16x8*)(whl + 32768 + ks * 1024);
                        acc = __builtin_amdgcn_mfma_f32_16x16x32_bf16(a[ks], bh, acc, 0, 0, 0); acc = __builtin_amdgcn_mfma_f32_16x16x32_bf16(a[ks], bl, acc, 0, 0, 0);
#pragma unroll
                        for (int j = 0; j < 8; ++j) { const float v = bf2f((unsigned short)a[ks][j]); ss += v * v; }
                    }
                    const int ntile = tile + NGW; const bool more = ntile < M / 16;
                    { const bf16* xa = xbp + (size_t)((more ? ntile : tile) * 16 + fr) * D + 8 * fq;
#pragma unroll
                      for (int ks = 0; ks < 32; ++ks) a[ks] = *(const bf16x8*)(xa + 32 * ks); }
                    ss += xor16_f(ss); ss = sum32_f(ss);
                    const float r = 1.0f / sqrtf(ss * (1.0f / D) + EPS);
                    f32x4 aff;
#pragma unroll
                    for (int rg = 0; rg < 4; ++rg) { const float rt = __builtin_bit_cast(float, __builtin_amdgcn_ds_bpermute((4 * fq + rg) * 4, __builtin_bit_cast(int, r)));
                        const float lg = acc[rg] * rt; const float mx = row16_max(lg); const float pe = expf(lg - mx); aff[rg] = pe / row16_sum(pe); }
                    const int b = row0 >> 11, s0 = row0 & (S - 1);
                    *(f32x4*)(AFFTp + ((size_t)b * NE + fr) * S + s0 + 4 * fq) = aff;
                    if (fq == 0) r2p[row0 + fr] = r;
                    if (!more) break;
                    tile = ntile;
                }
            }
        }
        SEAM(pb + 4);
        for (int rr_ = 0; rr_ < REP_TOPK; ++rr_)
        if (IN(pb + 5)) {
            KArgs ka = KARGS(); unsigned char* ws = ka->ws;
            const int lane = lane_id_v(), gw = vcu * NWAVES + wave;
            for (int u = vcu + G * wave; u < NB * NE; u += NGW) {
                const int b = u / NE, e = u % NE;
                const float* a = ((float*)(ws + WS_AFFT)) + (size_t)u * S; unsigned key[32];
#pragma unroll
                for (int j = 0; j < 32; ++j) key[j] = __builtin_bit_cast(unsigned, a[64 * j + lane]);
                float r2v[32];
#pragma unroll
                for (int j = 0; j < 32; ++j) r2v[j] = ((const float*)(ws + WS_R2))[b * S + 64 * j + lane];
                unsigned T = 0;
                for (int bit = 31; bit >= 0; --bit) { const unsigned cand = T | (1u << bit); int cnt = 0;
#pragma unroll
                    for (int j = 0; j < 32; ++j) cnt += (key[j] >= cand) ? 1 : 0;
                    cnt = wave_sum_i(cnt);
                    if (cnt >= CAP) T = cand; }
                int cgt = 0;
#pragma unroll
                for (int j = 0; j < 32; ++j) cgt += (key[j] > T) ? 1 : 0;
                cgt = wave_sum_i(cgt);
                const int need_eq = CAP - cgt; int eq_base = 0, base = 0;
                const size_t slot0 = ((size_t)e * NB + b) * CAP;
                short* inv = ((short*)(ws + WS_INV)) + (size_t)u * S;
#pragma unroll
                for (int j = 0; j < 32; ++j) {
                    const bool iseq = key[j] == T; const unsigned long long eqb = __ballot(iseq);
                    const int eqrank = eq_base + __builtin_popcountll(eqb & ((1ull << lane) - 1ull)); eq_base += __builtin_popcountll(eqb);
                    const bool sel = (key[j] > T) || (iseq && eqrank < need_eq);
                    const unsigned long long sb = __ballot(sel);
                    const int pos = base + __builtin_popcountll(sb & ((1ull << lane) - 1ull)); base += __builtin_popcountll(sb);
                    const int sp = 64 * j + lane;
                    if (sel) { ((int*)(ws + WS_IDX))[slot0 + pos] = b * S + sp; ((float*)(ws + WS_VSEL))[slot0 + pos] = __builtin_bit_cast(float, key[j]); ((float*)(ws + WS_RSEL))[slot0 + pos] = r2v[j]; }
                    inv[sp] = sel ? (short)pos : (short)-1;
                }
            }
        }
        SEAM(pb + 5);
#ifndef NO_UP
        for (int rr_ = 0; rr_ < REP_UP; ++rr_)
        if (IN(pb + 6)) {
            KArgs ka = KARGS(); unsigned char* ws = ka->ws;
            LAUNDER_BX(); pg8::Gemm g{((const bf16*)(ws + WS_XB8)), ((const bf16*)(ws + WS_WUP)), D / 2}; pg8::MoeOrder So{8, G, bx};
            pg8::EpiUp E{((float*)(ws + WS_RSEL)), (unsigned char*)(ws + WS_H)};
            pg8::gemm_phase<pg8::EpiUp, pg8::MoeOrder, true>(lds, g, So, E, ((int*)(ws + WS_IDX)), wave * 64 + lane_id_v(), ka->mode, pg8::NoHook(), (const float*)(ws + WS_RSEL));
        }
#endif
        SEAM(pb + 6);
#ifndef NO_DOWN
        for (int rr_ = 0; rr_ < REP_DOWN; ++rr_)
        if (IN(pb + 7)) {
            KArgs ka = KARGS(); unsigned char* ws = ka->ws;
            LAUNDER_BX(); pg8::Gemm g{((const bf16*)(ws + WS_H)), ((const bf16*)(ws + WS_WDN)), FF / 2}; pg8::MoeOrder So{4, G, bx};
            pg8::EpiDown E{((float*)(ws + WS_VSEL)), ((bf16*)(ws + WS_Y))};
            pg8::gemm_phase<pg8::EpiDown, pg8::MoeOrder, false>(lds, g, So, E, nullptr, wave * 64 + lane_id_v(), ka->mode, pg8::NoHook(), (const float*)(ws + WS_VSEL));
        }
#endif
        SEAM(pb + 7);
        if (IN(pb + 8)) {
            KArgs ka = KARGS(); unsigned char* ws = ka->ws;
            const int lane = lane_id_v(), gw = vcu * NWAVES + wave; const bool last_layer = (l == DEPTH - 1);
            bf16* xbp = (bf16*)(ws + WS_XB); const bf16* Yp = (const bf16*)(ws + WS_Y); const short* INVp = (const short*)(ws + WS_INV); float* r1p = (float*)(ws + WS_R1);
            f32x4 gfin[4];
#pragma unroll
            for (int j = 0; j < 4; ++j) gfin[j] = last_layer ? *((const f32x4*)ka->in[19] + lane + 64 * j) : (f32x4){1.f, 1.f, 1.f, 1.f};
            for (int m = gw; m < M; m += NGW) {
                const int b = m >> 11, sp = m & (S - 1);
                const int myc = INVp[((size_t)b * NE + (lane & 15)) * S + sp];
                u32x2* xr = (u32x2*)(xbp + (size_t)m * D) + lane; f32x4 v[4];
#pragma unroll
                for (int j = 0; j < 4; ++j) { const u32x2 w = xr[64 * j]; v[j] = (f32x4){bflo(w.x), bfhi(w.x), bflo(w.y), bfhi(w.y)}; }
                unsigned emask = (unsigned)(__ballot(myc >= 0) & 0xffffull);
                while (emask) {
                    u32x2 y[4][4]; int ne = 0;
#pragma unroll
                    for (int q = 0; q < 4; ++q) { if (emask) { const int e = __builtin_ctz(emask); emask &= emask - 1u; const int c = __builtin_amdgcn_readlane(myc, e);
                            const u32x2* yr = (const u32x2*)(Yp + (((size_t)e * NB + b) * CAP + c) * D) + lane;
#pragma unroll
                            for (int j = 0; j < 4; ++j) y[q][j] = yr[64 * j]; ne = q + 1; }
                        else {
#pragma unroll
                            for (int j = 0; j < 4; ++j) y[q][j] = (u32x2){0u, 0u}; } }
#pragma unroll
                    for (int q = 0; q < 4; ++q)
#pragma unroll
                        for (int j = 0; j < 4; ++j) { v[j].x += bflo(y[q][j].x); v[j].y += bfhi(y[q][j].x); v[j].z += bflo(y[q][j].y); v[j].w += bfhi(y[q][j].y); }
                }
                if (last_layer) {
                    float ss = 0.f;
#pragma unroll
                    for (int j = 0; j < 4; ++j) ss += v[j].x * v[j].x + v[j].y * v[j].y + v[j].z * v[j].z + v[j].w * v[j].w;
                    ss = wave_sum(ss); const float r = 1.0f / sqrtf(ss * (1.0f / D) + EPS);
                    f32x4* orow = (f32x4*)(ka->out + (size_t)m * D) + lane;
#pragma unroll
                    for (int j = 0; j < 4; ++j) orow[64 * j] = v[j] * r * gfin[j];
                } else {
                    float ss = 0.f;
                    unsigned* x8r = (unsigned*)(ws + WS_XB8 + (size_t)m * D) + lane;
#pragma unroll
                    for (int j = 0; j < 4; ++j) { u32x2 w; w.x = pk2(v[j].x, v[j].y); w.y = pk2(v[j].z, v[j].w); xr[64 * j] = w; x8r[64 * j] = pk4_fp8(v[j]);
                        const float a0 = bflo(w.x), a1 = bfhi(w.x), a2 = bflo(w.y), a3 = bfhi(w.y); ss += a0 * a0 + a1 * a1 + a2 * a2 + a3 * a3; }
                    ss = wave_sum(ss);
                    if (lane == 0) r1p[m] = 1.0f / sqrtf(ss * (1.0f / D) + EPS);
                }
            }
        }
        SEAM(pb + 8);
    }
#undef IN
#undef SEAM
}

#ifndef OPT_G1
#define OPT_G1 1
#endif
#ifndef OPT_G2
#define OPT_G2 1
#endif
#ifndef OPT_G3
#define OPT_G3 1
#endif
#ifndef OPT_UP
#define OPT_UP 1
#endif
#ifndef OPT_DOWN
#define OPT_DOWN 1
#endif
extern "C" void kernel_launch(void* const* d_in, const int* in_sizes, int n_in, void* d_out, int out_size, void* d_ws, size_t ws_size, hipStream_t stream) {
    if (n_in != 20 || ws_size < WS_END) { fprintf(stderr, "kernel_launch: unexpected n_in %d / ws_size %zu\n", n_in, ws_size); return; }
    static int grid = 0;
    if (grid == 0) {
        int dev = 0, cus = 0;
        if (hipGetDevice(&dev) != hipSuccess || hipDeviceGetAttribute(&cus, hipDeviceAttributeMultiprocessorCount, dev) != hipSuccess) { grid = -1; return; }
        if (hipFuncSetAttribute((const void*)mk_fwd, hipFuncAttributeMaxDynamicSharedMemorySize, LDS_BYTES) != hipSuccess) { fprintf(stderr, "hipFuncSetAttribute failed\n"); grid = -1; return; }
        (void)hipGetLastError();
        int per_cu = 0;
        if (hipOccupancyMaxActiveBlocksPerMultiprocessor(&per_cu, (const void*)mk_fwd, NWAVES * 64, LDS_BYTES) != hipSuccess || per_cu < 1)
            fprintf(stderr, "kernel_launch: note: the occupancy query reports %d workgroups per CU for %d bytes of LDS\n", per_cu, (int)LDS_BYTES);
        (void)hipGetLastError();
        grid = cus;
    }
    if (grid < 0) return;
    unsigned char* ws = (unsigned char*)d_ws;
    static_assert((CW_BAR + XCD_BAR_WORDS) * 4 <= 32768, "barrier words inside the cleared block");
    (void)hipMemsetAsync(ws + WS_CTL, 0, 32768, stream);
    MkArgs a{};
    for (int i = 0; i < 20; ++i) a.in[i] = (const float*)d_in[i];
    a.out = (float*)d_out; a.ws = ws;
    auto run = [&](int lo, int hi, int sub, int mode = 0) { MkArgs b = a; b.ph_lo = lo; b.ph_hi = hi; b.sub = sub; b.mode = mode; hipLaunchKernelGGL(mk_fwd, dim3(grid), dim3(NWAVES * 64), LDS_BYTES, stream, b); };
#ifndef MK_MULTI
#define MK_MULTI 0
#endif
    if (!MK_MULTI) { run(0, PH_TOTAL, 7); return; }
#ifndef PROBE_DUP_PH
#define PROBE_DUP_PH -1
#endif
#ifndef PROBE_DUP_MODE
#define PROBE_DUP_MODE 0
#endif
#ifndef PROBE_DUP_SUB
#define PROBE_DUP_SUB 7
#endif
    if (MK_MULTI == 2) {
        run(0, 1, 0); if (PROBE_DUP_PH == -2) run(0, 1, 0);
        for (int l = 0; l < DEPTH; ++l) { const int pb = 1 + l * PH_PER_LAYER;
            for (int k = 0; k < PH_PER_LAYER; ++k) { run(pb + k, pb + k + 1, 7);
                if (k == PROBE_DUP_PH && (k != 3 || PROBE_DUP_MODE != 0) && k != 8) run(pb + k, pb + k + 1, PROBE_DUP_SUB, PROBE_DUP_MODE); } }
        return;
    }
}
```
